# Optimizing an MI355X kernel written in HIP

```python
import math
import jax
import jax.numpy as jnp
from jax import lax
import numpy as np

D_MODEL = 2048
BATCH = 4
SEQ = 4096
DEPTH = 2

CTX_LEN = 256
GRID_W = 64
HEAD_DIM = 128
DA_WIDTH = 3 * D_MODEL // 8
NA_WIDTH = 3 * D_MODEL // 8
MLP_WIDTH = D_MODEL // 4
DA_HEADS = DA_WIDTH // HEAD_DIM
NA_HEADS = NA_WIDTH // HEAD_DIM
MLP_GROUPS = MLP_WIDTH // HEAD_DIM
DA_QK_DIM = HEAD_DIM // 2
NA_WIN_H = 8
NA_WIN_W = 16
CHUNK = 128
Q_BLOCK = 128
ROPE_BASE = 10000.0
EPS = 1e-6
IN_SIZES = (DA_WIDTH,) * 4 + (NA_WIDTH,) * 4 + (MLP_WIDTH,) * 3
IN_OFFSETS = tuple(sum(IN_SIZES[:i]) for i in range(len(IN_SIZES) + 1))
IN_WIDTH = IN_OFFSETS[-1]
MIX_WIDTH = DA_WIDTH + NA_WIDTH + MLP_WIDTH

kernel_name = "hybrid_diffattn_natten_gmlp_prefix_dit"


def rms_norm(x, g):
    xf = x.astype(jnp.float32)
    y = xf * lax.rsqrt(jnp.mean(xf * xf, axis=-1, keepdims=True) + EPS)
    return (y * g.astype(jnp.float32)).astype(x.dtype)


def layer_norm(x, g, b):
    xf = x.astype(jnp.float32)
    mu = jnp.mean(xf, axis=-1, keepdims=True)
    xc = xf - mu
    y = xc * lax.rsqrt(jnp.mean(xc * xc, axis=-1, keepdims=True) + EPS)
    return (y * g.astype(jnp.float32) + b.astype(jnp.float32)).astype(x.dtype)


def _rotate(xp, ang):
    h = xp.shape[-1] // 2
    x1, x2 = xp[..., :h], xp[..., h:]
    cos, sin = jnp.cos(ang), jnp.sin(ang)
    return jnp.concatenate([x1 * cos - x2 * sin, x2 * cos + x1 * sin], axis=-1)


def rope_2d(x, row, col):
    n = x.shape[-1] // 4
    freqs = ROPE_BASE ** (-jnp.arange(n, dtype=jnp.float32) / n)
    ar = (row.astype(jnp.float32)[:, None] * freqs)[:, None, None, :]
    ac = (col.astype(jnp.float32)[:, None] * freqs)[:, None, None, :]
    xr = _rotate(x[..., :2 * n].astype(jnp.float32), ar)
    xc = _rotate(x[..., 2 * n:].astype(jnp.float32), ac)
    return jnp.concatenate([xr, xc], axis=-1).astype(x.dtype)


def diff_attn(q, k, v, lam):
    s = jnp.einsum('bqhid,bkhid->bhiqk', q, k).astype(jnp.float32) * (q.shape[-1] ** -0.5)
    p = jax.nn.softmax(s, axis=-1)
    a = p[:, :, 0] - lam * p[:, :, 1]
    return jnp.einsum('bhqk,bkhd->bqhd', a.astype(v.dtype), v)


def softmax_attn(q, k, v):
    s = jnp.einsum('bqhd,bkhd->bhqk', q, k).astype(jnp.float32) * (q.shape[-1] ** -0.5)
    p = jax.nn.softmax(s, axis=-1)
    return jnp.einsum('bhqk,bkhd->bqhd', p.astype(v.dtype), v)


def neighbourhood_attn(q, k, v, kc, vc, rpb):
    B, S, H, d = q.shape
    rows = S // GRID_W
    kh = min(NA_WIN_H, rows)
    kw = NA_WIN_W
    qg = q.reshape(B, rows, GRID_W, H, d)
    kg = k.reshape(B, rows, GRID_W, H, d)
    vg = v.reshape(B, rows, GRID_W, H, d)
    cols = jnp.arange(GRID_W)
    cs = jnp.clip(cols - kw // 2, 0, GRID_W - kw)
    colidx = cs[:, None] + jnp.arange(kw)[None, :]
    rel_col = colidx - cols[:, None] + (NA_WIN_W - 1)
    scale = d ** -0.5

    def one_row(r):
        rs = jnp.clip(r - kh // 2, 0, rows - kh)
        qr = lax.dynamic_index_in_dim(qg, r, axis=1, keepdims=False)
        kr = lax.dynamic_slice_in_dim(kg, rs, kh, axis=1)
        vr = lax.dynamic_slice_in_dim(vg, rs, kh, axis=1)
        kwin = kr[:, :, colidx]
        vwin = vr[:, :, colidx]
        rel_row = rs + jnp.arange(kh) - r + (NA_WIN_H - 1)
        bias = rpb[:, rel_row[None, :, None], rel_col[:, None, :]]
        s_loc = (jnp.einsum('bchd,bicjhd->bhcij', qr, kwin).astype(jnp.float32) * scale
                 + bias.astype(jnp.float32)[None])
        s_loc = s_loc.reshape(B, H, GRID_W, kh * kw)
        s_ctx = jnp.einsum('bchd,bnhd->bhcn', qr, kc).astype(jnp.float32) * scale
        p = jax.nn.softmax(jnp.concatenate([s_loc, s_ctx], axis=-1), axis=-1).astype(v.dtype)
        p_loc = p[..., :kh * kw].reshape(B, H, GRID_W, kh, kw)
        p_ctx = p[..., kh * kw:]
        return (jnp.einsum('bhcij,bicjhd->bchd', p_loc, vwin)
                + jnp.einsum('bhcn,bnhd->bchd', p_ctx, vc))

    out = lax.map(one_row, jnp.arange(rows))
    return out.transpose(1, 0, 2, 3, 4).reshape(B, S, H, d)


def spatial_gating(u, v, ln_g, ln_b, w_s, b_s):
    B, N, G, c = u.shape
    vn = layer_norm(v, ln_g, ln_b).reshape(B, N // CHUNK, CHUNK, G, c)
    mixed = jnp.einsum('gpq,bnqgc->bnpgc', w_s, vn) + b_s.T[None, None, :, :, None]
    return u * mixed.reshape(B, N, G, c)


def _split_cols(p):
    return [p[..., a:b] for a, b in zip(IN_OFFSETS[:-1], IN_OFFSETS[1:])]


def _branch_out(o, z, g, factor):
    return (rms_norm(o, g) * factor).reshape(z.shape) * jax.nn.silu(z)


def _mixer(h_a, h_n, h_m, z_a, z_n, z_m, w_out, da_g, na_g, mlp_g, lam_init):
    ya = _branch_out(h_a, z_a, da_g, 1.0 - lam_init)
    yn = _branch_out(h_n, z_n, na_g, 1.0)
    ym = _branch_out(h_m, z_m, mlp_g, 1.0)
    return jnp.concatenate([ya, yn, ym], axis=-1) @ w_out


def _layer(x, xc, c, c_ctx, ada_w, ada_b, pre_g, post_g, w_in, w_out,
           lam_q1, lam_k1, lam_q2, lam_k2, da_g, na_rpb, na_g,
           mlp_ln_g, mlp_ln_b, mlp_ws, mlp_bs, mlp_g, layer_idx, ctx_out):
    B, S, _ = x.shape
    C = xc.shape[1]
    lam_init = 0.8 - 0.6 * math.exp(-0.3 * layer_idx)
    lam = (jnp.exp(jnp.sum(lam_q1.astype(jnp.float32) * lam_k1.astype(jnp.float32)))
           - jnp.exp(jnp.sum(lam_q2.astype(jnp.float32) * lam_k2.astype(jnp.float32)))
           + lam_init)

    shift, scale, gate = jnp.split(jax.nn.silu(c) @ ada_w + ada_b, 3, axis=-1)
    shift_c, scale_c, gate_c = jnp.split(jax.nn.silu(c_ctx) @ ada_w + ada_b, 3, axis=-1)
    h = rms_norm(x, pre_g) * (1.0 + scale[:, None, :]) + shift[:, None, :]
    hc = rms_norm(xc, pre_g) * (1.0 + scale_c) + shift_c

    aq, ak, av, az, nq, nk, nv, nz, mu, mv, mz = _split_cols(h @ w_in)
    if ctx_out:
        caq, cak, cav, caz, cnq, cnk, cnv, cnz, cmu, cmv, cmz = _split_cols(hc @ w_in)
    else:
        cak, cav = jnp.split(hc @ w_in[:, IN_OFFSETS[1]:IN_OFFSETS[3]], 2, axis=-1)
        cnk, cnv = jnp.split(hc @ w_in[:, IN_OFFSETS[5]:IN_OFFSETS[7]], 2, axis=-1)

    pos = jnp.arange(S)
    row, col = pos // GRID_W, pos % GRID_W

    dq = rope_2d(aq.reshape(B, S, DA_HEADS, 2, DA_QK_DIM), row, col)
    dk = rope_2d(ak.reshape(B, S, DA_HEADS, 2, DA_QK_DIM), row, col)
    dv = av.reshape(B, S, DA_HEADS, HEAD_DIM)
    dkc = cak.reshape(B, C, DA_HEADS, 2, DA_QK_DIM)
    dvc = cav.reshape(B, C, DA_HEADS, HEAD_DIM)
    k_all = jnp.concatenate([dk, dkc], axis=1)
    v_all = jnp.concatenate([dv, dvc], axis=1)
    qb = dq.reshape(B, S // Q_BLOCK, Q_BLOCK, DA_HEADS, 2, DA_QK_DIM).swapaxes(0, 1)
    oa = lax.map(lambda qi: diff_attn(qi, k_all, v_all, lam), qb)
    oa = oa.swapaxes(0, 1).reshape(B, S, DA_HEADS, HEAD_DIM)

    nkc = cnk.reshape(B, C, NA_HEADS, HEAD_DIM)
    nvc = cnv.reshape(B, C, NA_HEADS, HEAD_DIM)
    on = neighbourhood_attn(nq.reshape(B, S, NA_HEADS, HEAD_DIM), nk.reshape(B, S, NA_HEADS, HEAD_DIM),
                            nv.reshape(B, S, NA_HEADS, HEAD_DIM), nkc, nvc, na_rpb)

    om = spatial_gating(jax.nn.gelu(mu).reshape(B, S, MLP_GROUPS, HEAD_DIM),
                        jax.nn.gelu(mv).reshape(B, S, MLP_GROUPS, HEAD_DIM),
                        mlp_ln_g, mlp_ln_b, mlp_ws, mlp_bs)

    y = _mixer(oa, on, om, az, nz, mz, w_out, da_g, na_g, mlp_g, lam_init)
    x = x + gate[:, None, :] * rms_norm(y, post_g)

    if ctx_out:
        oca = diff_attn(caq.reshape(B, C, DA_HEADS, 2, DA_QK_DIM), dkc, dvc, lam)
        ocn = softmax_attn(cnq.reshape(B, C, NA_HEADS, HEAD_DIM), nkc, nvc)
        ocm = spatial_gating(jax.nn.gelu(cmu).reshape(B, C, MLP_GROUPS, HEAD_DIM),
                             jax.nn.gelu(cmv).reshape(B, C, MLP_GROUPS, HEAD_DIM),
                             mlp_ln_g, mlp_ln_b, mlp_ws, mlp_bs)
        yc = _mixer(oca, ocn, ocm, caz, cnz, cmz, w_out, da_g, na_g, mlp_g, lam_init)
        xc = xc + gate_c * rms_norm(yc, post_g)
    return x, xc


def setup_inputs(seed: int = 0) -> dict:
    key = jax.random.key(seed)
    ks = jax.random.split(key, 24)
    n = jax.random.normal
    f = jnp.float32
    L, D = DEPTH, D_MODEL
    return {
        "x": n(ks[0], (BATCH, SEQ, D), f),
        "c": n(ks[1], (BATCH, D), f),
        "ctx": n(ks[2], (BATCH, CTX_LEN, D), f),
        "c_ctx": n(ks[3], (D,), f),
        "ada_w": n(ks[4], (L, D, 3 * D), f) * (0.5 * D ** -0.5),
        "ada_b": n(ks[5], (L, 3 * D), f) * 0.01,
        "pre_g": 1.0 + 0.05 * n(ks[6], (L, D), f),
        "post_g": 1.0 + 0.05 * n(ks[7], (L, D), f),
        "w_in": n(ks[8], (L, D, IN_WIDTH), f) * D ** -0.5,
        "w_out": n(ks[9], (L, MIX_WIDTH, D), f) * MIX_WIDTH ** -0.5,
        "lam_q1": 0.1 * n(ks[10], (L, DA_QK_DIM), f),
        "lam_k1": 0.1 * n(ks[11], (L, DA_QK_DIM), f),
        "lam_q2": 0.1 * n(ks[12], (L, DA_QK_DIM), f),
        "lam_k2": 0.1 * n(ks[13], (L, DA_QK_DIM), f),
        "da_g": 1.0 + 0.05 * n(ks[14], (L, HEAD_DIM), f),
        "na_rpb": 0.1 * n(ks[15], (L, NA_HEADS, 2 * NA_WIN_H - 1, 2 * NA_WIN_W - 1), f),
        "na_g": 1.0 + 0.05 * n(ks[16], (L, NA_HEADS, HEAD_DIM), f),
        "mlp_ln_g": 1.0 + 0.05 * n(ks[17], (L, MLP_GROUPS, HEAD_DIM), f),
        "mlp_ln_b": 0.02 * n(ks[18], (L, MLP_GROUPS, HEAD_DIM), f),
        "mlp_ws": n(ks[19], (L, MLP_GROUPS, CHUNK, CHUNK), f) * CHUNK ** -0.5,
        "mlp_bs": 1.0 + 0.05 * n(ks[20], (L, MLP_GROUPS, CHUNK), f),
        "mlp_g": 1.0 + 0.05 * n(ks[21], (L, MLP_GROUPS, HEAD_DIM), f),
    }


def reference(x, c, ctx, c_ctx, ada_w, ada_b, pre_g, post_g, w_in, w_out,
              lam_q1, lam_k1, lam_q2, lam_k2, da_g, na_rpb, na_g,
              mlp_ln_g, mlp_ln_b, mlp_ws, mlp_bs, mlp_g):
    xc = ctx
    for l in range(DEPTH):
        x, xc = _layer(x, xc, c, c_ctx, ada_w[l], ada_b[l], pre_g[l], post_g[l], w_in[l], w_out[l],
                       lam_q1[l], lam_k1[l], lam_q2[l], lam_k2[l], da_g[l], na_rpb[l], na_g[l],
                       mlp_ln_g[l], mlp_ln_b[l], mlp_ws[l], mlp_bs[l], mlp_g[l],
                       l, l < DEPTH - 1)
    return x
```

```cpp
#include <hip/hip_runtime.h>
#include <hip/hip_cooperative_groups.h>
#include <cstdio>
#include <cstdint>
namespace cg = cooperative_groups;
#ifndef UNIT_MASK
#define UNIT_MASK 31
#endif

#ifndef MK_SINGLE
#define MK_SINGLE 0
#endif

#define LAS __attribute__((address_space(3)))
typedef unsigned short bf16_t;
typedef short bf16x8 __attribute__((ext_vector_type(8)));
typedef short s16x4 __attribute__((ext_vector_type(4)));
typedef float f32x2 __attribute__((ext_vector_type(2)));
typedef float f32x4 __attribute__((ext_vector_type(4)));
typedef float f32x8 __attribute__((ext_vector_type(8)));
typedef float f32x16 __attribute__((ext_vector_type(16)));
typedef unsigned u32x2 __attribute__((ext_vector_type(2)));
typedef unsigned u32x4 __attribute__((ext_vector_type(4)));

constexpr int DM = 2048, NB = 4, SEQ = 4096, CTXL = 256, NLAT = NB * SEQ, NCTX = NB * CTXL, MROWS = NLAT + NCTX;
constexpr int INW = 7680, LDP = INW, HD = 128;
constexpr int C_AQ = 0, C_AK = 768, C_AV = 1536, C_AZ = 2304, C_NQ = 3072, C_NK = 3840, C_NV = 4608, C_NZ = 5376, C_MU = 6144, C_MV = 6656, C_MZ = 7168;
constexpr float EPS = 1e-6f;
constexpr float LOG2E = 1.4426950408889634f;

constexpr size_t MiB = 1u << 20;
constexpr size_t WS_CTL = 0, CTL_BYTES = 1 * MiB;
constexpr size_t CTL_QCTR = 256;
constexpr size_t CTL_MOD = 4096;
constexpr size_t CTL_ROWSS = 262144;
constexpr size_t CTL_BAR = 524288;
constexpr size_t WS_TAB = 1 * MiB;
constexpr size_t WS_WSB = 1 * MiB + 65536;
constexpr size_t WS_WIN = 2 * MiB;
constexpr size_t WS_WOUT = 62 * MiB;
constexpr size_t WS_H = 78 * MiB;
constexpr size_t WS_XC1 = 146 * MiB;
constexpr size_t WS_P = 154 * MiB;
constexpr size_t WS_END = 409 * MiB;

constexpr int LDS_BYTES = 147456;
constexpr int MISC_OFF = 139264;

struct Params {
    const float *x, *c, *ctx, *c_ctx, *ada_w, *ada_b, *pre_g, *post_g, *w_in, *w_out, *lq1, *lk1, *lq2, *lk2, *da_g, *rpb, *na_g, *ln_g, *ln_b, *mws, *mbs, *mlp_g;
    float* out; unsigned char* ws; int ph_lo, ph_hi;
};

__device__ __forceinline__ unsigned cvt_pk_bf16(float lo, float hi) { unsigned r; asm volatile("v_cvt_pk_bf16_f32 %0, %1, %2" : "=v"(r) : "v"(lo), "v"(hi)); return r; }
__device__ __forceinline__ float bf_lo(unsigned w) { return __uint_as_float(w << 16); }
__device__ __forceinline__ float bf_hi(unsigned w) { return __uint_as_float(w & 0xffff0000u); }
__device__ __forceinline__ float wave_sum(float v) {
#pragma unroll
    for (int o = 1; o < 64; o <<= 1) v += __shfl_xor(v, o);
    return v;
}
__device__ __forceinline__ float silu_f(float z) { return z * __builtin_amdgcn_rcpf(1.0f + __builtin_amdgcn_exp2f(-z * LOG2E)); }
__device__ __forceinline__ float gelu_tanh(float x) {
    const float u = 0.7978845608028654f * (x + 0.044715f * x * x * x);
    return x * __builtin_amdgcn_rcpf(1.0f + __builtin_amdgcn_exp2f(-2.0f * LOG2E * u));
}

namespace pg8 {
constexpr int BM = 256, BK = 64, HALF = 128, HTB = HALF * BK * 2, STAGE_BYTES = 8 * HTB, NXCD = 8, WGM = 8;
__host__ __device__ __forceinline__ int lds_byte(int r, int c) { const int st = (r >> 4) * 2 + (c >> 5), rr = r & 15, cc = c & 31, ob = rr * 64 + cc * 2; return st * 1024 + (ob ^ (((ob >> 9) & 1) << 5)); }
__host__ __device__ __forceinline__ void stage_rc(int b, int& R, int& C) { const int st = b / 1024, sb = b % 1024, swz = sb ^ (((sb >> 9) & 1) << 5); R = (st >> 1) * 16 + swz / 64; C = (st & 1) * 32 + (swz % 64) / 2; }
__host__ __device__ __forceinline__ int perm32(int rho) { const int n = rho >> 4, i = rho & 15; return 8 * (i >> 2) + 4 * n + (i & 3); }

struct Unit { int pm, pn; };
struct Gemm { const bf16_t* A; const bf16_t* Bt; int K; };

struct Sched {
    int nM, nN, nwg, G, c, extra;
    __device__ void init(int nM_, int nN_, int G_, int c_, int extra_) { nM = nM_; nN = nN_; nwg = nM * nN; G = G_; c = c_; extra = extra_; }
    __device__ bool next(int i, Unit& u) const {
        const long L = (long)i * G + c;
        if (L < nwg) {
            int wgid = (int)L; { const int q = nwg / NXCD, r = nwg % NXCD, xcd = wgid % NXCD, off = wgid / NXCD; wgid = (xcd < r ? xcd * (q + 1) : r * (q + 1) + (xcd - r) * q) + off; }
            const int nig = WGM * nN, gid = wgid / nig, fm = gid * WGM, gsz = (nM - fm) < WGM ? (nM - fm) : WGM;
            u.pm = fm + ((wgid % nig) % gsz); u.pn = (wgid % nig) / gsz; return true;
        }
        const int e = (int)(L - nwg); if (e >= extra) return false;
        const int t = e >> 2; u.pm = 64 + (e & 3); u.pn = t < 6 ? 3 + t : 9 + t; return true;
    }
};

template <class Epi>
__device__ __forceinline__ void gemm_phase(LAS unsigned char* lds, const Gemm g, const Sched& S, const Epi& E) {
    const int tid = threadIdx.x, wid = __builtin_amdgcn_readfirstlane(tid >> 6), lane = tid & 63, wr = wid >> 2, wc = wid & 3, fr = lane & 15, fq = lane >> 4;
    const int K = g.K, nt = K / BK;
    unsigned voffA[2], voffB[2];
#pragma unroll
    for (int i = 0; i < 2; ++i) { int R, C; stage_rc(tid * 16 + i * 8192, R, C); const int Rb = Epi::PERM ? ((R & ~31) + perm32(R & 31)) : R;
        voffA[i] = (unsigned)(R * K + C) * 2u; voffB[i] = (unsigned)(Rb * K + C) * 2u; }
    const size_t kstep = (size_t)(BK * 2);
    const size_t hstep = (size_t)HALF * K * 2;
    const size_t tstep = 2 * hstep;
    const unsigned ldsw = (unsigned)wid * 1024u;
    const int aoff = lds_byte(wr * 64 + fr, fq * 8), boff = lds_byte(wc * 32 + fr, fq * 8);
#define PG8_SA(b, h) (((b) * 2 + (h)) * HTB)
#define PG8_SB(b, h) ((4 + (b) * 2 + (h)) * HTB)
#define PG8_STAGE(bufoff, gbase, voff) do { _Pragma("unroll") for (int _i = 0; _i < 2; ++_i) \
        __builtin_amdgcn_global_load_lds((const unsigned*)((const char*)(gbase) + (voff)[_i]), (LAS unsigned*)(lds + (bufoff) + ldsw + _i * 8192), 16, 0, 0); } while (0)
#define PG8_LDA(dst, b, h) do { _Pragma("unroll") for (int m = 0; m < 4; ++m) _Pragma("unroll") for (int k = 0; k < 2; ++k) dst[m][k] = *(const LAS bf16x8*)(lds + PG8_SA(b, h) + aoff + m * 2048 + k * 1024); } while (0)
#define PG8_LDB(dst, b, h) do { _Pragma("unroll") for (int n = 0; n < 2; ++n) _Pragma("unroll") for (int k = 0; k < 2; ++k) dst[n][k] = *(const LAS bf16x8*)(lds + PG8_SB(b, h) + boff + n * 2048 + k * 1024); } while (0)
#define PG8_MMA(ai, bj, At, Bt) do { __builtin_amdgcn_s_setprio(1); _Pragma("unroll") for (int m = 0; m < 4; ++m) _Pragma("unroll") for (int n = 0; n < 2; ++n) _Pragma("unroll") for (int k = 0; k < 2; ++k) \
        acc[ai][bj][m][n] = __builtin_amdgcn_mfma_f32_16x16x32_bf16(Bt[n][k], At[m][k], acc[ai][bj][m][n], 0, 0, 0); __builtin_amdgcn_s_setprio(0); } while (0)
#define PG8_WAIT_V(n) asm volatile("s_waitcnt vmcnt(" #n ")" ::: "memory")
#define PG8_WAIT_L(n) asm volatile("s_waitcnt lgkmcnt(" #n ")" ::: "memory")
#define PG8_BAR __builtin_amdgcn_s_barrier()
#define PG8_SCHED __builtin_amdgcn_sched_barrier(0)
    Unit cur, nxt; int ui = 0;
    if (!S.next(0, cur)) return;
    f32x4 acc[2][2][4][2];
#pragma unroll
    for (int a = 0; a < 2; ++a)
#pragma unroll
        for (int b = 0; b < 2; ++b)
#pragma unroll
            for (int m = 0; m < 4; ++m)
#pragma unroll
                for (int n = 0; n < 2; ++n) acc[a][b][m][n] = (f32x4){0.f, 0.f, 0.f, 0.f};
    bf16x8 At[4][2], B0[2][2], B1[2][2];
    const char* cA = (const char*)g.A + (size_t)cur.pm * tstep; const char* cB = (const char*)g.Bt + (size_t)cur.pn * tstep;
    PG8_STAGE(PG8_SB(0, 0), cB, voffB); PG8_STAGE(PG8_SB(0, 1), cB + hstep, voffB); PG8_STAGE(PG8_SA(0, 0), cA, voffA); PG8_STAGE(PG8_SA(0, 1), cA + hstep, voffA);
    if (wr == 1) PG8_BAR;
    PG8_WAIT_V(2); PG8_BAR;
    PG8_STAGE(PG8_SB(1, 0), cB + kstep, voffB); PG8_STAGE(PG8_SA(1, 0), cA + kstep, voffA); PG8_STAGE(PG8_SB(1, 1), cB + hstep + kstep, voffB);
    PG8_WAIT_V(6); PG8_BAR;
    for (;;) {
        const bool has_next = S.next(ui + 1, nxt);
        const char* nA = has_next ? (const char*)g.A + (size_t)nxt.pm * tstep : cA; const char* nB = has_next ? (const char*)g.Bt + (size_t)nxt.pn * tstep : cB;
        for (int t = 0; t < nt; t += 2) {
            const bool last = (t == nt - 2);
            const char* a1 = cA + (size_t)(t + 1) * kstep;
            const char* a2 = last ? nA : cA + (size_t)(t + 2) * kstep; const char* b2 = last ? nB : cB + (size_t)(t + 2) * kstep;
            const char* a3 = a2 + kstep; const char* b3 = b2 + kstep;
            PG8_LDB(B0, 0, 0); PG8_LDB(B1, 0, 1); PG8_SCHED; PG8_LDA(At, 0, 0); PG8_STAGE(PG8_SA(1, 1), a1 + hstep, voffA);
            PG8_WAIT_V(8); PG8_WAIT_L(0); PG8_BAR; PG8_MMA(0, 0, At, B0); PG8_MMA(0, 1, At, B1); PG8_BAR; PG8_SCHED;
            PG8_LDA(At, 0, 1); PG8_STAGE(PG8_SB(0, 0), b2, voffB); PG8_STAGE(PG8_SB(0, 1), b2 + hstep, voffB); PG8_STAGE(PG8_SA(0, 0), a2, voffA);
            PG8_WAIT_V(8); PG8_WAIT_L(0); PG8_BAR; PG8_MMA(1, 0, At, B0); PG8_MMA(1, 1, At, B1); PG8_BAR; PG8_SCHED;
            PG8_LDB(B0, 1, 0); PG8_LDB(B1, 1, 1); PG8_SCHED; PG8_LDA(At, 1, 0); PG8_STAGE(PG8_SA(0, 1), a2 + hstep, voffA);
            PG8_WAIT_V(8); PG8_WAIT_L(0); PG8_BAR; PG8_MMA(0, 0, At, B0); PG8_MMA(0, 1, At, B1); PG8_BAR; PG8_SCHED;
            PG8_LDA(At, 1, 1); PG8_STAGE(PG8_SB(1, 0), b3, voffB); PG8_STAGE(PG8_SB(1, 1), b3 + hstep, voffB); PG8_STAGE(PG8_SA(1, 0), a3, voffA);
            PG8_WAIT_V(8); PG8_WAIT_L(0); PG8_BAR; PG8_MMA(1, 0, At, B0); PG8_MMA(1, 1, At, B1); PG8_BAR; PG8_SCHED;
        }
        if (wr == 0) PG8_BAR;
        E(acc, cur, wr, wc, fr, fq);
        if (!has_next) break;
#pragma unroll
        for (int a = 0; a < 2; ++a)
#pragma unroll
            for (int b = 0; b < 2; ++b)
#pragma unroll
                for (int m = 0; m < 4; ++m)
#pragma unroll
                    for (int n = 0; n < 2; ++n) acc[a][b][m][n] = (f32x4){0.f, 0.f, 0.f, 0.f};
        cur = nxt; cA = nA; cB = nB; ++ui;
        if (wr == 1) PG8_BAR;
    }
    PG8_WAIT_V(0);
    PG8_BAR;
#undef PG8_SA
#undef PG8_SB
#undef PG8_STAGE
#undef PG8_LDA
#undef PG8_LDB
#undef PG8_MMA
#undef PG8_WAIT_V
#undef PG8_WAIT_L
#undef PG8_BAR
#undef PG8_SCHED
}

struct Epi1 {
    static constexpr bool PERM = true;
    bf16_t* O; const float* cs; const float* sn;
    __device__ __forceinline__ void operator()(const f32x4 (&acc)[2][2][4][2], const Unit& u, int wr, int wc, int fr, int fq) const {
        const int row0 = u.pm * BM + wr * 64 + fr, col0 = u.pn * BM + wc * 32 + 8 * fq;
        const bool rope = (u.pn < 6) && (u.pm < 64), gelu = (u.pn >= 24) && (u.pn < 28);
        const float sgn = (fq < 2) ? -1.f : 1.f;
#pragma unroll
        for (int ai = 0; ai < 2; ++ai)
#pragma unroll
            for (int m = 0; m < 4; ++m) {
                const int row = row0 + ai * HALF + m * 16;
                bf16_t* rowp = O + (size_t)row * LDP + col0;
                f32x4 c0 = {1.f, 1.f, 1.f, 1.f}, c1 = c0, s0 = {0.f, 0.f, 0.f, 0.f}, s1 = s0;
                if (rope) { const int s = row & (SEQ - 1); const int pos = (wc & 1) ? (s & 63) : (s >> 6); const int ti = pos * 16 + 8 * (fq & 1);
                    c0 = *(const f32x4*)(cs + ti); c1 = *(const f32x4*)(cs + ti + 4); s0 = *(const f32x4*)(sn + ti); s1 = *(const f32x4*)(sn + ti + 4);
                    s0 = s0 * sgn; s1 = s1 * sgn; }
#pragma unroll
                for (int bj = 0; bj < 2; ++bj) { f32x4 v0 = acc[ai][bj][m][0], v1 = acc[ai][bj][m][1];
                    if (rope) { f32x4 q0, q1;
#pragma unroll
                        for (int e = 0; e < 4; ++e) { q0[e] = __shfl_xor(v0[e], 32); q1[e] = __shfl_xor(v1[e], 32); }
                        v0 = v0 * c0 + q0 * s0; v1 = v1 * c1 + q1 * s1; }
                    if (gelu) {
#pragma unroll
                        for (int e = 0; e < 4; ++e) { v0[e] = gelu_tanh(v0[e]); v1[e] = gelu_tanh(v1[e]); } }
                    u32x4 w; w.x = cvt_pk_bf16(v0[0], v0[1]); w.y = cvt_pk_bf16(v0[2], v0[3]); w.z = cvt_pk_bf16(v1[0], v1[1]); w.w = cvt_pk_bf16(v1[2], v1[3]);
                    *(u32x4*)(rowp + bj * HALF) = w; } }
    }
};
struct Epi2 {
    static constexpr bool PERM = false;
    float* Yf; float* rowss;
    __device__ __forceinline__ void operator()(const f32x4 (&acc)[2][2][4][2], const Unit& u, int wr, int wc, int fr, int fq) const {
        const int row0 = u.pm * BM + wr * 64 + fr, col0 = u.pn * BM + wc * 32 + 4 * fq;
#pragma unroll
        for (int ai = 0; ai < 2; ++ai)
#pragma unroll
            for (int m = 0; m < 4; ++m) { const int row = row0 + ai * HALF + m * 16; float* rowp = Yf + (size_t)row * DM + col0; float ss = 0.f;
#pragma unroll
                for (int bj = 0; bj < 2; ++bj)
#pragma unroll
                    for (int n = 0; n < 2; ++n) { const f32x4 v = acc[ai][bj][m][n]; *(f32x4*)(rowp + bj * HALF + n * 16) = v; ss += (v[0] * v[0] + v[1] * v[1]) + (v[2] * v[2] + v[3] * v[3]); }
                ss += __shfl_xor(ss, 16); ss += __shfl_xor(ss, 32);
                if (fq == 0) atomicAdd(rowss + row, ss); }
    }
};
}

namespace att {
constexpr int SHM_V = 64 * 128 * 2, SHM_K = 64 * 128 * 2;
constexpr int WSF_OFF = 2 * SHM_V + 2 * SHM_K;
constexpr int BIAS_OFF = WSF_OFF + 2048;
constexpr int XS = 132;
constexpr float THR = 8.f;
#define KSWZ(row, colB) ((row) * 256 + ((colB) ^ (((row) & 7) << 4)))
#define SBAR() __builtin_amdgcn_sched_barrier(0)
__device__ __forceinline__ int crow(int r, int hi) { return (r & 3) + 8 * (r >> 2) + 4 * hi; }
__device__ __forceinline__ bf16x8 ld8(const bf16_t* p) { return *reinterpret_cast<const bf16x8*>(p); }

template <int MODE> struct ModeC { static constexpr float SC = (MODE == 0) ? 0.125f : 0.08838834764831845f; };

template <int MODE>
__device__ __forceinline__ void partialSM(f32x16& p0, f32x16& p1, float& m_reg, float& mn, float& alpha) {
    constexpr float C = ModeC<MODE>::SC * LOG2E;
    float pmax = p0[0];
#pragma unroll
    for (int r = 1; r < 16; ++r) pmax = fmaxf(pmax, p0[r]);
#pragma unroll
    for (int r = 0; r < 16; ++r) pmax = fmaxf(pmax, p1[r]);
    { auto rr = __builtin_amdgcn_permlane32_swap(__float_as_uint(pmax), __float_as_uint(pmax), false, false);
      pmax = fmaxf(__uint_as_float(rr[0]), __uint_as_float(rr[1])); }
    if (__builtin_expect(__all(pmax - m_reg <= THR / ModeC<MODE>::SC), 1)) { mn = m_reg; alpha = 1.f; }
    else { mn = fmaxf(m_reg, pmax); alpha = __builtin_amdgcn_exp2f((m_reg - mn) * C); m_reg = mn; }
    const float mnC = -mn * C;
#pragma unroll
    for (int r = 0; r < 16; ++r) p0[r] = fmaf(p0[r], C, mnC);
#pragma unroll
    for (int r = 0; r < 16; ++r) p1[r] = fmaf(p1[r], C, mnC);
#pragma unroll
    for (int r = 0; r < 16; ++r) p0[r] = __builtin_amdgcn_exp2f(p0[r]);
}
__device__ __forceinline__ void finishSM(f32x16& p0, f32x16& p1, float alpha, float& l_reg, bf16x8& pa0, bf16x8& pa1, bf16x8& pa2, bf16x8& pa3) {
#pragma unroll
    for (int r = 0; r < 16; ++r) p1[r] = __builtin_amdgcn_exp2f(p1[r]);
    float ps = 0;
#pragma unroll
    for (int r = 0; r < 16; ++r) ps += p0[r];
#pragma unroll
    for (int r = 0; r < 16; ++r) ps += p1[r];
    { auto rr = __builtin_amdgcn_permlane32_swap(__float_as_uint(ps), __float_as_uint(ps), false, false);
      ps = __uint_as_float(rr[0]) + __uint_as_float(rr[1]); }
    l_reg = l_reg * alpha + ps;
#define PK4(P, BASE, OUT) do { unsigned a0 = cvt_pk_bf16(P[BASE + 0], P[BASE + 1]), a1 = cvt_pk_bf16(P[BASE + 2], P[BASE + 3]);   \
    unsigned b0 = cvt_pk_bf16(P[BASE + 4], P[BASE + 5]), b1 = cvt_pk_bf16(P[BASE + 6], P[BASE + 7]);                              \
    auto r0 = __builtin_amdgcn_permlane32_swap(a0, b0, false, false); auto r1 = __builtin_amdgcn_permlane32_swap(a1, b1, false, false); \
    u32x4 w = {r0[0], r1[0], r0[1], r1[1]}; OUT = *reinterpret_cast<bf16x8*>(&w); } while (0)
    PK4(p0, 0, pa0); PK4(p0, 8, pa1); PK4(p1, 0, pa2); PK4(p1, 8, pa3);
#undef PK4
}
template <int ND0>
__device__ __forceinline__ void qkt(f32x16& p0, f32x16& p1, const LAS char* Ks, const bf16x8* qr, int r32, int hi, int dbase) {
    p0 = f32x16{}; p1 = f32x16{};
#pragma unroll
    for (int d0 = 0; d0 < ND0; ++d0) { const int cb = ((dbase + d0) * 16 + hi * 8) * 2;
        const bf16x8 b0 = *reinterpret_cast<const LAS bf16x8*>(Ks + KSWZ(r32, cb));
        const bf16x8 b1 = *reinterpret_cast<const LAS bf16x8*>(Ks + KSWZ(32 + r32, cb));
        p0 = __builtin_amdgcn_mfma_f32_32x32x16_bf16(b0, qr[d0], p0, 0, 0, 0);
        p1 = __builtin_amdgcn_mfma_f32_32x32x16_bf16(b1, qr[d0], p1, 0, 0, 0); }
}
__device__ __forceinline__ int v_st(int k, int c) { const int kk = (k & ~0xC) | ((k & 4) << 1) | ((k & 8) >> 1); return ((kk >> 3) * 4 + (c >> 5)) * 512 + ((kk & 7) * 32 + (c & 31)) * 2; }
__device__ __forceinline__ int v_rd_base(int lane) { return ((lane & 3) << 3) | (((lane >> 2) & 3) << 6) | (((lane >> 4) & 1) << 5) | (((lane >> 5) & 1) << 8); }
constexpr int v_rd_off(int d0, int ks, int half) { return d0 * 512 + ks * 4096 + half * 2048; }
template <int OFF> __device__ __forceinline__ s16x4 tr_read(int vb) {
    s16x4 r; asm volatile("ds_read_b64_tr_b16 %0, %1 offset:%2" : "=&v"(r) : "v"(vb), "i"(OFF) : "memory"); return r;
}
template <int D0> __device__ __forceinline__ void pv_one(f32x16& od, int vb, bf16x8 pa0, bf16x8 pa1, bf16x8 pa2, bf16x8 pa3) {
    const s16x4 l0 = tr_read<v_rd_off(D0, 0, 0)>(vb), h0 = tr_read<v_rd_off(D0, 0, 1)>(vb), l1 = tr_read<v_rd_off(D0, 1, 0)>(vb), h1 = tr_read<v_rd_off(D0, 1, 1)>(vb);
    const s16x4 l2 = tr_read<v_rd_off(D0, 2, 0)>(vb), h2 = tr_read<v_rd_off(D0, 2, 1)>(vb), l3 = tr_read<v_rd_off(D0, 3, 0)>(vb), h3 = tr_read<v_rd_off(D0, 3, 1)>(vb);
    asm volatile("s_waitcnt lgkmcnt(0)" ::: "memory"); SBAR();
#define PKV(L, H) (bf16x8){L[0], L[1], L[2], L[3], H[0], H[1], H[2], H[3]}
    od = __builtin_amdgcn_mfma_f32_32x32x16_bf16(pa0, PKV(l0, h0), od, 0, 0, 0);
    od = __builtin_amdgcn_mfma_f32_32x32x16_bf16(pa1, PKV(l1, h1), od, 0, 0, 0);
    od = __builtin_amdgcn_mfma_f32_32x32x16_bf16(pa2, PKV(l2, h2), od, 0, 0, 0);
    od = __builtin_amdgcn_mfma_f32_32x32x16_bf16(pa3, PKV(l3, h3), od, 0, 0, 0);
#undef PKV
}
__device__ __forceinline__ void pv_d0(f32x16* o, int vb, bf16x8 pa0, bf16x8 pa1, bf16x8 pa2, bf16x8 pa3) {
    pv_one<0>(o[0], vb, pa0, pa1, pa2, pa3); pv_one<1>(o[1], vb, pa0, pa1, pa2, pa3); pv_one<2>(o[2], vb, pa0, pa1, pa2, pa3); pv_one<3>(o[3], vb, pa0, pa1, pa2, pa3);
}

template <bool MLP>
__device__ __forceinline__ void final_pass(const LAS float* X, int nrows, const bf16_t* Z, bf16_t* Y, const float* g, float factor, const bf16_t* U, const float* rowb) {
    for (int idx = threadIdx.x; idx < nrows * 4; idx += 512) {
        const int row = idx >> 2, seg = idx & 3;
        f32x4 x[8];
#pragma unroll
        for (int i = 0; i < 8; ++i) x[i] = *reinterpret_cast<const LAS f32x4*>(X + row * XS + seg * 32 + 4 * i);
        if (MLP) { const float rb = rowb[row]; const u32x4* up = reinterpret_cast<const u32x4*>(U + (size_t)row * LDP + seg * 32);
#pragma unroll
            for (int i = 0; i < 4; ++i) { const u32x4 w = up[i];
                x[2 * i][0] = (x[2 * i][0] + rb) * bf_lo(w.x); x[2 * i][1] = (x[2 * i][1] + rb) * bf_hi(w.x); x[2 * i][2] = (x[2 * i][2] + rb) * bf_lo(w.y); x[2 * i][3] = (x[2 * i][3] + rb) * bf_hi(w.y);
                x[2 * i + 1][0] = (x[2 * i + 1][0] + rb) * bf_lo(w.z); x[2 * i + 1][1] = (x[2 * i + 1][1] + rb) * bf_hi(w.z); x[2 * i + 1][2] = (x[2 * i + 1][2] + rb) * bf_lo(w.w); x[2 * i + 1][3] = (x[2 * i + 1][3] + rb) * bf_hi(w.w); } }
        float ss = 0.f;
#pragma unroll
        for (int i = 0; i < 8; ++i) ss += (x[i][0] * x[i][0] + x[i][1] * x[i][1]) + (x[i][2] * x[i][2] + x[i][3] * x[i][3]);
        ss += __shfl_xor(ss, 1); ss += __shfl_xor(ss, 2);
        const float rstd = __builtin_amdgcn_rsqf(ss * (1.0f / 128.0f) + EPS) * factor;
        const u32x4* zp = reinterpret_cast<const u32x4*>(Z + (size_t)row * LDP + seg * 32);
        const f32x4* gp = reinterpret_cast<const f32x4*>(g + seg * 32);
        u32x4* yp = reinterpret_cast<u32x4*>(Y + (size_t)row * DM + seg * 32);
#pragma unroll
        for (int i = 0; i < 4; ++i) { const u32x4 w = zp[i]; const f32x4 g0 = gp[2 * i], g1 = gp[2 * i + 1]; const f32x4 a = x[2 * i], b = x[2 * i + 1];
            u32x4 o;
            o.x = cvt_pk_bf16(a[0] * rstd * g0[0] * silu_f(bf_lo(w.x)), a[1] * rstd * g0[1] * silu_f(bf_hi(w.x)));
            o.y = cvt_pk_bf16(a[2] * rstd * g0[2] * silu_f(bf_lo(w.y)), a[3] * rstd * g0[3] * silu_f(bf_hi(w.y)));
            o.z = cvt_pk_bf16(b[0] * rstd * g1[0] * silu_f(bf_lo(w.z)), b[1] * rstd * g1[1] * silu_f(bf_hi(w.z)));
            o.w = cvt_pk_bf16(b[2] * rstd * g1[2] * silu_f(bf_lo(w.w)), b[3] * rstd * g1[3] * silu_f(bf_hi(w.w)));
            yp[i] = o; }
    }
}

struct AttnArgs {
    const bf16_t* Q;
    const bf16_t *K1, *K2, *V1, *V2;
    int n1, n2, NT;
    int R0, kfirst;
    const float* rpb;
    const bf16_t* Z; bf16_t* Y; const float* g; float factor, lam;
};
template <int MODE>
__device__ __forceinline__ void attn_epilogue(LAS char* lds, const AttnArgs& a, f32x16 (&o)[4], float l_reg, LAS float* li_l, int map, int qg, int r32, int hi) {
    if (hi == 0) li_l[r32] = l_reg; asm volatile("s_waitcnt lgkmcnt(0)" ::: "memory");
    float rli[16];
#pragma unroll
    for (int r = 0; r < 16; ++r) rli[r] = __builtin_amdgcn_rcpf(li_l[crow(r, hi)]);
    __syncthreads();
    LAS float* X = (LAS float*)lds;
    if (MODE != 0 || map == 0) {
#pragma unroll
        for (int r = 0; r < 16; ++r)
#pragma unroll
            for (int d0 = 0; d0 < 4; ++d0) X[(qg * 32 + crow(r, hi)) * XS + d0 * 32 + r32] = o[d0][r] * rli[r];
    }
    __syncthreads();
    if (MODE == 0) {
        if (map == 1) {
#pragma unroll
            for (int r = 0; r < 16; ++r)
#pragma unroll
                for (int d0 = 0; d0 < 4; ++d0) { LAS float* xp = X + (qg * 32 + crow(r, hi)) * XS + d0 * 32 + r32; *xp = *xp - a.lam * (o[d0][r] * rli[r]); }
        }
        __syncthreads();
    }
    final_pass<false>(X, (MODE == 0) ? 128 : 256, a.Z, a.Y, a.g, a.factor, nullptr, nullptr);
    __syncthreads();
}
template <int MODE>
__device__ __forceinline__ void attn_unit(LAS char* lds, const AttnArgs& a) {
    constexpr int ND0 = (MODE == 0) ? 4 : 8;
    constexpr float SC = ModeC<MODE>::SC;
    int tid_ = threadIdx.x; asm volatile("" : "+v"(tid_));
    const int tid = tid_, wid = __builtin_amdgcn_readfirstlane(tid >> 6), lane = tid & 63, r32 = lane & 31, hi = lane >> 5;
    const int map = (MODE == 0) ? (wid >> 2) : 0, qg = (MODE == 0) ? (wid & 3) : wid;
    LAS char* V_lds = lds; LAS char* K_lds = lds + 2 * SHM_V;
    LAS float* wsf = (LAS float*)(lds + WSF_OFF) + wid * 64; LAS float* li_l = wsf; LAS float* al_l = wsf + 32;
    LAS float* bias_l = (LAS float*)(lds + BIAS_OFF);
    float m_reg = -1e30f, l_reg = 0; f32x16 o[4] = {}; bf16x8 qr[ND0];
    const bf16_t* Qw = a.Q + (size_t)(qg * 32 + r32) * LDP + map * 64 + hi * 8;
#pragma unroll
    for (int d0 = 0; d0 < ND0; ++d0) qr[d0] = ld8(Qw + d0 * 16);
    const int nr = a.R0 + (wid >> 1), nqc = 32 * (wid & 1) + r32;
    const int ncs = min(max(nqc - 8, 0), 48), nrs = min(max(nr - 4, 0), 56);
    if (MODE == 1) { if (tid < 465) bias_l[tid] = a.rpb[tid] * (1.0f / SC); }
    const int sr = tid >> 4, sc = (tid & 15) * 8, vst0 = v_st(sr, sc), vst1 = v_st(32 + sr, sc);
    const int vb0 = (int)(uintptr_t)V_lds + v_rd_base(lane);
    const int n1 = a.n1, n2 = a.n2, NT = a.NT;
    struct { bf16x8 vs0, vs1, ks0, ks1; } sr_[2];
#define TILE_PTRS(j) const int _j = (j); const int _j2 = min(_j - n1, n2 - 1); \
    const bf16_t* _Kt = (_j < n1) ? a.K1 + (size_t)_j * 64 * LDP : a.K2 + (size_t)_j2 * 64 * LDP; \
    const bf16_t* _Vt = (_j < n1) ? a.V1 + (size_t)_j * 64 * LDP : a.V2 + (size_t)_j2 * 64 * LDP;
#define SLOAD(i, j) do { TILE_PTRS(j); sr_[i].vs0 = ld8(_Vt + (size_t)sr * LDP + sc); sr_[i].vs1 = ld8(_Vt + (size_t)(32 + sr) * LDP + sc); \
    sr_[i].ks0 = ld8(_Kt + (size_t)sr * LDP + sc); sr_[i].ks1 = ld8(_Kt + (size_t)(32 + sr) * LDP + sc); } while (0)
#define SWRITE(b, i) do { *(LAS bf16x8*)(V_lds + (b) * SHM_V + vst0) = sr_[i].vs0; *(LAS bf16x8*)(V_lds + (b) * SHM_V + vst1) = sr_[i].vs1; const int kc = sc * 2; \
    *(LAS bf16x8*)(K_lds + (b) * SHM_K + KSWZ(sr, kc)) = sr_[i].ks0; *(LAS bf16x8*)(K_lds + (b) * SHM_K + KSWZ(32 + sr, kc)) = sr_[i].ks1; } while (0)
#define SWAIT() asm volatile("s_waitcnt vmcnt(4)" ::: "memory")
#define RESC(al) do { if (__any((al) < 1.f)) { if (hi == 0) al_l[r32] = (al); asm volatile("s_waitcnt lgkmcnt(0)" ::: "memory"); \
    _Pragma("unroll") for (int d = 0; d < 4; ++d) _Pragma("unroll") for (int r = 0; r < 16; ++r) o[d][r] *= al_l[crow(r, hi)]; } } while (0)
#define ACT(j) ((MODE != 1) ? true : (((j) < n1) ? ((a.kfirst + (j)) >= nrs && (a.kfirst + (j)) <= nrs + 7) : ((j) < n1 + n2)))
#define NAMASK(P0, P1, j) do { if (MODE == 1 && (j) < n1) { const int rel = (a.kfirst + (j)) - nr + 7; const LAS float* bl = bias_l + rel * 31 + 15 - nqc; \
    _Pragma("unroll") for (int r = 0; r < 16; ++r) { const int kc0 = crow(r, hi), kc1 = 32 + kc0; \
        const bool v0 = (unsigned)(kc0 - ncs) < 16u, v1 = (unsigned)(kc1 - ncs) < 16u; \
        const float bb0 = bl[min(max(kc0, nqc - 15), nqc + 15)], bb1 = bl[min(max(kc1, nqc - 15), nqc + 15)]; \
        P0[r] = v0 ? P0[r] + bb0 : -1e30f; P1[r] = v1 ? P1[r] + bb1 : -1e30f; } } } while (0)
    f32x16 pA0, pA1, pB0, pB1; float mnA = 0.f, mnB = 0.f, alA = 1.f, alB = 1.f; bf16x8 pa0, pa1, pa2, pa3;
    bool actA, actB;
    SLOAD(0, 0); asm volatile("s_waitcnt vmcnt(0)" ::: "memory"); SWRITE(0, 0); __syncthreads();
    actA = ACT(0);
    if (actA) { qkt<ND0>(pA0, pA1, K_lds, qr, r32, hi, map * 4); NAMASK(pA0, pA1, 0); partialSM<MODE>(pA0, pA1, m_reg, mnA, alA); } else { alA = 1.f; }
    SLOAD(1, 1); if (2 < NT) SLOAD(0, 2);
    SWAIT(); SWRITE(1, 1); __syncthreads();
    for (int j = 1; j + 1 < NT; j += 2) {
        actB = ACT(j);
        SBAR(); if (actB) { qkt<ND0>(pB0, pB1, K_lds + SHM_K, qr, r32, hi, map * 4); NAMASK(pB0, pB1, j); }
        if (actA) finishSM(pA0, pA1, alA, l_reg, pa0, pa1, pa2, pa3); SBAR();
        SLOAD(1, j + 2); SBAR();
        if (actA) pv_d0(o, vb0, pa0, pa1, pa2, pa3);
        if (actB) partialSM<MODE>(pB0, pB1, m_reg, mnB, alB); else alB = 1.f;
        __syncthreads(); SWAIT(); SWRITE(0, 0);
        RESC(alB); __syncthreads();
        actA = ACT(j + 1);
        SBAR(); if (actA) { qkt<ND0>(pA0, pA1, K_lds, qr, r32, hi, map * 4); NAMASK(pA0, pA1, j + 1); }
        if (actB) finishSM(pB0, pB1, alB, l_reg, pa0, pa1, pa2, pa3); SBAR();
        if (j + 3 < NT) SLOAD(0, j + 3); SBAR();
        if (actB) pv_d0(o, vb0 + SHM_V, pa0, pa1, pa2, pa3);
        if (actA) partialSM<MODE>(pA0, pA1, m_reg, mnA, alA); else alA = 1.f;
        __syncthreads(); SWAIT(); SWRITE(1, 1);
        RESC(alA); __syncthreads();
    }
    actB = ACT(NT - 1);
    SBAR(); if (actB) { qkt<ND0>(pB0, pB1, K_lds + SHM_K, qr, r32, hi, map * 4); NAMASK(pB0, pB1, NT - 1); }
    if (actA) finishSM(pA0, pA1, alA, l_reg, pa0, pa1, pa2, pa3); SBAR();
    if (actA) pv_d0(o, vb0, pa0, pa1, pa2, pa3);
    if (actB) partialSM<MODE>(pB0, pB1, m_reg, mnB, alB); else alB = 1.f;
    __syncthreads(); RESC(alB);
    if (actB) { finishSM(pB0, pB1, alB, l_reg, pa0, pa1, pa2, pa3); SBAR(); pv_d0(o, vb0 + SHM_V, pa0, pa1, pa2, pa3); }
    asm volatile("s_waitcnt vmcnt(0)" ::: "memory");
    attn_epilogue<MODE>(lds, a, o, l_reg, li_l, map, qg, r32, hi);
#undef TILE_PTRS
#undef SLOAD
#undef SWRITE
#undef SWAIT
#undef RESC
#undef ACT
#undef NAMASK
}

__device__ __forceinline__ void na_unit(LAS char* lds, const AttnArgs& a) {
    constexpr float SC = ModeC<1>::SC;
    int tid_ = threadIdx.x; asm volatile("" : "+v"(tid_));
    const int tid = tid_, wid = __builtin_amdgcn_readfirstlane(tid >> 6), lane = tid & 63, r32 = lane & 31, hi = lane >> 5;
    LAS char* V_lds = lds; LAS char* K_lds = lds + 2 * SHM_V;
    LAS float* wsf = (LAS float*)(lds + WSF_OFF) + wid * 64; LAS float* li_l = wsf; LAS float* al_l = wsf + 32;
    LAS float* bias_l = (LAS float*)(lds + BIAS_OFF);
    float m_reg = -1e30f, l_reg = 0; f32x16 o[4] = {}; bf16x8 qr[8];
    const bf16_t* Qw = a.Q + (size_t)(wid * 32 + r32) * LDP + hi * 8;
#pragma unroll
    for (int d0 = 0; d0 < 8; ++d0) qr[d0] = ld8(Qw + d0 * 16);
    const int nr = a.R0 + (wid >> 1), nqc = 32 * (wid & 1) + r32;
    const int ncs = min(max(nqc - 8, 0), 48), nrs = min(max(nr - 4, 0), 56);
    if (tid < 465) bias_l[tid] = a.rpb[tid] * (1.0f / SC);
    const int sr = tid >> 4, sc = (tid & 15) * 8, vst0 = v_st(sr, sc), vst1 = v_st(32 + sr, sc);
    const int vb0 = (int)(uintptr_t)V_lds + v_rd_base(lane);
    const int n1 = a.n1, NT = a.n1 + a.n2;
    bf16x8 vs0, vs1, ks0, ks1;
#define NA_SLOAD(j) do { const int _j = (j); const bf16_t* _Kt = (_j < n1) ? a.K1 + (size_t)_j * 64 * LDP : a.K2 + (size_t)(_j - n1) * 64 * LDP; \
    const bf16_t* _Vt = (_j < n1) ? a.V1 + (size_t)_j * 64 * LDP : a.V2 + (size_t)(_j - n1) * 64 * LDP; \
    vs0 = ld8(_Vt + (size_t)sr * LDP + sc); vs1 = ld8(_Vt + (size_t)(32 + sr) * LDP + sc); ks0 = ld8(_Kt + (size_t)sr * LDP + sc); ks1 = ld8(_Kt + (size_t)(32 + sr) * LDP + sc); } while (0)
    NA_SLOAD(0);
    for (int j = 0; j < NT; ++j) {
        const int buf = j & 1;
        { const int kc = sc * 2;
          *(LAS bf16x8*)(V_lds + buf * SHM_V + vst0) = vs0; *(LAS bf16x8*)(V_lds + buf * SHM_V + vst1) = vs1;
          *(LAS bf16x8*)(K_lds + buf * SHM_K + KSWZ(sr, kc)) = ks0; *(LAS bf16x8*)(K_lds + buf * SHM_K + KSWZ(32 + sr, kc)) = ks1; }
        if (j + 1 < NT) NA_SLOAD(j + 1);
        __syncthreads();
        const int kr = a.kfirst + j;
        const bool loc = j < n1;
        const bool act = loc ? (kr >= nrs && kr <= nrs + 7) : true;
        if (act) {
            f32x16 p0, p1; float mn, al; bf16x8 pa0, pa1, pa2, pa3;
            qkt<8>(p0, p1, K_lds + buf * SHM_K, qr, r32, hi, 0);
            if (loc) {
                const int rel = kr - nr + 7; const LAS float* bl = bias_l + rel * 31 + 15 - nqc;
#pragma unroll
                for (int r = 0; r < 16; ++r) { const int kc0 = crow(r, hi);
                    const bool v0 = (unsigned)(kc0 - ncs) < 16u; const float bb0 = bl[min(max(kc0, nqc - 15), nqc + 15)];
                    p0[r] = v0 ? p0[r] + bb0 : -1e30f; }
                asm volatile("" ::: "memory");
#pragma unroll
                for (int r = 0; r < 16; ++r) { const int kc1 = 32 + crow(r, hi);
                    const bool v1 = (unsigned)(kc1 - ncs) < 16u; const float bb1 = bl[min(max(kc1, nqc - 15), nqc + 15)];
                    p1[r] = v1 ? p1[r] + bb1 : -1e30f; }
            }
            partialSM<1>(p0, p1, m_reg, mn, al);
            if (__any(al < 1.f)) { if (hi == 0) al_l[r32] = al; asm volatile("s_waitcnt lgkmcnt(0)" ::: "memory");
#pragma unroll
                for (int d = 0; d < 4; ++d)
#pragma unroll
                    for (int r = 0; r < 16; ++r) o[d][r] *= al_l[crow(r, hi)]; }
            finishSM(p0, p1, al, l_reg, pa0, pa1, pa2, pa3);
            pv_d0(o, vb0 + buf * SHM_V, pa0, pa1, pa2, pa3);
        }
    }
#undef NA_SLOAD
    attn_epilogue<1>(lds, a, o, l_reg, li_l, 0, wid, r32, hi);
}

struct MlpArgs { const bf16_t* Prow; bf16_t* Yrow; const bf16_t* Wsb; const float *lng, *lnb, *bs, *mg; int g; };
__device__ __forceinline__ void mlp_unit(LAS char* lds, const MlpArgs& a) {
    int tid_ = threadIdx.x; asm volatile("" : "+v"(tid_));
    const int tid = tid_, wid = __builtin_amdgcn_readfirstlane(tid >> 6), lane = tid & 63, r32 = lane & 31, hi = lane >> 5;
    const int sr = tid >> 4, sc = (tid & 15) * 8, g = a.g;
    const f32x4 lg0 = *(const f32x4*)(a.lng + g * 128 + sc), lg1 = *(const f32x4*)(a.lng + g * 128 + sc + 4);
    const f32x4 lb0 = *(const f32x4*)(a.lnb + g * 128 + sc), lb1 = *(const f32x4*)(a.lnb + g * 128 + sc + 4);
#pragma unroll
    for (int t = 0; t < 4; ++t) {
        const int q = t * 32 + sr;
        const u32x4 w = *(const u32x4*)(a.Prow + (size_t)q * LDP + C_MV + g * 128 + sc);
        float v[8] = {bf_lo(w.x), bf_hi(w.x), bf_lo(w.y), bf_hi(w.y), bf_lo(w.z), bf_hi(w.z), bf_lo(w.w), bf_hi(w.w)};
        float s = 0.f;
#pragma unroll
        for (int e = 0; e < 8; ++e) s += v[e];
        s += __shfl_xor(s, 1); s += __shfl_xor(s, 2); s += __shfl_xor(s, 4); s += __shfl_xor(s, 8);
        const float mu = s * (1.0f / 128.0f); float qq = 0.f;
#pragma unroll
        for (int e = 0; e < 8; ++e) { v[e] -= mu; qq += v[e] * v[e]; }
        qq += __shfl_xor(qq, 1); qq += __shfl_xor(qq, 2); qq += __shfl_xor(qq, 4); qq += __shfl_xor(qq, 8);
        const float rstd = __builtin_amdgcn_rsqf(qq * (1.0f / 128.0f) + EPS);
        u32x4 ow;
        ow.x = cvt_pk_bf16(v[0] * rstd * lg0[0] + lb0[0], v[1] * rstd * lg0[1] + lb0[1]); ow.y = cvt_pk_bf16(v[2] * rstd * lg0[2] + lb0[2], v[3] * rstd * lg0[3] + lb0[3]);
        ow.z = cvt_pk_bf16(v[4] * rstd * lg1[0] + lb1[0], v[5] * rstd * lg1[1] + lb1[1]); ow.w = cvt_pk_bf16(v[6] * rstd * lg1[2] + lb1[2], v[7] * rstd * lg1[3] + lb1[3]);
        *(LAS u32x4*)(lds + (q >> 6) * SHM_V + v_st(q & 63, sc)) = ow;
    }
    const int prow0 = 32 * (wid & 3), dsel = wid >> 2;
    bf16x8 pa[8];
    const bf16_t* wp = a.Wsb + ((size_t)(g * 128 + prow0 + r32)) * 128 + 8 * hi;
#pragma unroll
    for (int s = 0; s < 8; ++s) pa[s] = ld8(wp + 16 * s);
    __syncthreads();
    f32x16 o0 = {}, o1 = {};
    const int vb0 = (int)(uintptr_t)lds + v_rd_base(lane);
    if (dsel == 0) { pv_one<0>(o0, vb0, pa[0], pa[1], pa[2], pa[3]); pv_one<1>(o1, vb0, pa[0], pa[1], pa[2], pa[3]);
                     pv_one<0>(o0, vb0 + SHM_V, pa[4], pa[5], pa[6], pa[7]); pv_one<1>(o1, vb0 + SHM_V, pa[4], pa[5], pa[6], pa[7]); }
    else           { pv_one<2>(o0, vb0, pa[0], pa[1], pa[2], pa[3]); pv_one<3>(o1, vb0, pa[0], pa[1], pa[2], pa[3]);
                     pv_one<2>(o0, vb0 + SHM_V, pa[4], pa[5], pa[6], pa[7]); pv_one<3>(o1, vb0 + SHM_V, pa[4], pa[5], pa[6], pa[7]); }
    __syncthreads();
    LAS float* X = (LAS float*)lds;
#pragma unroll
    for (int r = 0; r < 16; ++r) { X[(prow0 + crow(r, hi)) * XS + (2 * dsel) * 32 + r32] = o0[r]; X[(prow0 + crow(r, hi)) * XS + (2 * dsel + 1) * 32 + r32] = o1[r]; }
    __syncthreads();
    final_pass<true>(X, 128, a.Prow + C_MZ + g * 128, a.Yrow + 1536 + g * 128, a.mg + g * 128, 1.0f, a.Prow + C_MU + g * 128, a.bs + g * 128);
    __syncthreads();
}
}

__device__ __forceinline__ void p0_transpose_item(const float* W, int K, int N, bf16_t* WT, LAS float* scr, int item, int lane) {
    const int nblk = N / 32, kb = item / nblk, nb = item % nblk, k0 = 64 * kb, n0 = 32 * nb;
#pragma unroll 8
    for (int i = 0; i < 32; ++i) { const int kk = 2 * i + (lane >> 5); scr[kk * 33 + (lane & 31)] = W[(size_t)(k0 + kk) * N + n0 + (lane & 31)]; }
    asm volatile("s_waitcnt lgkmcnt(0)" ::: "memory");
    const int c = lane & 7;
#pragma unroll
    for (int j = 0; j < 4; ++j) { const int n = (lane >> 3) + 8 * j; const LAS float* s = scr + (8 * c) * 33 + n;
        u32x4 o; o.x = cvt_pk_bf16(s[0 * 33], s[1 * 33]); o.y = cvt_pk_bf16(s[2 * 33], s[3 * 33]); o.z = cvt_pk_bf16(s[4 * 33], s[5 * 33]); o.w = cvt_pk_bf16(s[6 * 33], s[7 * 33]);
        *(u32x4*)(WT + (size_t)(n0 + n) * K + k0 + 8 * c) = o; }
    asm volatile("s_waitcnt lgkmcnt(0)" ::: "memory");
}

__device__ __forceinline__ void phase0(const Params& p, LAS unsigned char* lds, int tid, int lane, int wave) {
    const int gw = blockIdx.x * 8 + wave, ngw = gridDim.x * 8;
    unsigned char* ws = p.ws;
    LAS float* scr = (LAS float*)(lds + wave * 16384);
    bf16_t* WinT = (bf16_t*)(ws + WS_WIN); bf16_t* WoutT = (bf16_t*)(ws + WS_WOUT);
    constexpr int I_IN = (DM / 64) * (INW / 32), I_OUT = (DM / 64) * (DM / 32), I_L = I_IN + I_OUT;
    for (int it = gw; it < 2 * I_L; it += ngw) {
        const int l = it / I_L, r = it % I_L;
        if (r < I_IN) p0_transpose_item(p.w_in + (size_t)l * DM * INW, DM, INW, WinT + (size_t)l * INW * DM, scr, r, lane);
        else p0_transpose_item(p.w_out + (size_t)l * DM * DM, DM, DM, WoutT + (size_t)l * DM * DM, scr, r - I_IN, lane);
    }
    float* mod = (float*)(ws + WS_CTL + CTL_MOD);
    for (int it = gw; it < 768; it += ngw) {
        const int l = it / 384, r = it % 384, kc = r / 24, nc = r % 24;
        const float* W = p.ada_w + (size_t)l * DM * 6144 + nc * 256 + lane * 4;
        f32x4 acc[5];
#pragma unroll
        for (int b = 0; b < 5; ++b) acc[b] = (f32x4){0.f, 0.f, 0.f, 0.f};
        for (int half = 0; half < 2; ++half) {
            const int k0 = kc * 128 + half * 64;
            float sv[5];
#pragma unroll
            for (int b = 0; b < 4; ++b) sv[b] = silu_f(p.c[b * DM + k0 + lane]);
            sv[4] = silu_f(p.c_ctx[k0 + lane]);
#pragma unroll 8
            for (int kk = 0; kk < 64; ++kk) {
                const f32x4 w4 = *(const f32x4*)(W + (size_t)(k0 + kk) * 6144);
#pragma unroll
                for (int b = 0; b < 5; ++b) { const float s = __uint_as_float(__builtin_amdgcn_readlane(__float_as_uint(sv[b]), kk)); acc[b] += w4 * s; }
            }
        }
        if (kc == 0) { const f32x4 bv = *(const f32x4*)(p.ada_b + l * 6144 + nc * 256 + lane * 4);
#pragma unroll
            for (int b = 0; b < 5; ++b) acc[b] += bv; }
#pragma unroll
        for (int b = 0; b < 5; ++b) { float* dst = mod + ((size_t)(l * 5 + b)) * 6144 + nc * 256 + lane * 4;
#pragma unroll
            for (int e = 0; e < 4; ++e) atomicAdd(dst + e, acc[b][e]); }
    }
    float* tab = (float*)(ws + WS_TAB);
    if (gw == ngw - 1) {
        for (int idx = lane; idx < 1024; idx += 64) { const int pos = idx >> 4, i = idx & 15;
            const float freq = powf(10000.0f, -(float)i / 16.0f); const float ang = (float)pos * freq;
            tab[idx] = cosf(ang); tab[1024 + idx] = sinf(ang); }
    }
    if (gw == ngw - 2) {
        for (int l = 0; l < 2; ++l) {
            const float s1 = wave_sum(p.lq1[l * 64 + lane] * p.lk1[l * 64 + lane]), s2 = wave_sum(p.lq2[l * 64 + lane] * p.lk2[l * 64 + lane]);
            const float lam_init = 0.8f - 0.6f * expf(-0.3f * (float)l);
            if (lane == 0) tab[2048 + l] = expf(s1) - expf(s2) + lam_init;
        }
    }
    { bf16_t* wsb = (bf16_t*)(ws + WS_WSB); const int gt = blockIdx.x * 512 + tid;
      if (gt < 16384) { const f32x4 a = *(const f32x4*)(p.mws + gt * 8), b = *(const f32x4*)(p.mws + gt * 8 + 4);
          u32x4 o; o.x = cvt_pk_bf16(a[0], a[1]); o.y = cvt_pk_bf16(a[2], a[3]); o.z = cvt_pk_bf16(b[0], b[1]); o.w = cvt_pk_bf16(b[2], b[3]); *(u32x4*)(wsb + gt * 8) = o; } }
}

template <int L>
__device__ __forceinline__ void norm_phase(const Params& p, int lane, int wave) {
    const int gw = blockIdx.x * 8 + wave, ngw = gridDim.x * 8;
    unsigned char* ws = p.ws;
    const float* mod = (const float*)(ws + WS_CTL + CTL_MOD);
    const float* rowss = (const float*)(ws + WS_CTL + CTL_ROWSS);
    const float* Yf = (const float*)(ws + WS_P);
    float* XC1 = (float*)(ws + WS_XC1);
    bf16_t* H = (bf16_t*)(ws + WS_H);
    const int nrows = (L == 0) ? MROWS : ((L == 1) ? MROWS : NLAT);
    for (int row = gw; row < nrows; row += ngw) {
        const bool isctx = row >= NLAT; const int b = isctx ? 4 : (row >> 12);
        const float* xin;
        if (L == 0) xin = isctx ? p.ctx + (size_t)(row - NLAT) * DM : p.x + (size_t)row * DM;
        else if (L == 1) xin = isctx ? p.ctx + (size_t)(row - NLAT) * DM : p.x + (size_t)row * DM;
        else xin = p.out + (size_t)row * DM;
        f32x4 v[8];
#pragma unroll
        for (int j = 0; j < 8; ++j) v[j] = *(const f32x4*)(xin + 4 * lane + 256 * j);
        if (L >= 1) {
            const int lp = L - 1;
            const float rs = __builtin_amdgcn_rsqf(rowss[lp * MROWS + row] * (1.0f / DM) + EPS);
            const float* gate = mod + ((size_t)(lp * 5 + b)) * 6144 + 4096;
            const float* pg = p.post_g + lp * DM;
            float* xo = (L == 2) ? p.out + (size_t)row * DM : (isctx ? XC1 + (size_t)(row - NLAT) * DM : p.out + (size_t)row * DM);
#pragma unroll
            for (int j = 0; j < 8; ++j) { const int cidx = 4 * lane + 256 * j;
                const f32x4 y = *(const f32x4*)(Yf + (size_t)row * DM + cidx), gt = *(const f32x4*)(gate + cidx), g4 = *(const f32x4*)(pg + cidx);
                v[j] = v[j] + gt * (y * rs) * g4;
                *(f32x4*)(xo + cidx) = v[j]; }
        }
        if (L <= 1) {
            float ss = 0.f;
#pragma unroll
            for (int j = 0; j < 8; ++j) ss += (v[j][0] * v[j][0] + v[j][1] * v[j][1]) + (v[j][2] * v[j][2] + v[j][3] * v[j][3]);
            ss = wave_sum(ss);
            const float rstd = __builtin_amdgcn_rsqf(ss * (1.0f / DM) + EPS);
            const float* shift = mod + ((size_t)(L * 5 + b)) * 6144; const float* scale = shift + 2048; const float* pg = p.pre_g + L * DM;
#pragma unroll
            for (int j = 0; j < 8; ++j) { const int cidx = 4 * lane + 256 * j;
                const f32x4 sh = *(const f32x4*)(shift + cidx), scv = *(const f32x4*)(scale + cidx), g4 = *(const f32x4*)(pg + cidx);
                const f32x4 hv = (v[j] * rstd) * g4 * (scv + 1.0f) + sh;
                u32x2 w; w.x = cvt_pk_bf16(hv[0], hv[1]); w.y = cvt_pk_bf16(hv[2], hv[3]);
                *(u32x2*)(H + (size_t)row * DM + cidx) = w; }
        }
    }
}

template <int L>
__device__ __forceinline__ void mixer_phase(const Params& p, LAS unsigned char* lds8, int tid) {
    LAS char* lds = (LAS char*)lds8;
    unsigned char* ws = p.ws;
    const bf16_t* P = (const bf16_t*)(ws + WS_P);
    bf16_t* Y = (bf16_t*)(ws + WS_H);
    const float* tab = (const float*)(ws + WS_TAB);
    const float lam = tab[2048 + L];
    const float lam_init = (L == 0) ? 0.2f : 0.35550906759096926f;
    unsigned* qctr = (unsigned*)(ws + WS_CTL + CTL_QCTR) + 64 * L;
    volatile LAS unsigned* misc = (volatile LAS unsigned*)(lds8 + MISC_OFF);
    constexpr int N_DIFF = NB * 6 * 32, N_NA = NB * 6 * 16, N_DIFFC = (L == 0) ? NB * 6 * 2 : 0, N_SMC = (L == 0) ? NB * 6 : 0, N_MLP = NB * 32 * 4, N_MLPC = (L == 0) ? NB * 2 * 4 : 0;
    constexpr int NU = N_DIFF + N_NA + N_DIFFC + N_SMC + N_MLP + N_MLPC;
#define PULL() do { if (tid == 0) misc[0] = atomicAdd(qctr, 1u); __syncthreads(); u = (int)misc[0]; __syncthreads(); } while (0)
    int u; PULL();
    constexpr int E_DIFF = N_DIFF, E_NA = E_DIFF + N_NA, E_DIFFC = E_NA + N_DIFFC, E_SMC = E_DIFFC + N_SMC;
    while ((UNIT_MASK & 1) && u < E_DIFF) {
        const int qb = u & 31, h = (u >> 5) % 6, b = u / 192;
        att::AttnArgs a{};
        const size_t t0 = (size_t)b * SEQ, tq = t0 + qb * 128, tc = (size_t)NLAT + b * CTXL;
        a.Q = P + tq * LDP + C_AQ + h * HD;
        a.K1 = P + t0 * LDP + C_AK + h * HD; a.K2 = P + tc * LDP + C_AK + h * HD;
        a.V1 = P + t0 * LDP + C_AV + h * HD; a.V2 = P + tc * LDP + C_AV + h * HD;
        a.n1 = 64; a.n2 = 4; a.NT = 68;
        a.Z = P + tq * LDP + C_AZ + h * HD; a.Y = Y + tq * DM + h * HD; a.g = p.da_g + L * HD; a.factor = 1.0f - lam_init; a.lam = lam;
        att::attn_unit<0>(lds, a);
        PULL();
    }
    while ((UNIT_MASK & 2) && u >= E_DIFF && u < E_NA) {
        const int v = u - E_DIFF; const int g4 = v & 15, h = (v >> 4) % 6, b = v / 96;
        att::AttnArgs a{};
        const int R0 = 4 * g4, kfirst = min(max(R0 - 4, 0), 56), klast = min(max(R0 - 1, 0), 56) + 7, nloc = klast - kfirst + 1;
        const size_t t0 = (size_t)b * SEQ, tq = t0 + R0 * 64, tk = t0 + kfirst * 64, tc = (size_t)NLAT + b * CTXL;
        a.Q = P + tq * LDP + C_NQ + h * HD;
        a.K1 = P + tk * LDP + C_NK + h * HD; a.K2 = P + tc * LDP + C_NK + h * HD;
        a.V1 = P + tk * LDP + C_NV + h * HD; a.V2 = P + tc * LDP + C_NV + h * HD;
        a.n1 = nloc; a.n2 = 4; a.NT = nloc + 4;
        a.R0 = R0; a.kfirst = kfirst; a.rpb = p.rpb + ((size_t)(L * 6 + h)) * 465;
        a.Z = P + tq * LDP + C_NZ + h * HD; a.Y = Y + tq * DM + 768 + h * HD; a.g = p.na_g + (L * 6 + h) * HD; a.factor = 1.0f; a.lam = 0.f;
        att::na_unit(lds, a);
        PULL();
    }
    while ((UNIT_MASK & 4) && L == 0 && u >= E_NA && u < E_DIFFC) {
        const int v = u - E_NA; const int qb = v & 1, h = (v >> 1) % 6, b = v / 12;
        att::AttnArgs a{};
        const size_t tc = (size_t)NLAT + b * CTXL, tq = tc + qb * 128;
        a.Q = P + tq * LDP + C_AQ + h * HD;
        a.K1 = P + tc * LDP + C_AK + h * HD; a.K2 = a.K1; a.V1 = P + tc * LDP + C_AV + h * HD; a.V2 = a.V1;
        a.n1 = 4; a.n2 = 1; a.NT = 4;
        a.Z = P + tq * LDP + C_AZ + h * HD; a.Y = Y + tq * DM + h * HD; a.g = p.da_g + L * HD; a.factor = 1.0f - lam_init; a.lam = lam;
        att::attn_unit<0>(lds, a);
        PULL();
    }
    while ((UNIT_MASK & 8) && L == 0 && u >= E_DIFFC && u < E_SMC) {
        const int v = u - E_DIFFC; const int h = v % 6, b = v / 6;
        att::AttnArgs a{};
        const size_t tc = (size_t)NLAT + b * CTXL;
        a.Q = P + tc * LDP + C_NQ + h * HD;
        a.K1 = P + tc * LDP + C_NK + h * HD; a.K2 = a.K1; a.V1 = P + tc * LDP + C_NV + h * HD; a.V2 = a.V1;
        a.n1 = 4; a.n2 = 1; a.NT = 4;
        a.Z = P + tc * LDP + C_NZ + h * HD; a.Y = Y + tc * DM + 768 + h * HD; a.g = p.na_g + (L * 6 + h) * HD; a.factor = 1.0f; a.lam = 0.f;
        att::attn_unit<2>(lds, a);
        PULL();
    }
    while ((UNIT_MASK & 16) && u >= E_SMC && u < NU) {
        const int v = u - E_SMC;
        att::MlpArgs m{};
        size_t t0;
        if (v < N_MLP) { const int g = v & 3, ch = (v >> 2) & 31, b = v >> 7; t0 = (size_t)b * SEQ + ch * 128; m.g = g; }
        else { const int w = v - N_MLP; const int g = w & 3, ch = (w >> 2) & 1, b = w >> 3; t0 = (size_t)NLAT + b * CTXL + ch * 128; m.g = g; }
        m.Prow = P + t0 * LDP; m.Yrow = Y + t0 * DM; m.Wsb = (const bf16_t*)(ws + WS_WSB) + (size_t)L * 4 * 128 * 128;
        m.lng = p.ln_g + L * 512; m.lnb = p.ln_b + L * 512; m.bs = p.mbs + L * 512; m.mg = p.mlp_g + L * 512;
        att::mlp_unit(lds, m);
        PULL();
    }
#undef PULL
}

#define XB_TMO      128
#define XB_XCNT(j)  (256  + 64 * (j))
#define XB_XSUB(j)  (1280 + 64 * (j))
#define XB_XGEN(j)  (2304 + 64 * (j))
#define XB_TOP      3328
#define XB_TOPGEN   3392
#define XCD_BAR_WORDS 3456
#define XB_SPIN_CAP (1u << 22)
__device__ __forceinline__ unsigned xb_ld(unsigned* p)              { return __hip_atomic_load(p, __ATOMIC_RELAXED, __HIP_MEMORY_SCOPE_AGENT); }
__device__ __forceinline__ unsigned xb_add(unsigned* p, unsigned v) { return __hip_atomic_fetch_add(p, v, __ATOMIC_RELAXED, __HIP_MEMORY_SCOPE_AGENT); }
__device__ __forceinline__ unsigned xb_xcc_id() { return (unsigned)__builtin_amdgcn_s_getreg((3 << 11) | 20) & 0xFu; }
#define XB_SPIN(cond, bar) do { unsigned _sp = 0; while (cond) { __builtin_amdgcn_s_sleep(1); \
    if ((++_sp & 255u) == 0u) { if (xb_ld(&(bar)[XB_TMO])) break; if (_sp > XB_SPIN_CAP) { atomicAdd(&(bar)[XB_TMO], 1u); break; } } } } while (0)
struct XcdBarrier { unsigned* bar; unsigned x; volatile LAS unsigned* st; };
__device__ __forceinline__ XcdBarrier xcd_barrier_post(unsigned* bar, volatile LAS unsigned* st) {
    XcdBarrier b; b.bar = bar; b.x = xb_xcc_id(); b.st = st;
    if (threadIdx.x == 0) (void)xb_add(&bar[XB_XCNT(b.x)], 1u);
    return b;
}
__device__ __forceinline__ void xcd_barrier_complete(unsigned* bar, unsigned x, unsigned& nloc, unsigned& nx) {
    const unsigned G = gridDim.x * gridDim.y * gridDim.z;
    unsigned sum, cnt, mine, sp = 0u;
    for (;;) {
        sum = 0u; cnt = 0u; mine = 0u;
#pragma unroll
        for (unsigned j = 0; j < 16; ++j) { const unsigned c = xb_ld(&bar[XB_XCNT(j)]); sum += c; cnt += (c > 0u) ? 1u : 0u; mine = (j == x) ? c : mine; }
        if (sum == G) break;
        __builtin_amdgcn_s_sleep(1);
        if ((++sp & 255u) == 0u) { if (xb_ld(&bar[XB_TMO])) break; if (sp > XB_SPIN_CAP) { atomicAdd(&bar[XB_TMO], 1u); break; } }
    }
    nloc = mine > 0u ? mine : 1u; nx = cnt > 0u ? cnt : 1u;
}
__device__ __forceinline__ void xcd_barrier(const XcdBarrier& b) {
    asm volatile("s_waitcnt vmcnt(0)" ::: "memory");
    __syncthreads();
    if (threadIdx.x == 0) {
        unsigned* bar = b.bar;
        __builtin_amdgcn_s_waitcnt(0);
        unsigned nloc = b.st[0], nx = b.st[1];
        if (nloc == 0u) { xcd_barrier_complete(bar, b.x, nloc, nx); b.st[0] = nloc; b.st[1] = nx; }
        const unsigned old = xb_add(&bar[XB_XSUB(b.x)], 1u);
        const unsigned gen = old / nloc;
        if (old + 1u == (gen + 1u) * nloc) {
            __builtin_amdgcn_fence(__ATOMIC_RELEASE, "agent");
            asm volatile("s_waitcnt vmcnt(0)" ::: "memory");
            const unsigned og = xb_add(&bar[XB_TOP], 1u);
            const unsigned tg = og / nx;
            if (og + 1u == (tg + 1u) * nx) xb_add(&bar[XB_TOPGEN], 1u);
            else XB_SPIN(xb_ld(&bar[XB_TOPGEN]) == tg, bar);
            __builtin_amdgcn_fence(__ATOMIC_ACQUIRE, "agent");
            xb_add(&bar[XB_XGEN(b.x)], 1u);
            asm volatile("s_waitcnt vmcnt(0)" ::: "memory");
        } else {
            XB_SPIN(xb_ld(&bar[XB_XGEN(b.x)]) == gen, bar);
            __builtin_amdgcn_fence(__ATOMIC_ACQUIRE, "agent");
            asm volatile("s_waitcnt vmcnt(0)" ::: "memory");
        }
    }
    __syncthreads();
}

__global__ void __launch_bounds__(512, 2) mega_fwd(Params p) {
    extern __shared__ __attribute__((aligned(16))) unsigned char lds_raw[];
    LAS unsigned char* lds = (LAS unsigned char*)lds_raw;
    cg::grid_group grid = cg::this_grid();
    const int tid = threadIdx.x, lane = tid & 63, wave = __builtin_amdgcn_readfirstlane(tid >> 6);
    unsigned char* ws = p.ws;
    const int lo = p.ph_lo, hi = p.ph_hi;
    volatile LAS unsigned* MISC = (volatile LAS unsigned*)(lds + MISC_OFF);
    if (tid < 64) MISC[tid] = 0u;
    __syncthreads();
    XcdBarrier bar = xcd_barrier_post((unsigned*)(ws + WS_CTL + CTL_BAR), MISC + 8);
#ifndef PH_MASK
#define PH_MASK 0x3ff
#endif
#define IN(k) (((PH_MASK >> (k)) & 1) && lo <= (k) && (k) < hi)
#define SEAM(k) do { if (IN(k) && IN((k) + 1)) { if ((k) == 0) grid.sync(); else xcd_barrier(bar); } } while (0)
    if (IN(0)) phase0(p, lds, tid, lane, wave);
    SEAM(0);
    if (IN(1)) norm_phase<0>(p, lane, wave);
    SEAM(1);
    if (IN(2)) { pg8::Gemm g{(const bf16_t*)(ws + WS_H), (const bf16_t*)(ws + WS_WIN), DM}; pg8::Sched S; S.init(68, 30, gridDim.x, blockIdx.x, 0);
        pg8::Epi1 E{(bf16_t*)(ws + WS_P), (const float*)(ws + WS_TAB), (const float*)(ws + WS_TAB) + 1024}; pg8::gemm_phase<pg8::Epi1>(lds, g, S, E); }
    SEAM(2);
    if (IN(3)) mixer_phase<0>(p, lds, tid);
    SEAM(3);
    if (IN(4)) { pg8::Gemm g{(const bf16_t*)(ws + WS_H), (const bf16_t*)(ws + WS_WOUT), DM}; pg8::Sched S; S.init(68, 8, gridDim.x, blockIdx.x, 0);
        pg8::Epi2 E{(float*)(ws + WS_P), (float*)(ws + WS_CTL + CTL_ROWSS)}; pg8::gemm_phase<pg8::Epi2>(lds, g, S, E); }
    SEAM(4);
    if (IN(5)) norm_phase<1>(p, lane, wave);
    SEAM(5);
    if (IN(6)) { pg8::Gemm g{(const bf16_t*)(ws + WS_H), (const bf16_t*)(ws + WS_WIN) + (size_t)INW * DM, DM}; pg8::Sched S; S.init(64, 30, gridDim.x, blockIdx.x, 48);
        pg8::Epi1 E{(bf16_t*)(ws + WS_P), (const float*)(ws + WS_TAB), (const float*)(ws + WS_TAB) + 1024}; pg8::gemm_phase<pg8::Epi1>(lds, g, S, E); }
    SEAM(6);
    if (IN(7)) mixer_phase<1>(p, lds, tid);
    SEAM(7);
    if (IN(8)) { pg8::Gemm g{(const bf16_t*)(ws + WS_H), (const bf16_t*)(ws + WS_WOUT) + (size_t)DM * DM, DM}; pg8::Sched S; S.init(64, 8, gridDim.x, blockIdx.x, 0);
        pg8::Epi2 E{(float*)(ws + WS_P), (float*)(ws + WS_CTL + CTL_ROWSS) + MROWS}; pg8::gemm_phase<pg8::Epi2>(lds, g, S, E); }
    SEAM(8);
    if (IN(9)) norm_phase<2>(p, lane, wave);
#undef IN
#undef SEAM
}

extern "C" void kernel_launch(void* const* d_in, const int* in_sizes, int n_in, void* d_out, int out_size, void* d_ws, size_t ws_size, hipStream_t stream) {
    static int grid = 0;
    if (grid == 0) {
        if (n_in != 22 || out_size != NLAT * DM || ws_size < WS_END) { fprintf(stderr, "kernel_launch: unexpected shapes (n_in %d out %d ws %zu)\n", n_in, out_size, ws_size); grid = -1; return; }
        int dev = 0, cus = 0, per_cu = 0;
        if (hipGetDevice(&dev) != hipSuccess || hipDeviceGetAttribute(&cus, hipDeviceAttributeMultiprocessorCount, dev) != hipSuccess) { grid = -1; return; }
        if (hipFuncSetAttribute((const void*)mega_fwd, hipFuncAttributeMaxDynamicSharedMemorySize, LDS_BYTES) != hipSuccess) { fprintf(stderr, "kernel_launch: hipFuncSetAttribute failed\n"); grid = -1; return; }
        if (hipOccupancyMaxActiveBlocksPerMultiprocessor(&per_cu, (const void*)mega_fwd, 512, LDS_BYTES) != hipSuccess || per_cu < 1) { fprintf(stderr, "kernel_launch: occupancy query says %d\n", per_cu); per_cu = 1; }
        (void)hipGetLastError();
        grid = cus * 1;
    }
    if (grid < 0) return;
    (void)hipMemsetAsync((char*)d_ws + WS_CTL, 0, CTL_BYTES, stream);
    Params p{};
    p.x = (const float*)d_in[0]; p.c = (const float*)d_in[1]; p.ctx = (const float*)d_in[2]; p.c_ctx = (const float*)d_in[3]; p.ada_w = (const float*)d_in[4]; p.ada_b = (const float*)d_in[5];
    p.pre_g = (const float*)d_in[6]; p.post_g = (const float*)d_in[7]; p.w_in = (const float*)d_in[8]; p.w_out = (const float*)d_in[9];
    p.lq1 = (const float*)d_in[10]; p.lk1 = (const float*)d_in[11]; p.lq2 = (const float*)d_in[12]; p.lk2 = (const float*)d_in[13];
    p.da_g = (const float*)d_in[14]; p.rpb = (const float*)d_in[15]; p.na_g = (const float*)d_in[16]; p.ln_g = (const float*)d_in[17]; p.ln_b = (const float*)d_in[18];
    p.mws = (const float*)d_in[19]; p.mbs = (const float*)d_in[20]; p.mlp_g = (const float*)d_in[21];
    p.out = (float*)d_out; p.ws = (unsigned char*)d_ws;
#if MK_SINGLE
    p.ph_lo = 0; p.ph_hi = 10;
    { void* args[] = {&p}; hipError_t e = hipLaunchCooperativeKernel((const void*)mega_fwd, dim3(grid), dim3(512), args, LDS_BYTES, stream);
      if (e != hipSuccess) fprintf(stderr, "kernel_launch: cooperative launch failed: %s (grid %d)\n", hipGetErrorString(e), grid); }
#else
    for (int ph = 0; ph < 10; ++ph) { p.ph_lo = ph; p.ph_hi = ph + 1; void* args[] = {&p};
        hipError_t e = hipLaunchCooperativeKernel((const void*)mega_fwd, dim3(grid), dim3(512), args, LDS_BYTES, stream);
        if (e != hipSuccess) { fprintf(stderr, "kernel_launch: launch %d failed: %s (grid %d)\n", ph, hipGetErrorString(e), grid); break; } }
#endif
}
```

```cpp
#include <hip/hip_runtime.h>
#include <hip/hip_cooperative_groups.h>
#include <cstdio>
#include <cstdint>
namespace cg = cooperative_groups;
#ifndef UNIT_MASK
#define UNIT_MASK 31
#endif

#ifndef MK_SINGLE
#define MK_SINGLE 1
#endif

#define LAS __attribute__((address_space(3)))
typedef unsigned short bf16_t;
typedef short bf16x8 __attribute__((ext_vector_type(8)));
typedef short s16x4 __attribute__((ext_vector_type(4)));
typedef float f32x2 __attribute__((ext_vector_type(2)));
typedef float f32x4 __attribute__((ext_vector_type(4)));
typedef float f32x8 __attribute__((ext_vector_type(8)));
typedef float f32x16 __attribute__((ext_vector_type(16)));
typedef unsigned u32x2 __attribute__((ext_vector_type(2)));
typedef unsigned u32x4 __attribute__((ext_vector_type(4)));

constexpr int DM = 2048, NB = 4, SEQ = 4096, CTXL = 256, NLAT = NB * SEQ, NCTX = NB * CTXL, MROWS = NLAT + NCTX;
constexpr int INW = 7680, LDP = INW, HD = 128;
constexpr int C_AQ = 0, C_AK = 768, C_AV = 1536, C_AZ = 2304, C_NQ = 3072, C_NK = 3840, C_NV = 4608, C_NZ = 5376, C_MU = 6144, C_MV = 6656, C_MZ = 7168;
constexpr float EPS = 1e-6f;
constexpr float LOG2E = 1.4426950408889634f;

constexpr size_t MiB = 1u << 20;
constexpr size_t WS_CTL = 0, CTL_BYTES = 1 * MiB;
constexpr size_t CTL_QCTR = 256;
constexpr size_t CTL_MOD = 4096;
constexpr size_t CTL_ROWSS = 262144;
constexpr size_t CTL_BAR = 524288;
constexpr size_t WS_TAB = 1 * MiB;
constexpr size_t WS_WSB = 1 * MiB + 65536;
constexpr size_t WS_WIN = 2 * MiB;
constexpr size_t WS_WOUT = 62 * MiB;
constexpr size_t WS_H = 78 * MiB;
constexpr size_t WS_XC1 = 146 * MiB;
constexpr size_t WS_P = 154 * MiB;
constexpr size_t WS_END = 409 * MiB;

constexpr int LDS_BYTES = 147456;
constexpr int MISC_OFF = 139264;

struct Params {
    const float *x, *c, *ctx, *c_ctx, *ada_w, *ada_b, *pre_g, *post_g, *w_in, *w_out, *lq1, *lk1, *lq2, *lk2, *da_g, *rpb, *na_g, *ln_g, *ln_b, *mws, *mbs, *mlp_g;
    float* out; unsigned char* ws; int ph_lo, ph_hi;
};

__device__ __forceinline__ unsigned cvt_pk_bf16(float lo, float hi) { unsigned r; asm volatile("v_cvt_pk_bf16_f32 %0, %1, %2" : "=v"(r) : "v"(lo), "v"(hi)); return r; }
__device__ __forceinline__ float bf_lo(unsigned w) { return __uint_as_float(w << 16); }
__device__ __forceinline__ float bf_hi(unsigned w) { return __uint_as_float(w & 0xffff0000u); }
__device__ __forceinline__ float wave_sum(float v) {
#pragma unroll
    for (int o = 1; o < 64; o <<= 1) v += __shfl_xor(v, o);
    return v;
}
__device__ __forceinline__ float silu_f(float z) { return z * __builtin_amdgcn_rcpf(1.0f + __builtin_amdgcn_exp2f(-z * LOG2E)); }
__device__ __forceinline__ float gelu_tanh(float x) {
    const float u = 0.7978845608028654f * (x + 0.044715f * x * x * x);
    return x * __builtin_amdgcn_rcpf(1.0f + __builtin_amdgcn_exp2f(-2.0f * LOG2E * u));
}

namespace pg8 {
constexpr int BM = 256, BK = 64, HALF = 128, HTB = HALF * BK * 2, STAGE_BYTES = 8 * HTB, NXCD = 8, WGM = 8;
__host__ __device__ __forceinline__ int lds_byte(int r, int c) { const int st = (r >> 4) * 2 + (c >> 5), rr = r & 15, cc = c & 31, ob = rr * 64 + cc * 2; return st * 1024 + (ob ^ (((ob >> 9) & 1) << 5)); }
__host__ __device__ __forceinline__ void stage_rc(int b, int& R, int& C) { const int st = b / 1024, sb = b % 1024, swz = sb ^ (((sb >> 9) & 1) << 5); R = (st >> 1) * 16 + swz / 64; C = (st & 1) * 32 + (swz % 64) / 2; }
__host__ __device__ __forceinline__ int perm32(int rho) { const int n = rho >> 4, i = rho & 15; return 8 * (i >> 2) + 4 * n + (i & 3); }

struct Unit { int pm, pn; };
struct Gemm { const bf16_t* A; const bf16_t* Bt; int K; };

struct Sched {
    int nM, nN, nwg, G, c, extra;
    __device__ void init(int nM_, int nN_, int G_, int c_, int extra_) { nM = nM_; nN = nN_; nwg = nM * nN; G = G_; c = c_; extra = extra_; }
    __device__ bool next(int i, Unit& u) const {
        const long L = (long)i * G + c;
        if (L < nwg) {
            int wgid = (int)L; { const int q = nwg / NXCD, r = nwg % NXCD, xcd = wgid % NXCD, off = wgid / NXCD; wgid = (xcd < r ? xcd * (q + 1) : r * (q + 1) + (xcd - r) * q) + off; }
            const int nig = WGM * nN, gid = wgid / nig, fm = gid * WGM, gsz = (nM - fm) < WGM ? (nM - fm) : WGM;
            u.pm = fm + ((wgid % nig) % gsz); u.pn = (wgid % nig) / gsz; return true;
        }
        const int e = (int)(L - nwg); if (e >= extra) return false;
        const int t = e >> 2; u.pm = 64 + (e & 3); u.pn = t < 6 ? 3 + t : 9 + t; return true;
    }
};

template <class Epi>
__device__ __forceinline__ void gemm_phase(LAS unsigned char* lds, const Gemm g, const Sched& S, const Epi& E) {
    const int tid = threadIdx.x, wid = __builtin_amdgcn_readfirstlane(tid >> 6), lane = tid & 63, wr = wid >> 2, wc = wid & 3, fr = lane & 15, fq = lane >> 4;
    const int K = g.K, nt = K / BK;
    unsigned voffA[2], voffB[2];
#pragma unroll
    for (int i = 0; i < 2; ++i) { int R, C; stage_rc(tid * 16 + i * 8192, R, C); const int Rb = Epi::PERM ? ((R & ~31) + perm32(R & 31)) : R;
        voffA[i] = (unsigned)(R * K + C) * 2u; voffB[i] = (unsigned)(Rb * K + C) * 2u; }
    const size_t kstep = (size_t)(BK * 2);
    const size_t hstep = (size_t)HALF * K * 2;
    const size_t tstep = 2 * hstep;
    const unsigned ldsw = (unsigned)wid * 1024u;
    const int aoff = lds_byte(wr * 64 + fr, fq * 8), boff = lds_byte(wc * 32 + fr, fq * 8);
#define PG8_SA(b, h) (((b) * 2 + (h)) * HTB)
#define PG8_SB(b, h) ((4 + (b) * 2 + (h)) * HTB)
#define PG8_STAGE(bufoff, gbase, voff) do { _Pragma("unroll") for (int _i = 0; _i < 2; ++_i) \
        __builtin_amdgcn_global_load_lds((const unsigned*)((const char*)(gbase) + (voff)[_i]), (LAS unsigned*)(lds + (bufoff) + ldsw + _i * 8192), 16, 0, 0); } while (0)
#define PG8_LDA(dst, b, h) do { _Pragma("unroll") for (int m = 0; m < 4; ++m) _Pragma("unroll") for (int k = 0; k < 2; ++k) dst[m][k] = *(const LAS bf16x8*)(lds + PG8_SA(b, h) + aoff + m * 2048 + k * 1024); } while (0)
#define PG8_LDB(dst, b, h) do { _Pragma("unroll") for (int n = 0; n < 2; ++n) _Pragma("unroll") for (int k = 0; k < 2; ++k) dst[n][k] = *(const LAS bf16x8*)(lds + PG8_SB(b, h) + boff + n * 2048 + k * 1024); } while (0)
#define PG8_MMA(ai, bj, At, Bt) do { __builtin_amdgcn_s_setprio(1); _Pragma("unroll") for (int m = 0; m < 4; ++m) _Pragma("unroll") for (int n = 0; n < 2; ++n) _Pragma("unroll") for (int k = 0; k < 2; ++k) \
        acc[ai][bj][m][n] = __builtin_amdgcn_mfma_f32_16x16x32_bf16(Bt[n][k], At[m][k], acc[ai][bj][m][n], 0, 0, 0); __builtin_amdgcn_s_setprio(0); } while (0)
#define PG8_WAIT_V(n) asm volatile("s_waitcnt vmcnt(" #n ")" ::: "memory")
#define PG8_WAIT_L(n) asm volatile("s_waitcnt lgkmcnt(" #n ")" ::: "memory")
#define PG8_BAR __builtin_amdgcn_s_barrier()
#define PG8_SCHED __builtin_amdgcn_sched_barrier(0)
    Unit cur, nxt; int ui = 0;
    if (!S.next(0, cur)) return;
    f32x4 acc[2][2][4][2];
#pragma unroll
    for (int a = 0; a < 2; ++a)
#pragma unroll
        for (int b = 0; b < 2; ++b)
#pragma unroll
            for (int m = 0; m < 4; ++m)
#pragma unroll
                for (int n = 0; n < 2; ++n) acc[a][b][m][n] = (f32x4){0.f, 0.f, 0.f, 0.f};
    bf16x8 At[4][2], B0[2][2], B1[2][2];
    const char* cA = (const char*)g.A + (size_t)cur.pm * tstep; const char* cB = (const char*)g.Bt + (size_t)cur.pn * tstep;
    PG8_STAGE(PG8_SB(0, 0), cB, voffB); PG8_STAGE(PG8_SB(0, 1), cB + hstep, voffB); PG8_STAGE(PG8_SA(0, 0), cA, voffA); PG8_STAGE(PG8_SA(0, 1), cA + hstep, voffA);
    if (wr == 1) PG8_BAR;
    PG8_WAIT_V(2); PG8_BAR;
    PG8_STAGE(PG8_SB(1, 0), cB + kstep, voffB); PG8_STAGE(PG8_SA(1, 0), cA + kstep, voffA); PG8_STAGE(PG8_SB(1, 1), cB + hstep + kstep, voffB);
    PG8_WAIT_V(6); PG8_BAR;
    for (;;) {
        const bool has_next = S.next(ui + 1, nxt);
        const char* nA = has_next ? (const char*)g.A + (size_t)nxt.pm * tstep : cA; const char* nB = has_next ? (const char*)g.Bt + (size_t)nxt.pn * tstep : cB;
        for (int t = 0; t < nt; t += 2) {
            const bool last = (t == nt - 2);
            const char* a1 = cA + (size_t)(t + 1) * kstep;
            const char* a2 = last ? nA : cA + (size_t)(t + 2) * kstep; const char* b2 = last ? nB : cB + (size_t)(t + 2) * kstep;
            const char* a3 = a2 + kstep; const char* b3 = b2 + kstep;
            PG8_LDB(B0, 0, 0); PG8_LDB(B1, 0, 1); PG8_SCHED; PG8_LDA(At, 0, 0); PG8_STAGE(PG8_SA(1, 1), a1 + hstep, voffA);
            PG8_WAIT_V(8); PG8_WAIT_L(0); PG8_BAR; PG8_MMA(0, 0, At, B0); PG8_MMA(0, 1, At, B1); PG8_BAR; PG8_SCHED;
            PG8_LDA(At, 0, 1); PG8_STAGE(PG8_SB(0, 0), b2, voffB); PG8_STAGE(PG8_SB(0, 1), b2 + hstep, voffB); PG8_STAGE(PG8_SA(0, 0), a2, voffA);
            PG8_WAIT_V(8); PG8_WAIT_L(0); PG8_BAR; PG8_MMA(1, 0, At, B0); PG8_MMA(1, 1, At, B1); PG8_BAR; PG8_SCHED;
            PG8_LDB(B0, 1, 0); PG8_LDB(B1, 1, 1); PG8_SCHED; PG8_LDA(At, 1, 0); PG8_STAGE(PG8_SA(0, 1), a2 + hstep, voffA);
            PG8_WAIT_V(8); PG8_WAIT_L(0); PG8_BAR; PG8_MMA(0, 0, At, B0); PG8_MMA(0, 1, At, B1); PG8_BAR; PG8_SCHED;
            PG8_LDA(At, 1, 1); PG8_STAGE(PG8_SB(1, 0), b3, voffB); PG8_STAGE(PG8_SB(1, 1), b3 + hstep, voffB); PG8_STAGE(PG8_SA(1, 0), a3, voffA);
            PG8_WAIT_V(8); PG8_WAIT_L(0); PG8_BAR; PG8_MMA(1, 0, At, B0); PG8_MMA(1, 1, At, B1); PG8_BAR; PG8_SCHED;
        }
        if (wr == 0) PG8_BAR;
        E(acc, cur, wr, wc, fr, fq);
        if (!has_next) break;
#pragma unroll
        for (int a = 0; a < 2; ++a)
#pragma unroll
            for (int b = 0; b < 2; ++b)
#pragma unroll
                for (int m = 0; m < 4; ++m)
#pragma unroll
                    for (int n = 0; n < 2; ++n) acc[a][b][m][n] = (f32x4){0.f, 0.f, 0.f, 0.f};
        cur = nxt; cA = nA; cB = nB; ++ui;
        if (wr == 1) PG8_BAR;
    }
    PG8_WAIT_V(0);
    PG8_BAR;
#undef PG8_SA
#undef PG8_SB
#undef PG8_STAGE
#undef PG8_LDA
#undef PG8_LDB
#undef PG8_MMA
#undef PG8_WAIT_V
#undef PG8_WAIT_L
#undef PG8_BAR
#undef PG8_SCHED
}

struct Epi1 {
    static constexpr bool PERM = true;
    bf16_t* O; const float* cs; const float* sn;
    __device__ __forceinline__ void operator()(const f32x4 (&acc)[2][2][4][2], const Unit& u, int wr, int wc, int fr, int fq) const {
        const int row0 = u.pm * BM + wr * 64 + fr, col0 = u.pn * BM + wc * 32 + 8 * fq;
        const bool rope = (u.pn < 6) && (u.pm < 64), gelu = (u.pn >= 24) && (u.pn < 28);
        const float sgn = (fq < 2) ? -1.f : 1.f;
#pragma unroll
        for (int ai = 0; ai < 2; ++ai)
#pragma unroll
            for (int m = 0; m < 4; ++m) {
                const int row = row0 + ai * HALF + m * 16;
                bf16_t* rowp = O + (size_t)row * LDP + col0;
                f32x4 c0 = {1.f, 1.f, 1.f, 1.f}, c1 = c0, s0 = {0.f, 0.f, 0.f, 0.f}, s1 = s0;
                if (rope) { const int s = row & (SEQ - 1); const int pos = (wc & 1) ? (s & 63) : (s >> 6); const int ti = pos * 16 + 8 * (fq & 1);
                    c0 = *(const f32x4*)(cs + ti); c1 = *(const f32x4*)(cs + ti + 4); s0 = *(const f32x4*)(sn + ti); s1 = *(const f32x4*)(sn + ti + 4);
                    s0 = s0 * sgn; s1 = s1 * sgn; }
#pragma unroll
                for (int bj = 0; bj < 2; ++bj) { f32x4 v0 = acc[ai][bj][m][0], v1 = acc[ai][bj][m][1];
                    if (rope) { f32x4 q0, q1;
#pragma unroll
                        for (int e = 0; e < 4; ++e) { q0[e] = __shfl_xor(v0[e], 32); q1[e] = __shfl_xor(v1[e], 32); }
                        v0 = v0 * c0 + q0 * s0; v1 = v1 * c1 + q1 * s1; }
                    if (gelu) {
#pragma unroll
                        for (int e = 0; e < 4; ++e) { v0[e] = gelu_tanh(v0[e]); v1[e] = gelu_tanh(v1[e]); } }
                    u32x4 w; w.x = cvt_pk_bf16(v0[0], v0[1]); w.y = cvt_pk_bf16(v0[2], v0[3]); w.z = cvt_pk_bf16(v1[0], v1[1]); w.w = cvt_pk_bf16(v1[2], v1[3]);
                    *(u32x4*)(rowp + bj * HALF) = w; } }
    }
};
struct Epi2 {
    static constexpr bool PERM = false;
    float* Yf; float* rowss;
    __device__ __forceinline__ void operator()(const f32x4 (&acc)[2][2][4][2], const Unit& u, int wr, int wc, int fr, int fq) const {
        const int row0 = u.pm * BM + wr * 64 + fr, col0 = u.pn * BM + wc * 32 + 4 * fq;
#pragma unroll
        for (int ai = 0; ai < 2; ++ai)
#pragma unroll
            for (int m = 0; m < 4; ++m) { const int row = row0 + ai * HALF + m * 16; float* rowp = Yf + (size_t)row * DM + col0; float ss = 0.f;
#pragma unroll
                for (int bj = 0; bj < 2; ++bj)
#pragma unroll
                    for (int n = 0; n < 2; ++n) { const f32x4 v = acc[ai][bj][m][n]; *(f32x4*)(rowp + bj * HALF + n * 16) = v; ss += (v[0] * v[0] + v[1] * v[1]) + (v[2] * v[2] + v[3] * v[3]); }
                ss += __shfl_xor(ss, 16); ss += __shfl_xor(ss, 32);
                if (fq == 0) atomicAdd(rowss + row, ss); }
    }
};
}

namespace att {
constexpr int SHM_V = 64 * 128 * 2, SHM_K = 64 * 128 * 2;
constexpr int WSF_OFF = 2 * SHM_V + 2 * SHM_K;
constexpr int BIAS_OFF = WSF_OFF + 2048;
constexpr int XS = 132;
constexpr float THR = 8.f;
#define KSWZ(row, colB) ((row) * 256 + ((colB) ^ (((row) & 7) << 4)))
#define SBAR() __builtin_amdgcn_sched_barrier(0)
__device__ __forceinline__ int crow(int r, int hi) { return (r & 3) + 8 * (r >> 2) + 4 * hi; }
__device__ __forceinline__ bf16x8 ld8(const bf16_t* p) { return *reinterpret_cast<const bf16x8*>(p); }

template <int MODE> struct ModeC { static constexpr float SC = (MODE == 0) ? 0.125f : 0.08838834764831845f; };

template <int MODE>
__device__ __forceinline__ void partialSM(f32x16& p0, f32x16& p1, float& m_reg, float& mn, float& alpha) {
    constexpr float C = ModeC<MODE>::SC * LOG2E;
    float pmax = p0[0];
#pragma unroll
    for (int r = 1; r < 16; ++r) pmax = fmaxf(pmax, p0[r]);
#pragma unroll
    for (int r = 0; r < 16; ++r) pmax = fmaxf(pmax, p1[r]);
    { auto rr = __builtin_amdgcn_permlane32_swap(__float_as_uint(pmax), __float_as_uint(pmax), false, false);
      pmax = fmaxf(__uint_as_float(rr[0]), __uint_as_float(rr[1])); }
    if (__builtin_expect(__all(pmax - m_reg <= THR / ModeC<MODE>::SC), 1)) { mn = m_reg; alpha = 1.f; }
    else { mn = fmaxf(m_reg, pmax); alpha = __builtin_amdgcn_exp2f((m_reg - mn) * C); m_reg = mn; }
    const float mnC = -mn * C;
#pragma unroll
    for (int r = 0; r < 16; ++r) p0[r] = fmaf(p0[r], C, mnC);
#pragma unroll
    for (int r = 0; r < 16; ++r) p1[r] = fmaf(p1[r], C, mnC);
#pragma unroll
    for (int r = 0; r < 16; ++r) p0[r] = __builtin_amdgcn_exp2f(p0[r]);
}
__device__ __forceinline__ void finishSM(f32x16& p0, f32x16& p1, float alpha, float& l_reg, bf16x8& pa0, bf16x8& pa1, bf16x8& pa2, bf16x8& pa3) {
#pragma unroll
    for (int r = 0; r < 16; ++r) p1[r] = __builtin_amdgcn_exp2f(p1[r]);
    float ps = 0;
#pragma unroll
    for (int r = 0; r < 16; ++r) ps += p0[r];
#pragma unroll
    for (int r = 0; r < 16; ++r) ps += p1[r];
    { auto rr = __builtin_amdgcn_permlane32_swap(__float_as_uint(ps), __float_as_uint(ps), false, false);
      ps = __uint_as_float(rr[0]) + __uint_as_float(rr[1]); }
    l_reg = l_reg * alpha + ps;
#define PK4(P, BASE, OUT) do { unsigned a0 = cvt_pk_bf16(P[BASE + 0], P[BASE + 1]), a1 = cvt_pk_bf16(P[BASE + 2], P[BASE + 3]);   \
    unsigned b0 = cvt_pk_bf16(P[BASE + 4], P[BASE + 5]), b1 = cvt_pk_bf16(P[BASE + 6], P[BASE + 7]);                              \
    auto r0 = __builtin_amdgcn_permlane32_swap(a0, b0, false, false); auto r1 = __builtin_amdgcn_permlane32_swap(a1, b1, false, false); \
    u32x4 w = {r0[0], r1[0], r0[1], r1[1]}; OUT = *reinterpret_cast<bf16x8*>(&w); } while (0)
    PK4(p0, 0, pa0); PK4(p0, 8, pa1); PK4(p1, 0, pa2); PK4(p1, 8, pa3);
#undef PK4
}
template <int ND0>
__device__ __forceinline__ void qkt(f32x16& p0, f32x16& p1, const LAS char* Ks, const bf16x8* qr, int r32, int hi, int dbase) {
    p0 = f32x16{}; p1 = f32x16{};
#pragma unroll
    for (int d0 = 0; d0 < ND0; ++d0) { const int cb = ((dbase + d0) * 16 + hi * 8) * 2;
        const bf16x8 b0 = *reinterpret_cast<const LAS bf16x8*>(Ks + KSWZ(r32, cb));
        const bf16x8 b1 = *reinterpret_cast<const LAS bf16x8*>(Ks + KSWZ(32 + r32, cb));
        p0 = __builtin_amdgcn_mfma_f32_32x32x16_bf16(b0, qr[d0], p0, 0, 0, 0);
        p1 = __builtin_amdgcn_mfma_f32_32x32x16_bf16(b1, qr[d0], p1, 0, 0, 0); }
}
__device__ __forceinline__ int v_st(int k, int c) { const int kk = (k & ~0xC) | ((k & 4) << 1) | ((k & 8) >> 1); return ((kk >> 3) * 4 + (c >> 5)) * 512 + ((kk & 7) * 32 + (c & 31)) * 2; }
__device__ __forceinline__ int v_rd_base(int lane) { return ((lane & 3) << 3) | (((lane >> 2) & 3) << 6) | (((lane >> 4) & 1) << 5) | (((lane >> 5) & 1) << 8); }
constexpr int v_rd_off(int d0, int ks, int half) { return d0 * 512 + ks * 4096 + half * 2048; }
template <int OFF> __device__ __forceinline__ s16x4 tr_read(int vb) {
    s16x4 r; asm volatile("ds_read_b64_tr_b16 %0, %1 offset:%2" : "=&v"(r) : "v"(vb), "i"(OFF) : "memory"); return r;
}
template <int D0> __device__ __forceinline__ void pv_one(f32x16& od, int vb, bf16x8 pa0, bf16x8 pa1, bf16x8 pa2, bf16x8 pa3) {
    const s16x4 l0 = tr_read<v_rd_off(D0, 0, 0)>(vb), h0 = tr_read<v_rd_off(D0, 0, 1)>(vb), l1 = tr_read<v_rd_off(D0, 1, 0)>(vb), h1 = tr_read<v_rd_off(D0, 1, 1)>(vb);
    const s16x4 l2 = tr_read<v_rd_off(D0, 2, 0)>(vb), h2 = tr_read<v_rd_off(D0, 2, 1)>(vb), l3 = tr_read<v_rd_off(D0, 3, 0)>(vb), h3 = tr_read<v_rd_off(D0, 3, 1)>(vb);
    asm volatile("s_waitcnt lgkmcnt(0)" ::: "memory"); SBAR();
#define PKV(L, H) (bf16x8){L[0], L[1], L[2], L[3], H[0], H[1], H[2], H[3]}
    od = __builtin_amdgcn_mfma_f32_32x32x16_bf16(pa0, PKV(l0, h0), od, 0, 0, 0);
    od = __builtin_amdgcn_mfma_f32_32x32x16_bf16(pa1, PKV(l1, h1), od, 0, 0, 0);
    od = __builtin_amdgcn_mfma_f32_32x32x16_bf16(pa2, PKV(l2, h2), od, 0, 0, 0);
    od = __builtin_amdgcn_mfma_f32_32x32x16_bf16(pa3, PKV(l3, h3), od, 0, 0, 0);
#undef PKV
}
__device__ __forceinline__ void pv_d0(f32x16* o, int vb, bf16x8 pa0, bf16x8 pa1, bf16x8 pa2, bf16x8 pa3) {
    pv_one<0>(o[0], vb, pa0, pa1, pa2, pa3); pv_one<1>(o[1], vb, pa0, pa1, pa2, pa3); pv_one<2>(o[2], vb, pa0, pa1, pa2, pa3); pv_one<3>(o[3], vb, pa0, pa1, pa2, pa3);
}

template <bool MLP>
__device__ __forceinline__ void final_pass(const LAS float* X, int nrows, const bf16_t* Z, bf16_t* Y, const float* g, float factor, const bf16_t* U, const float* rowb) {
    for (int idx = threadIdx.x; idx < nrows * 4; idx += 512) {
        const int row = idx >> 2, seg = idx & 3;
        f32x4 x[8];
#pragma unroll
        for (int i = 0; i < 8; ++i) x[i] = *reinterpret_cast<const LAS f32x4*>(X + row * XS + seg * 32 + 4 * i);
        if (MLP) { const float rb = rowb[row]; const u32x4* up = reinterpret_cast<const u32x4*>(U + (size_t)row * LDP + seg * 32);
#pragma unroll
            for (int i = 0; i < 4; ++i) { const u32x4 w = up[i];
                x[2 * i][0] = (x[2 * i][0] + rb) * bf_lo(w.x); x[2 * i][1] = (x[2 * i][1] + rb) * bf_hi(w.x); x[2 * i][2] = (x[2 * i][2] + rb) * bf_lo(w.y); x[2 * i][3] = (x[2 * i][3] + rb) * bf_hi(w.y);
                x[2 * i + 1][0] = (x[2 * i + 1][0] + rb) * bf_lo(w.z); x[2 * i + 1][1] = (x[2 * i + 1][1] + rb) * bf_hi(w.z); x[2 * i + 1][2] = (x[2 * i + 1][2] + rb) * bf_lo(w.w); x[2 * i + 1][3] = (x[2 * i + 1][3] + rb) * bf_hi(w.w); } }
        float ss = 0.f;
#pragma unroll
        for (int i = 0; i < 8; ++i) ss += (x[i][0] * x[i][0] + x[i][1] * x[i][1]) + (x[i][2] * x[i][2] + x[i][3] * x[i][3]);
        ss += __shfl_xor(ss, 1); ss += __shfl_xor(ss, 2);
        const float rstd = __builtin_amdgcn_rsqf(ss * (1.0f / 128.0f) + EPS) * factor;
        const u32x4* zp = reinterpret_cast<const u32x4*>(Z + (size_t)row * LDP + seg * 32);
        const f32x4* gp = reinterpret_cast<const f32x4*>(g + seg * 32);
        u32x4* yp = reinterpret_cast<u32x4*>(Y + (size_t)row * DM + seg * 32);
#pragma unroll
        for (int i = 0; i < 4; ++i) { const u32x4 w = zp[i]; const f32x4 g0 = gp[2 * i], g1 = gp[2 * i + 1]; const f32x4 a = x[2 * i], b = x[2 * i + 1];
            u32x4 o;
            o.x = cvt_pk_bf16(a[0] * rstd * g0[0] * silu_f(bf_lo(w.x)), a[1] * rstd * g0[1] * silu_f(bf_hi(w.x)));
            o.y = cvt_pk_bf16(a[2] * rstd * g0[2] * silu_f(bf_lo(w.y)), a[3] * rstd * g0[3] * silu_f(bf_hi(w.y)));
            o.z = cvt_pk_bf16(b[0] * rstd * g1[0] * silu_f(bf_lo(w.z)), b[1] * rstd * g1[1] * silu_f(bf_hi(w.z)));
            o.w = cvt_pk_bf16(b[2] * rstd * g1[2] * silu_f(bf_lo(w.w)), b[3] * rstd * g1[3] * silu_f(bf_hi(w.w)));
            yp[i] = o; }
    }
}

struct AttnArgs {
    const bf16_t* Q;
    const bf16_t *K1, *K2, *V1, *V2;
    int n1, n2, NT;
    int R0, kfirst;
    const float* rpb;
    const bf16_t* Z; bf16_t* Y; const float* g; float factor, lam;
};
template <int MODE>
__device__ __forceinline__ void attn_epilogue(LAS char* lds, const AttnArgs& a, f32x16 (&o)[4], float l_reg, LAS float* li_l, int map, int qg, int r32, int hi) {
    if (hi == 0) li_l[r32] = l_reg; asm volatile("s_waitcnt lgkmcnt(0)" ::: "memory");
    float rli[16];
#pragma unroll
    for (int r = 0; r < 16; ++r) rli[r] = __builtin_amdgcn_rcpf(li_l[crow(r, hi)]);
    __syncthreads();
    LAS float* X = (LAS float*)lds;
    if (MODE != 0 || map == 0) {
#pragma unroll
        for (int r = 0; r < 16; ++r)
#pragma unroll
            for (int d0 = 0; d0 < 4; ++d0) X[(qg * 32 + crow(r, hi)) * XS + d0 * 32 + r32] = o[d0][r] * rli[r];
    }
    __syncthreads();
    if (MODE == 0) {
        if (map == 1) {
#pragma unroll
            for (int r = 0; r < 16; ++r)
#pragma unroll
                for (int d0 = 0; d0 < 4; ++d0) { LAS float* xp = X + (qg * 32 + crow(r, hi)) * XS + d0 * 32 + r32; *xp = *xp - a.lam * (o[d0][r] * rli[r]); }
        }
        __syncthreads();
    }
    final_pass<false>(X, (MODE == 0) ? 128 : 256, a.Z, a.Y, a.g, a.factor, nullptr, nullptr);
    __syncthreads();
}
template <int MODE>
__device__ __forceinline__ void attn_unit(LAS char* lds, const AttnArgs& a) {
    constexpr int ND0 = (MODE == 0) ? 4 : 8;
    constexpr float SC = ModeC<MODE>::SC;
    int tid_ = threadIdx.x; asm volatile("" : "+v"(tid_));
    const int tid = tid_, wid = __builtin_amdgcn_readfirstlane(tid >> 6), lane = tid & 63, r32 = lane & 31, hi = lane >> 5;
    const int map = (MODE == 0) ? (wid >> 2) : 0, qg = (MODE == 0) ? (wid & 3) : wid;
    LAS char* V_lds = lds; LAS char* K_lds = lds + 2 * SHM_V;
    LAS float* wsf = (LAS float*)(lds + WSF_OFF) + wid * 64; LAS float* li_l = wsf; LAS float* al_l = wsf + 32;
    LAS float* bias_l = (LAS float*)(lds + BIAS_OFF);
    float m_reg = -1e30f, l_reg = 0; f32x16 o[4] = {}; bf16x8 qr[ND0];
    const bf16_t* Qw = a.Q + (size_t)(qg * 32 + r32) * LDP + map * 64 + hi * 8;
#pragma unroll
    for (int d0 = 0; d0 < ND0; ++d0) qr[d0] = ld8(Qw + d0 * 16);
    const int nr = a.R0 + (wid >> 1), nqc = 32 * (wid & 1) + r32;
    const int ncs = min(max(nqc - 8, 0), 48), nrs = min(max(nr - 4, 0), 56);
    if (MODE == 1) { if (tid < 465) bias_l[tid] = a.rpb[tid] * (1.0f / SC); }
    const int sr = tid >> 4, sc = (tid & 15) * 8, vst0 = v_st(sr, sc), vst1 = v_st(32 + sr, sc);
    const int vb0 = (int)(uintptr_t)V_lds + v_rd_base(lane);
    const int n1 = a.n1, n2 = a.n2, NT = a.NT;
    struct { bf16x8 vs0, vs1, ks0, ks1; } sr_[2];
#define TILE_PTRS(j) const int _j = (j); const int _j2 = min(_j - n1, n2 - 1); \
    const bf16_t* _Kt = (_j < n1) ? a.K1 + (size_t)_j * 64 * LDP : a.K2 + (size_t)_j2 * 64 * LDP; \
    const bf16_t* _Vt = (_j < n1) ? a.V1 + (size_t)_j * 64 * LDP : a.V2 + (size_t)_j2 * 64 * LDP;
#define SLOAD(i, j) do { TILE_PTRS(j); sr_[i].vs0 = ld8(_Vt + (size_t)sr * LDP + sc); sr_[i].vs1 = ld8(_Vt + (size_t)(32 + sr) * LDP + sc); \
    sr_[i].ks0 = ld8(_Kt + (size_t)sr * LDP + sc); sr_[i].ks1 = ld8(_Kt + (size_t)(32 + sr) * LDP + sc); } while (0)
#define SWRITE(b, i) do { *(LAS bf16x8*)(V_lds + (b) * SHM_V + vst0) = sr_[i].vs0; *(LAS bf16x8*)(V_lds + (b) * SHM_V + vst1) = sr_[i].vs1; const int kc = sc * 2; \
    *(LAS bf16x8*)(K_lds + (b) * SHM_K + KSWZ(sr, kc)) = sr_[i].ks0; *(LAS bf16x8*)(K_lds + (b) * SHM_K + KSWZ(32 + sr, kc)) = sr_[i].ks1; } while (0)
#define SWAIT() asm volatile("s_waitcnt vmcnt(4)" ::: "memory")
#define RESC(al) do { if (__any((al) < 1.f)) { if (hi == 0) al_l[r32] = (al); asm volatile("s_waitcnt lgkmcnt(0)" ::: "memory"); \
    _Pragma("unroll") for (int d = 0; d < 4; ++d) _Pragma("unroll") for (int r = 0; r < 16; ++r) o[d][r] *= al_l[crow(r, hi)]; } } while (0)
#define ACT(j) ((MODE != 1) ? true : (((j) < n1) ? ((a.kfirst + (j)) >= nrs && (a.kfirst + (j)) <= nrs + 7) : ((j) < n1 + n2)))
#define NAMASK(P0, P1, j) do { if (MODE == 1 && (j) < n1) { const int rel = (a.kfirst + (j)) - nr + 7; const LAS float* bl = bias_l + rel * 31 + 15 - nqc; \
    _Pragma("unroll") for (int r = 0; r < 16; ++r) { const int kc0 = crow(r, hi), kc1 = 32 + kc0; \
        const bool v0 = (unsigned)(kc0 - ncs) < 16u, v1 = (unsigned)(kc1 - ncs) < 16u; \
        const float bb0 = bl[min(max(kc0, nqc - 15), nqc + 15)], bb1 = bl[min(max(kc1, nqc - 15), nqc + 15)]; \
        P0[r] = v0 ? P0[r] + bb0 : -1e30f; P1[r] = v1 ? P1[r] + bb1 : -1e30f; } } } while (0)
    f32x16 pA0, pA1, pB0, pB1; float mnA = 0.f, mnB = 0.f, alA = 1.f, alB = 1.f; bf16x8 pa0, pa1, pa2, pa3;
    bool actA, actB;
    SLOAD(0, 0); asm volatile("s_waitcnt vmcnt(0)" ::: "memory"); SWRITE(0, 0); __syncthreads();
    actA = ACT(0);
    if (actA) { qkt<ND0>(pA0, pA1, K_lds, qr, r32, hi, map * 4); NAMASK(pA0, pA1, 0); partialSM<MODE>(pA0, pA1, m_reg, mnA, alA); } else { alA = 1.f; }
    SLOAD(1, 1); if (2 < NT) SLOAD(0, 2);
    SWAIT(); SWRITE(1, 1); __syncthreads();
    for (int j = 1; j + 1 < NT; j += 2) {
        actB = ACT(j);
        SBAR(); if (actB) { qkt<ND0>(pB0, pB1, K_lds + SHM_K, qr, r32, hi, map * 4); NAMASK(pB0, pB1, j); }
        if (actA) finishSM(pA0, pA1, alA, l_reg, pa0, pa1, pa2, pa3); SBAR();
        SLOAD(1, j + 2); SBAR();
        if (actA) pv_d0(o, vb0, pa0, pa1, pa2, pa3);
        if (actB) partialSM<MODE>(pB0, pB1, m_reg, mnB, alB); else alB = 1.f;
        __syncthreads(); SWAIT(); SWRITE(0, 0);
        RESC(alB); __syncthreads();
        actA = ACT(j + 1);
        SBAR(); if (actA) { qkt<ND0>(pA0, pA1, K_lds, qr, r32, hi, map * 4); NAMASK(pA0, pA1, j + 1); }
        if (actB) finishSM(pB0, pB1, alB, l_reg, pa0, pa1, pa2, pa3); SBAR();
        if (j + 3 < NT) SLOAD(0, j + 3); SBAR();
        if (actB) pv_d0(o, vb0 + SHM_V, pa0, pa1, pa2, pa3);
        if (actA) partialSM<MODE>(pA0, pA1, m_reg, mnA, alA); else alA = 1.f;
        __syncthreads(); SWAIT(); SWRITE(1, 1);
        RESC(alA); __syncthreads();
    }
    actB = ACT(NT - 1);
    SBAR(); if (actB) { qkt<ND0>(pB0, pB1, K_lds + SHM_K, qr, r32, hi, map * 4); NAMASK(pB0, pB1, NT - 1); }
    if (actA) finishSM(pA0, pA1, alA, l_reg, pa0, pa1, pa2, pa3); SBAR();
    if (actA) pv_d0(o, vb0, pa0, pa1, pa2, pa3);
    if (actB) partialSM<MODE>(pB0, pB1, m_reg, mnB, alB); else alB = 1.f;
    __syncthreads(); RESC(alB);
    if (actB) { finishSM(pB0, pB1, alB, l_reg, pa0, pa1, pa2, pa3); SBAR(); pv_d0(o, vb0 + SHM_V, pa0, pa1, pa2, pa3); }
    asm volatile("s_waitcnt vmcnt(0)" ::: "memory");
    attn_epilogue<MODE>(lds, a, o, l_reg, li_l, map, qg, r32, hi);
#undef TILE_PTRS
#undef SLOAD
#undef SWRITE
#undef SWAIT
#undef RESC
#undef ACT
#undef NAMASK
}

__device__ __forceinline__ void na_unit(LAS char* lds, const AttnArgs& a) {
    constexpr float SC = ModeC<1>::SC;
    int tid_ = threadIdx.x; asm volatile("" : "+v"(tid_));
    const int tid = tid_, wid = __builtin_amdgcn_readfirstlane(tid >> 6), lane = tid & 63, r32 = lane & 31, hi = lane >> 5;
    LAS char* V_lds = lds; LAS char* K_lds = lds + 2 * SHM_V;
    LAS float* wsf = (LAS float*)(lds + WSF_OFF) + wid * 64; LAS float* li_l = wsf; LAS float* al_l = wsf + 32;
    LAS float* bias_l = (LAS float*)(lds + BIAS_OFF);
    float m_reg = -1e30f, l_reg = 0; f32x16 o[4] = {}; bf16x8 qr[8];
    const bf16_t* Qw = a.Q + (size_t)(wid * 32 + r32) * LDP + hi * 8;
#pragma unroll
    for (int d0 = 0; d0 < 8; ++d0) qr[d0] = ld8(Qw + d0 * 16);
    const int nr = a.R0 + (wid >> 1), nqc = 32 * (wid & 1) + r32;
    const int ncs = min(max(nqc - 8, 0), 48), nrs = min(max(nr - 4, 0), 56);
    if (tid < 465) bias_l[tid] = a.rpb[tid] * (1.0f / SC);
    const int sr = tid >> 4, sc = (tid & 15) * 8, vst0 = v_st(sr, sc), vst1 = v_st(32 + sr, sc);
    const int vb0 = (int)(uintptr_t)V_lds + v_rd_base(lane);
    const int n1 = a.n1, NT = a.n1 + a.n2;
    bf16x8 vs0, vs1, ks0, ks1;
#define NA_SLOAD(j) do { const int _j = (j); const bf16_t* _Kt = (_j < n1) ? a.K1 + (size_t)_j * 64 * LDP : a.K2 + (size_t)(_j - n1) * 64 * LDP; \
    const bf16_t* _Vt = (_j < n1) ? a.V1 + (size_t)_j * 64 * LDP : a.V2 + (size_t)(_j - n1) * 64 * LDP; \
    vs0 = ld8(_Vt + (size_t)sr * LDP + sc); vs1 = ld8(_Vt + (size_t)(32 + sr) * LDP + sc); ks0 = ld8(_Kt + (size_t)sr * LDP + sc); ks1 = ld8(_Kt + (size_t)(32 + sr) * LDP + sc); } while (0)
    NA_SLOAD(0);
    for (int j = 0; j < NT; ++j) {
        const int buf = j & 1;
        { const int kc = sc * 2;
          *(LAS bf16x8*)(V_lds + buf * SHM_V + vst0) = vs0; *(LAS bf16x8*)(V_lds + buf * SHM_V + vst1) = vs1;
          *(LAS bf16x8*)(K_lds + buf * SHM_K + KSWZ(sr, kc)) = ks0; *(LAS bf16x8*)(K_lds + buf * SHM_K + KSWZ(32 + sr, kc)) = ks1; }
        if (j + 1 < NT) NA_SLOAD(j + 1);
        __syncthreads();
        const int kr = a.kfirst + j;
        const bool loc = j < n1;
        const bool act = loc ? (kr >= nrs && kr <= nrs + 7) : true;
        if (act) {
            f32x16 p0, p1; float mn, al; bf16x8 pa0, pa1, pa2, pa3;
            qkt<8>(p0, p1, K_lds + buf * SHM_K, qr, r32, hi, 0);
            if (loc) {
                const int rel = kr - nr + 7; const LAS float* bl = bias_l + rel * 31 + 15 - nqc;
#pragma unroll
                for (int r = 0; r < 16; ++r) { const int kc0 = crow(r, hi);
                    const bool v0 = (unsigned)(kc0 - ncs) < 16u; const float bb0 = bl[min(max(kc0, nqc - 15), nqc + 15)];
                    p0[r] = v0 ? p0[r] + bb0 : -1e30f; }
                asm volatile("" ::: "memory");
#pragma unroll
                for (int r = 0; r < 16; ++r) { const int kc1 = 32 + crow(r, hi);
                    const bool v1 = (unsigned)(kc1 - ncs) < 16u; const float bb1 = bl[min(max(kc1, nqc - 15), nqc + 15)];
                    p1[r] = v1 ? p1[r] + bb1 : -1e30f; }
            }
            partialSM<1>(p0, p1, m_reg, mn, al);
            if (__any(al < 1.f)) { if (hi == 0) al_l[r32] = al; asm volatile("s_waitcnt lgkmcnt(0)" ::: "memory");
#pragma unroll
                for (int d = 0; d < 4; ++d)
#pragma unroll
                    for (int r = 0; r < 16; ++r) o[d][r] *= al_l[crow(r, hi)]; }
            finishSM(p0, p1, al, l_reg, pa0, pa1, pa2, pa3);
            pv_d0(o, vb0 + buf * SHM_V, pa0, pa1, pa2, pa3);
        }
    }
#undef NA_SLOAD
    attn_epilogue<1>(lds, a, o, l_reg, li_l, 0, wid, r32, hi);
}

struct MlpArgs { const bf16_t* Prow; bf16_t* Yrow; const bf16_t* Wsb; const float *lng, *lnb, *bs, *mg; int g; };
__device__ __forceinline__ void mlp_unit(LAS char* lds, const MlpArgs& a) {
    int tid_ = threadIdx.x; asm volatile("" : "+v"(tid_));
    const int tid = tid_, wid = __builtin_amdgcn_readfirstlane(tid >> 6), lane = tid & 63, r32 = lane & 31, hi = lane >> 5;
    const int sr = tid >> 4, sc = (tid & 15) * 8, g = a.g;
    const f32x4 lg0 = *(const f32x4*)(a.lng + g * 128 + sc), lg1 = *(const f32x4*)(a.lng + g * 128 + sc + 4);
    const f32x4 lb0 = *(const f32x4*)(a.lnb + g * 128 + sc), lb1 = *(const f32x4*)(a.lnb + g * 128 + sc + 4);
#pragma unroll
    for (int t = 0; t < 4; ++t) {
        const int q = t * 32 + sr;
        const u32x4 w = *(const u32x4*)(a.Prow + (size_t)q * LDP + C_MV + g * 128 + sc);
        float v[8] = {bf_lo(w.x), bf_hi(w.x), bf_lo(w.y), bf_hi(w.y), bf_lo(w.z), bf_hi(w.z), bf_lo(w.w), bf_hi(w.w)};
        float s = 0.f;
#pragma unroll
        for (int e = 0; e < 8; ++e) s += v[e];
        s += __shfl_xor(s, 1); s += __shfl_xor(s, 2); s += __shfl_xor(s, 4); s += __shfl_xor(s, 8);
        const float mu = s * (1.0f / 128.0f); float qq = 0.f;
#pragma unroll
        for (int e = 0; e < 8; ++e) { v[e] -= mu; qq += v[e] * v[e]; }
        qq += __shfl_xor(qq, 1); qq += __shfl_xor(qq, 2); qq += __shfl_xor(qq, 4); qq += __shfl_xor(qq, 8);
        const float rstd = __builtin_amdgcn_rsqf(qq * (1.0f / 128.0f) + EPS);
        u32x4 ow;
        ow.x = cvt_pk_bf16(v[0] * rstd * lg0[0] + lb0[0], v[1] * rstd * lg0[1] + lb0[1]); ow.y = cvt_pk_bf16(v[2] * rstd * lg0[2] + lb0[2], v[3] * rstd * lg0[3] + lb0[3]);
        ow.z = cvt_pk_bf16(v[4] * rstd * lg1[0] + lb1[0], v[5] * rstd * lg1[1] + lb1[1]); ow.w = cvt_pk_bf16(v[6] * rstd * lg1[2] + lb1[2], v[7] * rstd * lg1[3] + lb1[3]);
        *(LAS u32x4*)(lds + (q >> 6) * SHM_V + v_st(q & 63, sc)) = ow;
    }
    const int prow0 = 32 * (wid & 3), dsel = wid >> 2;
    bf16x8 pa[8];
    const bf16_t* wp = a.Wsb + ((size_t)(g * 128 + prow0 + r32)) * 128 + 8 * hi;
#pragma unroll
    for (int s = 0; s < 8; ++s) pa[s] = ld8(wp + 16 * s);
    __syncthreads();
    f32x16 o0 = {}, o1 = {};
    const int vb0 = (int)(uintptr_t)lds + v_rd_base(lane);
    if (dsel == 0) { pv_one<0>(o0, vb0, pa[0], pa[1], pa[2], pa[3]); pv_one<1>(o1, vb0, pa[0], pa[1], pa[2], pa[3]);
                     pv_one<0>(o0, vb0 + SHM_V, pa[4], pa[5], pa[6], pa[7]); pv_one<1>(o1, vb0 + SHM_V, pa[4], pa[5], pa[6], pa[7]); }
    else           { pv_one<2>(o0, vb0, pa[0], pa[1], pa[2], pa[3]); pv_one<3>(o1, vb0, pa[0], pa[1], pa[2], pa[3]);
                     pv_one<2>(o0, vb0 + SHM_V, pa[4], pa[5], pa[6], pa[7]); pv_one<3>(o1, vb0 + SHM_V, pa[4], pa[5], pa[6], pa[7]); }
    __syncthreads();
    LAS float* X = (LAS float*)lds;
#pragma unroll
    for (int r = 0; r < 16; ++r) { X[(prow0 + crow(r, hi)) * XS + (2 * dsel) * 32 + r32] = o0[r]; X[(prow0 + crow(r, hi)) * XS + (2 * dsel + 1) * 32 + r32] = o1[r]; }
    __syncthreads();
    final_pass<true>(X, 128, a.Prow + C_MZ + g * 128, a.Yrow + 1536 + g * 128, a.mg + g * 128, 1.0f, a.Prow + C_MU + g * 128, a.bs + g * 128);
    __syncthreads();
}
}

__device__ __forceinline__ void p0_transpose_item(const float* W, int K, int N, bf16_t* WT, LAS float* scr, int item, int lane) {
    const int nblk = N / 32, kb = item / nblk, nb = item % nblk, k0 = 64 * kb, n0 = 32 * nb;
#pragma unroll 8
    for (int i = 0; i < 32; ++i) { const int kk = 2 * i + (lane >> 5); scr[kk * 33 + (lane & 31)] = W[(size_t)(k0 + kk) * N + n0 + (lane & 31)]; }
    asm volatile("s_waitcnt lgkmcnt(0)" ::: "memory");
    const int c = lane & 7;
#pragma unroll
    for (int j = 0; j < 4; ++j) { const int n = (lane >> 3) + 8 * j; const LAS float* s = scr + (8 * c) * 33 + n;
        u32x4 o; o.x = cvt_pk_bf16(s[0 * 33], s[1 * 33]); o.y = cvt_pk_bf16(s[2 * 33], s[3 * 33]); o.z = cvt_pk_bf16(s[4 * 33], s[5 * 33]); o.w = cvt_pk_bf16(s[6 * 33], s[7 * 33]);
        *(u32x4*)(WT + (size_t)(n0 + n) * K + k0 + 8 * c) = o; }
    asm volatile("s_waitcnt lgkmcnt(0)" ::: "memory");
}

__device__ __forceinline__ void phase0(const Params& p, LAS unsigned char* lds, int tid, int lane, int wave) {
    const int gw = blockIdx.x * 8 + wave, ngw = gridDim.x * 8;
    unsigned char* ws = p.ws;
    LAS float* scr = (LAS float*)(lds + wave * 16384);
    bf16_t* WinT = (bf16_t*)(ws + WS_WIN); bf16_t* WoutT = (bf16_t*)(ws + WS_WOUT);
    constexpr int I_IN = (DM / 64) * (INW / 32), I_OUT = (DM / 64) * (DM / 32), I_L = I_IN + I_OUT;
    for (int it = gw; it < 2 * I_L; it += ngw) {
        const int l = it / I_L, r = it % I_L;
        if (r < I_IN) p0_transpose_item(p.w_in + (size_t)l * DM * INW, DM, INW, WinT + (size_t)l * INW * DM, scr, r, lane);
        else p0_transpose_item(p.w_out + (size_t)l * DM * DM, DM, DM, WoutT + (size_t)l * DM * DM, scr, r - I_IN, lane);
    }
    float* mod = (float*)(ws + WS_CTL + CTL_MOD);
    for (int it = gw; it < 768; it += ngw) {
        const int l = it / 384, r = it % 384, kc = r / 24, nc = r % 24;
        const float* W = p.ada_w + (size_t)l * DM * 6144 + nc * 256 + lane * 4;
        f32x4 acc[5];
#pragma unroll
        for (int b = 0; b < 5; ++b) acc[b] = (f32x4){0.f, 0.f, 0.f, 0.f};
        for (int half = 0; half < 2; ++half) {
            const int k0 = kc * 128 + half * 64;
            float sv[5];
#pragma unroll
            for (int b = 0; b < 4; ++b) sv[b] = silu_f(p.c[b * DM + k0 + lane]);
            sv[4] = silu_f(p.c_ctx[k0 + lane]);
#pragma unroll 8
            for (int kk = 0; kk < 64; ++kk) {
                const f32x4 w4 = *(const f32x4*)(W + (size_t)(k0 + kk) * 6144);
#pragma unroll
                for (int b = 0; b < 5; ++b) { const float s = __uint_as_float(__builtin_amdgcn_readlane(__float_as_uint(sv[b]), kk)); acc[b] += w4 * s; }
            }
        }
        if (kc == 0) { const f32x4 bv = *(const f32x4*)(p.ada_b + l * 6144 + nc * 256 + lane * 4);
#pragma unroll
            for (int b = 0; b < 5; ++b) acc[b] += bv; }
#pragma unroll
        for (int b = 0; b < 5; ++b) { float* dst = mod + ((size_t)(l * 5 + b)) * 6144 + nc * 256 + lane * 4;
#pragma unroll
            for (int e = 0; e < 4; ++e) atomicAdd(dst + e, acc[b][e]); }
    }
    float* tab = (float*)(ws + WS_TAB);
    if (gw == ngw - 1) {
        for (int idx = lane; idx < 1024; idx += 64) { const int pos = idx >> 4, i = idx & 15;
            const float freq = powf(10000.0f, -(float)i / 16.0f); const float ang = (float)pos * freq;
            tab[idx] = cosf(ang); tab[1024 + idx] = sinf(ang); }
    }
    if (gw == ngw - 2) {
        for (int l = 0; l < 2; ++l) {
            const float s1 = wave_sum(p.lq1[l * 64 + lane] * p.lk1[l * 64 + lane]), s2 = wave_sum(p.lq2[l * 64 + lane] * p.lk2[l * 64 + lane]);
            const float lam_init = 0.8f - 0.6f * expf(-0.3f * (float)l);
            if (lane == 0) tab[2048 + l] = expf(s1) - expf(s2) + lam_init;
        }
    }
    { bf16_t* wsb = (bf16_t*)(ws + WS_WSB); const int gt = blockIdx.x * 512 + tid;
      if (gt < 16384) { const f32x4 a = *(const f32x4*)(p.mws + gt * 8), b = *(const f32x4*)(p.mws + gt * 8 + 4);
          u32x4 o; o.x = cvt_pk_bf16(a[0], a[1]); o.y = cvt_pk_bf16(a[2], a[3]); o.z = cvt_pk_bf16(b[0], b[1]); o.w = cvt_pk_bf16(b[2], b[3]); *(u32x4*)(wsb + gt * 8) = o; } }
}

template <int L>
__device__ __forceinline__ void norm_phase(const Params& p, int lane, int wave) {
    const int gw = blockIdx.x * 8 + wave, ngw = gridDim.x * 8;
    unsigned char* ws = p.ws;
    const float* mod = (const float*)(ws + WS_CTL + CTL_MOD);
    const float* rowss = (const float*)(ws + WS_CTL + CTL_ROWSS);
    const float* Yf = (const float*)(ws + WS_P);
    float* XC1 = (float*)(ws + WS_XC1);
    bf16_t* H = (bf16_t*)(ws + WS_H);
    const int nrows = (L == 0) ? MROWS : ((L == 1) ? MROWS : NLAT);
    for (int row = gw; row < nrows; row += ngw) {
        const bool isctx = row >= NLAT; const int b = isctx ? 4 : (row >> 12);
        const float* xin;
        if (L == 0) xin = isctx ? p.ctx + (size_t)(row - NLAT) * DM : p.x + (size_t)row * DM;
        else if (L == 1) xin = isctx ? p.ctx + (size_t)(row - NLAT) * DM : p.x + (size_t)row * DM;
        else xin = p.out + (size_t)row * DM;
        f32x4 v[8];
#pragma unroll
        for (int j = 0; j < 8; ++j) v[j] = *(const f32x4*)(xin + 4 * lane + 256 * j);
        if (L >= 1) {
            const int lp = L - 1;
            const float rs = __builtin_amdgcn_rsqf(rowss[lp * MROWS + row] * (1.0f / DM) + EPS);
            const float* gate = mod + ((size_t)(lp * 5 + b)) * 6144 + 4096;
            const float* pg = p.post_g + lp * DM;
            float* xo = (L == 2) ? p.out + (size_t)row * DM : (isctx ? XC1 + (size_t)(row - NLAT) * DM : p.out + (size_t)row * DM);
#pragma unroll
            for (int j = 0; j < 8; ++j) { const int cidx = 4 * lane + 256 * j;
                const f32x4 y = *(const f32x4*)(Yf + (size_t)row * DM + cidx), gt = *(const f32x4*)(gate + cidx), g4 = *(const f32x4*)(pg + cidx);
                v[j] = v[j] + gt * (y * rs) * g4;
                *(f32x4*)(xo + cidx) = v[j]; }
        }
        if (L <= 1) {
            float ss = 0.f;
#pragma unroll
            for (int j = 0; j < 8; ++j) ss += (v[j][0] * v[j][0] + v[j][1] * v[j][1]) + (v[j][2] * v[j][2] + v[j][3] * v[j][3]);
            ss = wave_sum(ss);
            const float rstd = __builtin_amdgcn_rsqf(ss * (1.0f / DM) + EPS);
            const float* shift = mod + ((size_t)(L * 5 + b)) * 6144; const float* scale = shift + 2048; const float* pg = p.pre_g + L * DM;
#pragma unroll
            for (int j = 0; j < 8; ++j) { const int cidx = 4 * lane + 256 * j;
                const f32x4 sh = *(const f32x4*)(shift + cidx), scv = *(const f32x4*)(scale + cidx), g4 = *(const f32x4*)(pg + cidx);
                const f32x4 hv = (v[j] * rstd) * g4 * (scv + 1.0f) + sh;
                u32x2 w; w.x = cvt_pk_bf16(hv[0], hv[1]); w.y = cvt_pk_bf16(hv[2], hv[3]);
                *(u32x2*)(H + (size_t)row * DM + cidx) = w; }
        }
    }
}

template <int L>
__device__ __forceinline__ void mixer_phase(const Params& p, LAS unsigned char* lds8, int tid) {
    LAS char* lds = (LAS char*)lds8;
    unsigned char* ws = p.ws;
    const bf16_t* P = (const bf16_t*)(ws + WS_P);
    bf16_t* Y = (bf16_t*)(ws + WS_H);
    const float* tab = (const float*)(ws + WS_TAB);
    const float lam = tab[2048 + L];
    const float lam_init = (L == 0) ? 0.2f : 0.35550906759096926f;
    unsigned* qctr = (unsigned*)(ws + WS_CTL + CTL_QCTR) + 64 * L;
    volatile LAS unsigned* misc = (volatile LAS unsigned*)(lds8 + MISC_OFF);
    constexpr int N_DIFF = NB * 6 * 32, N_NA = NB * 6 * 16, N_DIFFC = (L == 0) ? NB * 6 * 2 : 0, N_SMC = (L == 0) ? NB * 6 : 0, N_MLP = NB * 32 * 4, N_MLPC = (L == 0) ? NB * 2 * 4 : 0;
    constexpr int NU = N_DIFF + N_NA + N_DIFFC + N_SMC + N_MLP + N_MLPC;
#define PULL() do { if (tid == 0) misc[0] = atomicAdd(qctr, 1u); __syncthreads(); u = (int)misc[0]; __syncthreads(); } while (0)
    int u; PULL();
    constexpr int E_DIFF = N_DIFF, E_NA = E_DIFF + N_NA, E_DIFFC = E_NA + N_DIFFC, E_SMC = E_DIFFC + N_SMC;
    while ((UNIT_MASK & 1) && u < E_DIFF) {
        const int qb = u & 31, h = (u >> 5) % 6, b = u / 192;
        att::AttnArgs a{};
        const size_t t0 = (size_t)b * SEQ, tq = t0 + qb * 128, tc = (size_t)NLAT + b * CTXL;
        a.Q = P + tq * LDP + C_AQ + h * HD;
        a.K1 = P + t0 * LDP + C_AK + h * HD; a.K2 = P + tc * LDP + C_AK + h * HD;
        a.V1 = P + t0 * LDP + C_AV + h * HD; a.V2 = P + tc * LDP + C_AV + h * HD;
        a.n1 = 64; a.n2 = 4; a.NT = 68;
        a.Z = P + tq * LDP + C_AZ + h * HD; a.Y = Y + tq * DM + h * HD; a.g = p.da_g + L * HD; a.factor = 1.0f - lam_init; a.lam = lam;
        att::attn_unit<0>(lds, a);
        PULL();
    }
    while ((UNIT_MASK & 2) && u >= E_DIFF && u < E_NA) {
        const int v = u - E_DIFF; const int g4 = v & 15, h = (v >> 4) % 6, b = v / 96;
        att::AttnArgs a{};
        const int R0 = 4 * g4, kfirst = min(max(R0 - 4, 0), 56), klast = min(max(R0 - 1, 0), 56) + 7, nloc = klast - kfirst + 1;
        const size_t t0 = (size_t)b * SEQ, tq = t0 + R0 * 64, tk = t0 + kfirst * 64, tc = (size_t)NLAT + b * CTXL;
        a.Q = P + tq * LDP + C_NQ + h * HD;
        a.K1 = P + tk * LDP + C_NK + h * HD; a.K2 = P + tc * LDP + C_NK + h * HD;
        a.V1 = P + tk * LDP + C_NV + h * HD; a.V2 = P + tc * LDP + C_NV + h * HD;
        a.n1 = nloc; a.n2 = 4; a.NT = nloc + 4;
        a.R0 = R0; a.kfirst = kfirst; a.rpb = p.rpb + ((size_t)(L * 6 + h)) * 465;
        a.Z = P + tq * LDP + C_NZ + h * HD; a.Y = Y + tq * DM + 768 + h * HD; a.g = p.na_g + (L * 6 + h) * HD; a.factor = 1.0f; a.lam = 0.f;
        att::na_unit(lds, a);
        PULL();
    }
    while ((UNIT_MASK & 4) && L == 0 && u >= E_NA && u < E_DIFFC) {
        const int v = u - E_NA; const int qb = v & 1, h = (v >> 1) % 6, b = v / 12;
        att::AttnArgs a{};
        const size_t tc = (size_t)NLAT + b * CTXL, tq = tc + qb * 128;
        a.Q = P + tq * LDP + C_AQ + h * HD;
        a.K1 = P + tc * LDP + C_AK + h * HD; a.K2 = a.K1; a.V1 = P + tc * LDP + C_AV + h * HD; a.V2 = a.V1;
        a.n1 = 4; a.n2 = 1; a.NT = 4;
        a.Z = P + tq * LDP + C_AZ + h * HD; a.Y = Y + tq * DM + h * HD; a.g = p.da_g + L * HD; a.factor = 1.0f - lam_init; a.lam = lam;
        att::attn_unit<0>(lds, a);
        PULL();
    }
    while ((UNIT_MASK & 8) && L == 0 && u >= E_DIFFC && u < E_SMC) {
        const int v = u - E_DIFFC; const int h = v % 6, b = v / 6;
        att::AttnArgs a{};
        const size_t tc = (size_t)NLAT + b * CTXL;
        a.Q = P + tc * LDP + C_NQ + h * HD;
        a.K1 = P + tc * LDP + C_NK + h * HD; a.K2 = a.K1; a.V1 = P + tc * LDP + C_NV + h * HD; a.V2 = a.V1;
        a.n1 = 4; a.n2 = 1; a.NT = 4;
        a.Z = P + tc * LDP + C_NZ + h * HD; a.Y = Y + tc * DM + 768 + h * HD; a.g = p.na_g + (L * 6 + h) * HD; a.factor = 1.0f; a.lam = 0.f;
        att::attn_unit<2>(lds, a);
        PULL();
    }
    while ((UNIT_MASK & 16) && u >= E_SMC && u < NU) {
        const int v = u - E_SMC;
        att::MlpArgs m{};
        size_t t0;
        if (v < N_MLP) { const int g = v & 3, ch = (v >> 2) & 31, b = v >> 7; t0 = (size_t)b * SEQ + ch * 128; m.g = g; }
        else { const int w = v - N_MLP; const int g = w & 3, ch = (w >> 2) & 1, b = w >> 3; t0 = (size_t)NLAT + b * CTXL + ch * 128; m.g = g; }
        m.Prow = P + t0 * LDP; m.Yrow = Y + t0 * DM; m.Wsb = (const bf16_t*)(ws + WS_WSB) + (size_t)L * 4 * 128 * 128;
        m.lng = p.ln_g + L * 512; m.lnb = p.ln_b + L * 512; m.bs = p.mbs + L * 512; m.mg = p.mlp_g + L * 512;
        att::mlp_unit(lds, m);
        PULL();
    }
#undef PULL
}

#define XB_TMO      128
#define XB_XCNT(j)  (256  + 64 * (j))
#define XB_XSUB(j)  (1280 + 64 * (j))
#define XB_XGEN(j)  (2304 + 64 * (j))
#define XB_TOP      3328
#define XB_TOPGEN   3392
#define XCD_BAR_WORDS 3456
#define XB_SPIN_CAP (1u << 22)
__device__ __forceinline__ unsigned xb_ld(unsigned* p)              { return __hip_atomic_load(p, __ATOMIC_RELAXED, __HIP_MEMORY_SCOPE_AGENT); }
__device__ __forceinline__ unsigned xb_add(unsigned* p, unsigned v) { return __hip_atomic_fetch_add(p, v, __ATOMIC_RELAXED, __HIP_MEMORY_SCOPE_AGENT); }
__device__ __forceinline__ unsigned xb_xcc_id() { return (unsigned)__builtin_amdgcn_s_getreg((3 << 11) | 20) & 0xFu; }
#define XB_SPIN(cond, bar) do { unsigned _sp = 0; while (cond) { __builtin_amdgcn_s_sleep(1); \
    if ((++_sp & 255u) == 0u) { if (xb_ld(&(bar)[XB_TMO])) break; if (_sp > XB_SPIN_CAP) { atomicAdd(&(bar)[XB_TMO], 1u); break; } } } } while (0)
struct XcdBarrier { unsigned* bar; unsigned x; volatile LAS unsigned* st; };
__device__ __forceinline__ XcdBarrier xcd_barrier_post(unsigned* bar, volatile LAS unsigned* st) {
    XcdBarrier b; b.bar = bar; b.x = xb_xcc_id(); b.st = st;
    if (threadIdx.x == 0) (void)xb_add(&bar[XB_XCNT(b.x)], 1u);
    return b;
}
__device__ __forceinline__ void xcd_barrier_complete(unsigned* bar, unsigned x, unsigned& nloc, unsigned& nx) {
    const unsigned G = gridDim.x * gridDim.y * gridDim.z;
    unsigned sum, cnt, mine, sp = 0u;
    for (;;) {
        sum = 0u; cnt = 0u; mine = 0u;
#pragma unroll
        for (unsigned j = 0; j < 16; ++j) { const unsigned c = xb_ld(&bar[XB_XCNT(j)]); sum += c; cnt += (c > 0u) ? 1u : 0u; mine = (j == x) ? c : mine; }
        if (sum == G) break;
        __builtin_amdgcn_s_sleep(1);
        if ((++sp & 255u) == 0u) { if (xb_ld(&bar[XB_TMO])) break; if (sp > XB_SPIN_CAP) { atomicAdd(&bar[XB_TMO], 1u); break; } }
    }
    nloc = mine > 0u ? mine : 1u; nx = cnt > 0u ? cnt : 1u;
}
__device__ __forceinline__ void xcd_barrier(const XcdBarrier& b) {
    asm volatile("s_waitcnt vmcnt(0)" ::: "memory");
    __syncthreads();
    if (threadIdx.x == 0) {
        unsigned* bar = b.bar;
        __builtin_amdgcn_s_waitcnt(0);
        unsigned nloc = b.st[0], nx = b.st[1];
        if (nloc == 0u) { xcd_barrier_complete(bar, b.x, nloc, nx); b.st[0] = nloc; b.st[1] = nx; }
        const unsigned old = xb_add(&bar[XB_XSUB(b.x)], 1u);
        const unsigned gen = old / nloc;
        if (old + 1u == (gen + 1u) * nloc) {
            __builtin_amdgcn_fence(__ATOMIC_RELEASE, "agent");
            asm volatile("s_waitcnt vmcnt(0)" ::: "memory");
            const unsigned og = xb_add(&bar[XB_TOP], 1u);
            const unsigned tg = og / nx;
            if (og + 1u == (tg + 1u) * nx) xb_add(&bar[XB_TOPGEN], 1u);
            else XB_SPIN(xb_ld(&bar[XB_TOPGEN]) == tg, bar);
            __builtin_amdgcn_fence(__ATOMIC_ACQUIRE, "agent");
            xb_add(&bar[XB_XGEN(b.x)], 1u);
            asm volatile("s_waitcnt vmcnt(0)" ::: "memory");
        } else {
            XB_SPIN(xb_ld(&bar[XB_XGEN(b.x)]) == gen, bar);
            __builtin_amdgcn_fence(__ATOMIC_ACQUIRE, "agent");
            asm volatile("s_waitcnt vmcnt(0)" ::: "memory");
        }
    }
    __syncthreads();
}

__global__ void __launch_bounds__(512, 2) mega_fwd(Params p) {
    extern __shared__ __attribute__((aligned(16))) unsigned char lds_raw[];
    LAS unsigned char* lds = (LAS unsigned char*)lds_raw;
    cg::grid_group grid = cg::this_grid();
    const int tid = threadIdx.x, lane = tid & 63, wave = __builtin_amdgcn_readfirstlane(tid >> 6);
    unsigned char* ws = p.ws;
    const int lo = p.ph_lo, hi = p.ph_hi;
    volatile LAS unsigned* MISC = (volatile LAS unsigned*)(lds + MISC_OFF);
    if (tid < 64) MISC[tid] = 0u;
    __syncthreads();
    XcdBarrier bar = xcd_barrier_post((unsigned*)(ws + WS_CTL + CTL_BAR), MISC + 8);
#ifndef PH_MASK
#define PH_MASK 0x3ff
#endif
#define IN(k) (((PH_MASK >> (k)) & 1) && lo <= (k) && (k) < hi)
#define SEAM(k) do { if (IN(k) && IN((k) + 1)) { if ((k) == 0) grid.sync(); else xcd_barrier(bar); } } while (0)
    if (IN(0)) phase0(p, lds, tid, lane, wave);
    SEAM(0);
    if (IN(1)) norm_phase<0>(p, lane, wave);
    SEAM(1);
    if (IN(2)) { pg8::Gemm g{(const bf16_t*)(ws + WS_H), (const bf16_t*)(ws + WS_WIN), DM}; pg8::Sched S; S.init(68, 30, gridDim.x, blockIdx.x, 0);
        pg8::Epi1 E{(bf16_t*)(ws + WS_P), (const float*)(ws + WS_TAB), (const float*)(ws + WS_TAB) + 1024}; pg8::gemm_phase<pg8::Epi1>(lds, g, S, E); }
    SEAM(2);
    if (IN(3)) mixer_phase<0>(p, lds, tid);
    SEAM(3);
    if (IN(4)) { pg8::Gemm g{(const bf16_t*)(ws + WS_H), (const bf16_t*)(ws + WS_WOUT), DM}; pg8::Sched S; S.init(68, 8, gridDim.x, blockIdx.x, 0);
        pg8::Epi2 E{(float*)(ws + WS_P), (float*)(ws + WS_CTL + CTL_ROWSS)}; pg8::gemm_phase<pg8::Epi2>(lds, g, S, E); }
    SEAM(4);
    if (IN(5)) norm_phase<1>(p, lane, wave);
    SEAM(5);
    if (IN(6)) { pg8::Gemm g{(const bf16_t*)(ws + WS_H), (const bf16_t*)(ws + WS_WIN) + (size_t)INW * DM, DM}; pg8::Sched S; S.init(64, 30, gridDim.x, blockIdx.x, 48);
        pg8::Epi1 E{(bf16_t*)(ws + WS_P), (const float*)(ws + WS_TAB), (const float*)(ws + WS_TAB) + 1024}; pg8::gemm_phase<pg8::Epi1>(lds, g, S, E); }
    SEAM(6);
    if (IN(7)) mixer_phase<1>(p, lds, tid);
    SEAM(7);
    if (IN(8)) { pg8::Gemm g{(const bf16_t*)(ws + WS_H), (const bf16_t*)(ws + WS_WOUT) + (size_t)DM * DM, DM}; pg8::Sched S; S.init(64, 8, gridDim.x, blockIdx.x, 0);
        pg8::Epi2 E{(float*)(ws + WS_P), (float*)(ws + WS_CTL + CTL_ROWSS) + MROWS}; pg8::gemm_phase<pg8::Epi2>(lds, g, S, E); }
    SEAM(8);
    if (IN(9)) norm_phase<2>(p, lane, wave);
#undef IN
#undef SEAM
}

extern "C" void kernel_launch(void* const* d_in, const int* in_sizes, int n_in, void* d_out, int out_size, void* d_ws, size_t ws_size, hipStream_t stream) {
    static int grid = 0;
    if (grid == 0) {
        if (n_in != 22 || out_size != NLAT * DM || ws_size < WS_END) { fprintf(stderr, "kernel_launch: unexpected shapes (n_in %d out %d ws %zu)\n", n_in, out_size, ws_size); grid = -1; return; }
        int dev = 0, cus = 0, per_cu = 0;
        if (hipGetDevice(&dev) != hipSuccess || hipDeviceGetAttribute(&cus, hipDeviceAttributeMultiprocessorCount, dev) != hipSuccess) { grid = -1; return; }
        if (hipFuncSetAttribute((const void*)mega_fwd, hipFuncAttributeMaxDynamicSharedMemorySize, LDS_BYTES) != hipSuccess) { fprintf(stderr, "kernel_launch: hipFuncSetAttribute failed\n"); grid = -1; return; }
        if (hipOccupancyMaxActiveBlocksPerMultiprocessor(&per_cu, (const void*)mega_fwd, 512, LDS_BYTES) != hipSuccess || per_cu < 1) { fprintf(stderr, "kernel_launch: occupancy query says %d\n", per_cu); per_cu = 1; }
        (void)hipGetLastError();
        grid = cus * 1;
    }
    if (grid < 0) return;
    (void)hipMemsetAsync((char*)d_ws + WS_CTL, 0, CTL_BYTES, stream);
    Params p{};
    p.x = (const float*)d_in[0]; p.c = (const float*)d_in[1]; p.ctx = (const float*)d_in[2]; p.c_ctx = (const float*)d_in[3]; p.ada_w = (const float*)d_in[4]; p.ada_b = (const float*)d_in[5];
    p.pre_g = (const float*)d_in[6]; p.post_g = (const float*)d_in[7]; p.w_in = (const float*)d_in[8]; p.w_out = (const float*)d_in[9];
    p.lq1 = (const float*)d_in[10]; p.lk1 = (const float*)d_in[11]; p.lq2 = (const float*)d_in[12]; p.lk2 = (const float*)d_in[13];
    p.da_g = (const float*)d_in[14]; p.rpb = (const float*)d_in[15]; p.na_g = (const float*)d_in[16]; p.ln_g = (const float*)d_in[17]; p.ln_b = (const float*)d_in[18];
    p.mws = (const float*)d_in[19]; p.mbs = (const float*)d_in[20]; p.mlp_g = (const float*)d_in[21];
    p.out = (float*)d_out; p.ws = (unsigned char*)d_ws;
#if MK_SINGLE
    p.ph_lo = 0; p.ph_hi = 10;
    { void* args[] = {&p}; hipError_t e = hipLaunchCooperativeKernel((const void*)mega_fwd, dim3(grid), dim3(512), args, LDS_BYTES, stream);
      if (e != hipSuccess) fprintf(stderr, "kernel_launch: cooperative launch failed: %s (grid %d)\n", hipGetErrorString(e), grid); }
#else
    for (int ph = 0; ph < 10; ++ph) { p.ph_lo = ph; p.ph_hi = ph + 1; void* args[] = {&p};
        hipError_t e = hipLaunchCooperativeKernel((const void*)mega_fwd, dim3(grid), dim3(512), args, LDS_BYTES, stream);
        if (e != hipSuccess) { fprintf(stderr, "kernel_launch: launch %d failed: %s (grid %d)\n", ph, hipGetErrorString(e), grid); break; } }
#endif
}
```

```cpp
#include <hip/hip_runtime.h>
#include <hip/hip_cooperative_groups.h>
#include <cstdio>
#include <cstdint>
namespace cg = cooperative_groups;
#ifndef UNIT_MASK
#define UNIT_MASK 31
#endif
#ifndef DUP_PHASE
#define DUP_PHASE -1
#endif
#ifndef DUP_UMASK
#define DUP_UMASK 31
#endif

#ifndef MK_SINGLE
#define MK_SINGLE 1
#endif

#define LAS __attribute__((address_space(3)))
typedef unsigned short bf16_t;
typedef short bf16x8 __attribute__((ext_vector_type(8)));
typedef short s16x4 __attribute__((ext_vector_type(4)));
typedef float f32x2 __attribute__((ext_vector_type(2)));
typedef float f32x4 __attribute__((ext_vector_type(4)));
typedef float f32x8 __attribute__((ext_vector_type(8)));
typedef float f32x16 __attribute__((ext_vector_type(16)));
typedef unsigned u32x2 __attribute__((ext_vector_type(2)));
typedef unsigned u32x4 __attribute__((ext_vector_type(4)));

constexpr int DM = 2048, NB = 4, SEQ = 4096, CTXL = 256, NLAT = NB * SEQ, NCTX = NB * CTXL, MROWS = NLAT + NCTX;
constexpr int INW = 7680, LDP = INW, HD = 128;
constexpr int C_AQ = 0, C_AK = 768, C_AV = 1536, C_AZ = 2304, C_NQ = 3072, C_NK = 3840, C_NV = 4608, C_NZ = 5376, C_MU = 6144, C_MV = 6656, C_MZ = 7168;
constexpr float EPS = 1e-6f;
constexpr float LOG2E = 1.4426950408889634f;

constexpr size_t MiB = 1u << 20;
constexpr size_t WS_CTL = 0, CTL_BYTES = 1 * MiB;
constexpr size_t CTL_QCTR = 256;
constexpr size_t CTL_MOD = 4096;
constexpr size_t CTL_ROWSS = 262144;
constexpr size_t CTL_BAR = 524288;
constexpr size_t WS_TAB = 1 * MiB;
constexpr size_t WS_WSB = 1 * MiB + 65536;
constexpr size_t WS_WIN = 2 * MiB;
constexpr size_t WS_WOUT = 62 * MiB;
constexpr size_t WS_H = 78 * MiB;
constexpr size_t WS_XC1 = 146 * MiB;
constexpr size_t WS_P = 154 * MiB;
constexpr size_t WS_Y0 = 409 * MiB;
constexpr size_t WS_END = 477 * MiB;

constexpr int LDS_BYTES = 147456;
constexpr int MISC_OFF = 139264;

struct Params {
    const float *x, *c, *ctx, *c_ctx, *ada_w, *ada_b, *pre_g, *post_g, *w_in, *w_out, *lq1, *lk1, *lq2, *lk2, *da_g, *rpb, *na_g, *ln_g, *ln_b, *mws, *mbs, *mlp_g;
    float* out; unsigned char* ws; int ph_lo, ph_hi;
};

__device__ __forceinline__ unsigned cvt_pk_bf16(float lo, float hi) { unsigned r; asm volatile("v_cvt_pk_bf16_f32 %0, %1, %2" : "=v"(r) : "v"(lo), "v"(hi)); return r; }
__device__ __forceinline__ float bf_lo(unsigned w) { return __uint_as_float(w << 16); }
__device__ __forceinline__ float bf_hi(unsigned w) { return __uint_as_float(w & 0xffff0000u); }
__device__ __forceinline__ float wave_sum(float v) {
#pragma unroll
    for (int o = 1; o < 64; o <<= 1) v += __shfl_xor(v, o);
    return v;
}
__device__ __forceinline__ float silu_f(float z) { return z * __builtin_amdgcn_rcpf(1.0f + __builtin_amdgcn_exp2f(-z * LOG2E)); }
__device__ __forceinline__ float gelu_tanh(float x) {
    const float u = 0.7978845608028654f * (x + 0.044715f * x * x * x);
    return x * __builtin_amdgcn_rcpf(1.0f + __builtin_amdgcn_exp2f(-2.0f * LOG2E * u));
}

namespace pg8 {
constexpr int BM = 256, BK = 64, HALF = 128, HTB = HALF * BK * 2, STAGE_BYTES = 8 * HTB, NXCD = 8, WGM = 8;
__host__ __device__ __forceinline__ int lds_byte(int r, int c) { const int st = (r >> 4) * 2 + (c >> 5), rr = r & 15, cc = c & 31, ob = rr * 64 + cc * 2; return st * 1024 + (ob ^ (((ob >> 9) & 1) << 5)); }
__host__ __device__ __forceinline__ void stage_rc(int b, int& R, int& C) { const int st = b / 1024, sb = b % 1024, swz = sb ^ (((sb >> 9) & 1) << 5); R = (st >> 1) * 16 + swz / 64; C = (st & 1) * 32 + (swz % 64) / 2; }
__host__ __device__ __forceinline__ int perm32(int rho) { const int n = rho >> 4, i = rho & 15; return 8 * (i >> 2) + 4 * n + (i & 3); }

struct Unit { int pm, pn; };
struct Gemm { const bf16_t* A; const bf16_t* Bt; int K; };

struct Sched {
    int nM, nN, nwg, G, c, extra;
    __device__ void init(int nM_, int nN_, int G_, int c_, int extra_) { nM = nM_; nN = nN_; nwg = nM * nN; G = G_; c = c_; extra = extra_; }
    __device__ bool next(int i, Unit& u) const {
        const long L = (long)i * G + c;
        if (L < nwg) {
            int wgid = (int)L; { const int q = nwg / NXCD, r = nwg % NXCD, xcd = wgid % NXCD, off = wgid / NXCD; wgid = (xcd < r ? xcd * (q + 1) : r * (q + 1) + (xcd - r) * q) + off; }
            const int nig = WGM * nN, gid = wgid / nig, fm = gid * WGM, gsz = (nM - fm) < WGM ? (nM - fm) : WGM;
            u.pm = fm + ((wgid % nig) % gsz); u.pn = (wgid % nig) / gsz; return true;
        }
        const int e = (int)(L - nwg); if (e >= extra) return false;
        const int t = e >> 2; u.pm = 64 + (e & 3); u.pn = t < 6 ? 3 + t : 9 + t; return true;
    }
};

template <class Epi>
__device__ __forceinline__ void gemm_phase(LAS unsigned char* lds, const Gemm g, const Sched& S, const Epi& E) {
    const int tid = threadIdx.x, wid = __builtin_amdgcn_readfirstlane(tid >> 6), lane = tid & 63, wr = wid >> 2, wc = wid & 3, fr = lane & 15, fq = lane >> 4;
    const int K = g.K, nt = K / BK;
    unsigned voffA[2], voffB[2];
#pragma unroll
    for (int i = 0; i < 2; ++i) { int R, C; stage_rc(tid * 16 + i * 8192, R, C); const int Rb = Epi::PERM ? ((R & ~31) + perm32(R & 31)) : R;
        voffA[i] = (unsigned)(R * K + C) * 2u; voffB[i] = (unsigned)(Rb * K + C) * 2u; }
    const size_t kstep = (size_t)(BK * 2);
    const size_t hstep = (size_t)HALF * K * 2;
    const size_t tstep = 2 * hstep;
    const unsigned ldsw = (unsigned)wid * 1024u;
    const int aoff = lds_byte(wr * 64 + fr, fq * 8), boff = lds_byte(wc * 32 + fr, fq * 8);
#define PG8_SA(b, h) (((b) * 2 + (h)) * HTB)
#define PG8_SB(b, h) ((4 + (b) * 2 + (h)) * HTB)
#define PG8_STAGE(bufoff, gbase, voff) do { _Pragma("unroll") for (int _i = 0; _i < 2; ++_i) \
        __builtin_amdgcn_global_load_lds((const unsigned*)((const char*)(gbase) + (voff)[_i]), (LAS unsigned*)(lds + (bufoff) + ldsw + _i * 8192), 16, 0, 0); } while (0)
#define PG8_LDA(dst, b, h) do { _Pragma("unroll") for (int m = 0; m < 4; ++m) _Pragma("unroll") for (int k = 0; k < 2; ++k) dst[m][k] = *(const LAS bf16x8*)(lds + PG8_SA(b, h) + aoff + m * 2048 + k * 1024); } while (0)
#define PG8_LDB(dst, b, h) do { _Pragma("unroll") for (int n = 0; n < 2; ++n) _Pragma("unroll") for (int k = 0; k < 2; ++k) dst[n][k] = *(const LAS bf16x8*)(lds + PG8_SB(b, h) + boff + n * 2048 + k * 1024); } while (0)
#define PG8_MMA(ai, bj, At, Bt) do { __builtin_amdgcn_s_setprio(1); _Pragma("unroll") for (int m = 0; m < 4; ++m) _Pragma("unroll") for (int n = 0; n < 2; ++n) _Pragma("unroll") for (int k = 0; k < 2; ++k) \
        acc[ai][bj][m][n] = __builtin_amdgcn_mfma_f32_16x16x32_bf16(Bt[n][k], At[m][k], acc[ai][bj][m][n], 0, 0, 0); __builtin_amdgcn_s_setprio(0); } while (0)
#define PG8_WAIT_V(n) asm volatile("s_waitcnt vmcnt(" #n ")" ::: "memory")
#define PG8_WAIT_L(n) asm volatile("s_waitcnt lgkmcnt(" #n ")" ::: "memory")
#define PG8_BAR __builtin_amdgcn_s_barrier()
#define PG8_SCHED __builtin_amdgcn_sched_barrier(0)
    Unit cur, nxt; int ui = 0;
    if (!S.next(0, cur)) return;
    f32x4 acc[2][2][4][2];
#pragma unroll
    for (int a = 0; a < 2; ++a)
#pragma unroll
        for (int b = 0; b < 2; ++b)
#pragma unroll
            for (int m = 0; m < 4; ++m)
#pragma unroll
                for (int n = 0; n < 2; ++n) acc[a][b][m][n] = (f32x4){0.f, 0.f, 0.f, 0.f};
    bf16x8 At[4][2], B0[2][2], B1[2][2];
    const char* cA = (const char*)g.A + (size_t)cur.pm * tstep; const char* cB = (const char*)g.Bt + (size_t)cur.pn * tstep;
    PG8_STAGE(PG8_SB(0, 0), cB, voffB); PG8_STAGE(PG8_SB(0, 1), cB + hstep, voffB); PG8_STAGE(PG8_SA(0, 0), cA, voffA); PG8_STAGE(PG8_SA(0, 1), cA + hstep, voffA);
    if (wr == 1) PG8_BAR;
    PG8_WAIT_V(2); PG8_BAR;
    PG8_STAGE(PG8_SB(1, 0), cB + kstep, voffB); PG8_STAGE(PG8_SA(1, 0), cA + kstep, voffA); PG8_STAGE(PG8_SB(1, 1), cB + hstep + kstep, voffB);
    PG8_WAIT_V(6); PG8_BAR;
    for (;;) {
        const bool has_next = S.next(ui + 1, nxt);
        const char* nA = has_next ? (const char*)g.A + (size_t)nxt.pm * tstep : cA; const char* nB = has_next ? (const char*)g.Bt + (size_t)nxt.pn * tstep : cB;
        for (int t = 0; t < nt; t += 2) {
            const bool last = (t == nt - 2);
            const char* a1 = cA + (size_t)(t + 1) * kstep;
            const char* a2 = last ? nA : cA + (size_t)(t + 2) * kstep; const char* b2 = last ? nB : cB + (size_t)(t + 2) * kstep;
            const char* a3 = a2 + kstep; const char* b3 = b2 + kstep;
            PG8_LDB(B0, 0, 0); PG8_LDB(B1, 0, 1); PG8_SCHED; PG8_LDA(At, 0, 0); PG8_STAGE(PG8_SA(1, 1), a1 + hstep, voffA);
            PG8_WAIT_V(8); PG8_WAIT_L(0); PG8_BAR; PG8_MMA(0, 0, At, B0); PG8_MMA(0, 1, At, B1); PG8_BAR; PG8_SCHED;
            PG8_LDA(At, 0, 1); PG8_STAGE(PG8_SB(0, 0), b2, voffB); PG8_STAGE(PG8_SB(0, 1), b2 + hstep, voffB); PG8_STAGE(PG8_SA(0, 0), a2, voffA);
            PG8_WAIT_V(8); PG8_WAIT_L(0); PG8_BAR; PG8_MMA(1, 0, At, B0); PG8_MMA(1, 1, At, B1); PG8_BAR; PG8_SCHED;
            PG8_LDB(B0, 1, 0); PG8_LDB(B1, 1, 1); PG8_SCHED; PG8_LDA(At, 1, 0); PG8_STAGE(PG8_SA(0, 1), a2 + hstep, voffA);
            PG8_WAIT_V(8); PG8_WAIT_L(0); PG8_BAR; PG8_MMA(0, 0, At, B0); PG8_MMA(0, 1, At, B1); PG8_BAR; PG8_SCHED;
            PG8_LDA(At, 1, 1); PG8_STAGE(PG8_SB(1, 0), b3, voffB); PG8_STAGE(PG8_SB(1, 1), b3 + hstep, voffB); PG8_STAGE(PG8_SA(1, 0), a3, voffA);
            PG8_WAIT_V(8); PG8_WAIT_L(0); PG8_BAR; PG8_MMA(1, 0, At, B0); PG8_MMA(1, 1, At, B1); PG8_BAR; PG8_SCHED;
        }
        if (wr == 0) PG8_BAR;
        E(acc, cur, wr, wc, fr, fq);
        if (!has_next) break;
#pragma unroll
        for (int a = 0; a < 2; ++a)
#pragma unroll
            for (int b = 0; b < 2; ++b)
#pragma unroll
                for (int m = 0; m < 4; ++m)
#pragma unroll
                    for (int n = 0; n < 2; ++n) acc[a][b][m][n] = (f32x4){0.f, 0.f, 0.f, 0.f};
        cur = nxt; cA = nA; cB = nB; ++ui;
        if (wr == 1) PG8_BAR;
    }
    PG8_WAIT_V(0);
    PG8_BAR;
#undef PG8_SA
#undef PG8_SB
#undef PG8_STAGE
#undef PG8_LDA
#undef PG8_LDB
#undef PG8_MMA
#undef PG8_WAIT_V
#undef PG8_WAIT_L
#undef PG8_BAR
#undef PG8_SCHED
}

struct Epi1 {
    static constexpr bool PERM = true;
    bf16_t* O; const float* cs; const float* sn;
    __device__ __forceinline__ void operator()(const f32x4 (&acc)[2][2][4][2], const Unit& u, int wr, int wc, int fr, int fq) const {
        const int row0 = u.pm * BM + wr * 64 + fr, col0 = u.pn * BM + wc * 32 + 8 * fq;
        const bool rope = (u.pn < 6) && (u.pm < 64), gelu = (u.pn >= 24) && (u.pn < 28);
        const float sgn = (fq < 2) ? -1.f : 1.f;
#pragma unroll
        for (int ai = 0; ai < 2; ++ai)
#pragma unroll
            for (int m = 0; m < 4; ++m) {
                const int row = row0 + ai * HALF + m * 16;
                bf16_t* rowp = O + (size_t)row * LDP + col0;
                f32x4 c0 = {1.f, 1.f, 1.f, 1.f}, c1 = c0, s0 = {0.f, 0.f, 0.f, 0.f}, s1 = s0;
                if (rope) { const int s = row & (SEQ - 1); const int pos = (wc & 1) ? (s & 63) : (s >> 6); const int ti = pos * 16 + 8 * (fq & 1);
                    c0 = *(const f32x4*)(cs + ti); c1 = *(const f32x4*)(cs + ti + 4); s0 = *(const f32x4*)(sn + ti); s1 = *(const f32x4*)(sn + ti + 4);
                    s0 = s0 * sgn; s1 = s1 * sgn; }
#pragma unroll
                for (int bj = 0; bj < 2; ++bj) { f32x4 v0 = acc[ai][bj][m][0], v1 = acc[ai][bj][m][1];
                    if (rope) { f32x4 q0, q1;
#pragma unroll
                        for (int e = 0; e < 4; ++e) { q0[e] = __shfl_xor(v0[e], 32); q1[e] = __shfl_xor(v1[e], 32); }
                        v0 = v0 * c0 + q0 * s0; v1 = v1 * c1 + q1 * s1; }
                    if (gelu) {
#pragma unroll
                        for (int e = 0; e < 4; ++e) { v0[e] = gelu_tanh(v0[e]); v1[e] = gelu_tanh(v1[e]); } }
                    u32x4 w; w.x = cvt_pk_bf16(v0[0], v0[1]); w.y = cvt_pk_bf16(v0[2], v0[3]); w.z = cvt_pk_bf16(v1[0], v1[1]); w.w = cvt_pk_bf16(v1[2], v1[3]);
                    *(u32x4*)(rowp + bj * HALF) = w; } }
    }
};
struct Epi2 {
    static constexpr bool PERM = true;
    bf16_t* Yb; float* rowss;
    __device__ __forceinline__ void operator()(const f32x4 (&acc)[2][2][4][2], const Unit& u, int wr, int wc, int fr, int fq) const {
        const int row0 = u.pm * BM + wr * 64 + fr, col0 = u.pn * BM + wc * 32 + 8 * fq;
#pragma unroll
        for (int ai = 0; ai < 2; ++ai)
#pragma unroll
            for (int m = 0; m < 4; ++m) { const int row = row0 + ai * HALF + m * 16; bf16_t* rowp = Yb + (size_t)row * DM + col0; float ss = 0.f;
#pragma unroll
                for (int bj = 0; bj < 2; ++bj) { const f32x4 v0 = acc[ai][bj][m][0], v1 = acc[ai][bj][m][1];
                    ss += (v0[0] * v0[0] + v0[1] * v0[1]) + (v0[2] * v0[2] + v0[3] * v0[3]) + (v1[0] * v1[0] + v1[1] * v1[1]) + (v1[2] * v1[2] + v1[3] * v1[3]);
                    u32x4 w; w.x = cvt_pk_bf16(v0[0], v0[1]); w.y = cvt_pk_bf16(v0[2], v0[3]); w.z = cvt_pk_bf16(v1[0], v1[1]); w.w = cvt_pk_bf16(v1[2], v1[3]);
                    *(u32x4*)(rowp + bj * HALF) = w; }
                ss += __shfl_xor(ss, 16); ss += __shfl_xor(ss, 32);
                if (fq == 0) atomicAdd(rowss + row, ss); }
    }
};
}

namespace att {
constexpr int SHM_V = 64 * 128 * 2, SHM_K = 64 * 128 * 2;
constexpr int WSF_OFF = 2 * SHM_V + 2 * SHM_K;
constexpr int BIAS_OFF = WSF_OFF + 2048;
constexpr int XS = 132;
constexpr float THR = 8.f;
#define KSWZ(row, colB) ((row) * 256 + ((colB) ^ (((row) & 7) << 4)))
#define SBAR() __builtin_amdgcn_sched_barrier(0)
__device__ __forceinline__ int crow(int r, int hi) { return (r & 3) + 8 * (r >> 2) + 4 * hi; }
__device__ __forceinline__ bf16x8 ld8(const bf16_t* p) { return *reinterpret_cast<const bf16x8*>(p); }

template <int MODE> struct ModeC { static constexpr float SC = (MODE == 0) ? 0.125f : 0.08838834764831845f; };

template <int MODE>
__device__ __forceinline__ void partialSM(f32x16& p0, f32x16& p1, float& m_reg, float& mn, float& alpha) {
    constexpr float C = ModeC<MODE>::SC * LOG2E;
    float pmax = p0[0];
#pragma unroll
    for (int r = 1; r < 16; ++r) pmax = fmaxf(pmax, p0[r]);
#pragma unroll
    for (int r = 0; r < 16; ++r) pmax = fmaxf(pmax, p1[r]);
    { auto rr = __builtin_amdgcn_permlane32_swap(__float_as_uint(pmax), __float_as_uint(pmax), false, false);
      pmax = fmaxf(__uint_as_float(rr[0]), __uint_as_float(rr[1])); }
    if (__builtin_expect(__all(pmax - m_reg <= THR / ModeC<MODE>::SC), 1)) { mn = m_reg; alpha = 1.f; }
    else { mn = fmaxf(m_reg, pmax); alpha = __builtin_amdgcn_exp2f((m_reg - mn) * C); m_reg = mn; }
    const float mnC = -mn * C;
#pragma unroll
    for (int r = 0; r < 16; ++r) p0[r] = fmaf(p0[r], C, mnC);
#pragma unroll
    for (int r = 0; r < 16; ++r) p1[r] = fmaf(p1[r], C, mnC);
#pragma unroll
    for (int r = 0; r < 16; ++r) p0[r] = __builtin_amdgcn_exp2f(p0[r]);
}
__device__ __forceinline__ void finishSM(f32x16& p0, f32x16& p1, float alpha, float& l_reg, bf16x8& pa0, bf16x8& pa1, bf16x8& pa2, bf16x8& pa3) {
#pragma unroll
    for (int r = 0; r < 16; ++r) p1[r] = __builtin_amdgcn_exp2f(p1[r]);
    float ps = 0;
#pragma unroll
    for (int r = 0; r < 16; ++r) ps += p0[r];
#pragma unroll
    for (int r = 0; r < 16; ++r) ps += p1[r];
    { auto rr = __builtin_amdgcn_permlane32_swap(__float_as_uint(ps), __float_as_uint(ps), false, false);
      ps = __uint_as_float(rr[0]) + __uint_as_float(rr[1]); }
    l_reg = l_reg * alpha + ps;
#define PK4(P, BASE, OUT) do { unsigned a0 = cvt_pk_bf16(P[BASE + 0], P[BASE + 1]), a1 = cvt_pk_bf16(P[BASE + 2], P[BASE + 3]);   \
    unsigned b0 = cvt_pk_bf16(P[BASE + 4], P[BASE + 5]), b1 = cvt_pk_bf16(P[BASE + 6], P[BASE + 7]);                              \
    auto r0 = __builtin_amdgcn_permlane32_swap(a0, b0, false, false); auto r1 = __builtin_amdgcn_permlane32_swap(a1, b1, false, false); \
    u32x4 w = {r0[0], r1[0], r0[1], r1[1]}; OUT = *reinterpret_cast<bf16x8*>(&w); } while (0)
    PK4(p0, 0, pa0); PK4(p0, 8, pa1); PK4(p1, 0, pa2); PK4(p1, 8, pa3);
#undef PK4
}
template <int MODE>
__device__ __forceinline__ void sm_max(const f32x16& p0, const f32x16& p1, float& m_reg, float& mnC, float& alpha) {
    constexpr float C = ModeC<MODE>::SC * LOG2E;
    float pmax = p0[0];
#pragma unroll
    for (int r = 1; r < 16; ++r) pmax = fmaxf(pmax, p0[r]);
#pragma unroll
    for (int r = 0; r < 16; ++r) pmax = fmaxf(pmax, p1[r]);
    { auto rr = __builtin_amdgcn_permlane32_swap(__float_as_uint(pmax), __float_as_uint(pmax), false, false);
      pmax = fmaxf(__uint_as_float(rr[0]), __uint_as_float(rr[1])); }
    const bool keep = __all(pmax - m_reg <= THR / ModeC<MODE>::SC);
    const float mn = keep ? m_reg : fmaxf(m_reg, pmax);
    alpha = __builtin_amdgcn_exp2f((m_reg - mn) * C);
    m_reg = mn; mnC = -mn * C;
}
template <int MODE>
__device__ __forceinline__ void sm_scale(f32x16& p, float mnC) {
    constexpr float C = ModeC<MODE>::SC * LOG2E;
#pragma unroll
    for (int r = 0; r < 16; ++r) p[r] = fmaf(p[r], C, mnC);
}
__device__ __forceinline__ void sm_exp(f32x16& p) {
#pragma unroll
    for (int r = 0; r < 16; ++r) p[r] = __builtin_amdgcn_exp2f(p[r]);
}
__device__ __forceinline__ void sm_finish(f32x16& p0, f32x16& p1, float alpha, float& l_reg, bf16x8& pa0, bf16x8& pa1, bf16x8& pa2, bf16x8& pa3) {
    float ps = 0;
#pragma unroll
    for (int r = 0; r < 16; ++r) ps += p0[r];
#pragma unroll
    for (int r = 0; r < 16; ++r) ps += p1[r];
    { auto rr = __builtin_amdgcn_permlane32_swap(__float_as_uint(ps), __float_as_uint(ps), false, false);
      ps = __uint_as_float(rr[0]) + __uint_as_float(rr[1]); }
    l_reg = l_reg * alpha + ps;
#define PK4(P, BASE, OUT) do { unsigned a0 = cvt_pk_bf16(P[BASE + 0], P[BASE + 1]), a1 = cvt_pk_bf16(P[BASE + 2], P[BASE + 3]);   \
    unsigned b0 = cvt_pk_bf16(P[BASE + 4], P[BASE + 5]), b1 = cvt_pk_bf16(P[BASE + 6], P[BASE + 7]);                              \
    auto r0 = __builtin_amdgcn_permlane32_swap(a0, b0, false, false); auto r1 = __builtin_amdgcn_permlane32_swap(a1, b1, false, false); \
    u32x4 w = {r0[0], r1[0], r0[1], r1[1]}; OUT = *reinterpret_cast<bf16x8*>(&w); } while (0)
    PK4(p0, 0, pa0); PK4(p0, 8, pa1); PK4(p1, 0, pa2); PK4(p1, 8, pa3);
#undef PK4
}
template <int ND0>
__device__ __forceinline__ void qkt(f32x16& p0, f32x16& p1, const LAS char* Ks, const bf16x8* qr, int r32, int hi, int dbase) {
    p0 = f32x16{}; p1 = f32x16{};
#pragma unroll
    for (int d0 = 0; d0 < ND0; ++d0) { const int cb = ((dbase + d0) * 16 + hi * 8) * 2;
        const bf16x8 b0 = *reinterpret_cast<const LAS bf16x8*>(Ks + KSWZ(r32, cb));
        const bf16x8 b1 = *reinterpret_cast<const LAS bf16x8*>(Ks + KSWZ(32 + r32, cb));
        p0 = __builtin_amdgcn_mfma_f32_32x32x16_bf16(b0, qr[d0], p0, 0, 0, 0);
        p1 = __builtin_amdgcn_mfma_f32_32x32x16_bf16(b1, qr[d0], p1, 0, 0, 0); }
}
__device__ __forceinline__ int v_st(int k, int c) { const int kk = (k & ~0xC) | ((k & 4) << 1) | ((k & 8) >> 1); return ((kk >> 3) * 4 + (c >> 5)) * 512 + ((kk & 7) * 32 + (c & 31)) * 2; }
__device__ __forceinline__ int v_rd_base(int lane) { return ((lane & 3) << 3) | (((lane >> 2) & 3) << 6) | (((lane >> 4) & 1) << 5) | (((lane >> 5) & 1) << 8); }
constexpr int v_rd_off(int d0, int ks, int half) { return d0 * 512 + ks * 4096 + half * 2048; }
template <int OFF> __device__ __forceinline__ s16x4 tr_read(int vb) {
    s16x4 r; asm volatile("ds_read_b64_tr_b16 %0, %1 offset:%2" : "=&v"(r) : "v"(vb), "i"(OFF) : "memory"); return r;
}
template <int D0> __device__ __forceinline__ void pv_one(f32x16& od, int vb, bf16x8 pa0, bf16x8 pa1, bf16x8 pa2, bf16x8 pa3) {
    const s16x4 l0 = tr_read<v_rd_off(D0, 0, 0)>(vb), h0 = tr_read<v_rd_off(D0, 0, 1)>(vb), l1 = tr_read<v_rd_off(D0, 1, 0)>(vb), h1 = tr_read<v_rd_off(D0, 1, 1)>(vb);
    const s16x4 l2 = tr_read<v_rd_off(D0, 2, 0)>(vb), h2 = tr_read<v_rd_off(D0, 2, 1)>(vb), l3 = tr_read<v_rd_off(D0, 3, 0)>(vb), h3 = tr_read<v_rd_off(D0, 3, 1)>(vb);
    asm volatile("s_waitcnt lgkmcnt(0)" ::: "memory"); SBAR();
#define PKV(L, H) (bf16x8){L[0], L[1], L[2], L[3], H[0], H[1], H[2], H[3]}
    od = __builtin_amdgcn_mfma_f32_32x32x16_bf16(pa0, PKV(l0, h0), od, 0, 0, 0);
    od = __builtin_amdgcn_mfma_f32_32x32x16_bf16(pa1, PKV(l1, h1), od, 0, 0, 0);
    od = __builtin_amdgcn_mfma_f32_32x32x16_bf16(pa2, PKV(l2, h2), od, 0, 0, 0);
    od = __builtin_amdgcn_mfma_f32_32x32x16_bf16(pa3, PKV(l3, h3), od, 0, 0, 0);
#undef PKV
}
__device__ __forceinline__ void pv_d0(f32x16* o, int vb, bf16x8 pa0, bf16x8 pa1, bf16x8 pa2, bf16x8 pa3) {
    pv_one<0>(o[0], vb, pa0, pa1, pa2, pa3); pv_one<1>(o[1], vb, pa0, pa1, pa2, pa3); pv_one<2>(o[2], vb, pa0, pa1, pa2, pa3); pv_one<3>(o[3], vb, pa0, pa1, pa2, pa3);
}

template <bool MLP>
__device__ __forceinline__ void final_pass(const LAS float* X, int nrows, const bf16_t* Z, bf16_t* Y, const float* g, float factor, const bf16_t* U, const float* rowb) {
    int t_ = threadIdx.x; asm volatile("" : "+v"(t_));
    for (int idx = t_; idx < nrows * 4; idx += 512) {
        const int row = idx >> 2, seg = idx & 3;
        f32x4 x[8];
#pragma unroll
        for (int i = 0; i < 8; ++i) x[i] = *reinterpret_cast<const LAS f32x4*>(X + row * XS + seg * 32 + 4 * i);
        if (MLP) { const float rb = rowb[row]; const u32x4* up = reinterpret_cast<const u32x4*>(U + (size_t)row * LDP + seg * 32);
#pragma unroll
            for (int i = 0; i < 4; ++i) { const u32x4 w = up[i];
                x[2 * i][0] = (x[2 * i][0] + rb) * bf_lo(w.x); x[2 * i][1] = (x[2 * i][1] + rb) * bf_hi(w.x); x[2 * i][2] = (x[2 * i][2] + rb) * bf_lo(w.y); x[2 * i][3] = (x[2 * i][3] + rb) * bf_hi(w.y);
                x[2 * i + 1][0] = (x[2 * i + 1][0] + rb) * bf_lo(w.z); x[2 * i + 1][1] = (x[2 * i + 1][1] + rb) * bf_hi(w.z); x[2 * i + 1][2] = (x[2 * i + 1][2] + rb) * bf_lo(w.w); x[2 * i + 1][3] = (x[2 * i + 1][3] + rb) * bf_hi(w.w); } }
        float ss = 0.f;
#pragma unroll
        for (int i = 0; i < 8; ++i) ss += (x[i][0] * x[i][0] + x[i][1] * x[i][1]) + (x[i][2] * x[i][2] + x[i][3] * x[i][3]);
        ss += __shfl_xor(ss, 1); ss += __shfl_xor(ss, 2);
        const float rstd = __builtin_amdgcn_rsqf(ss * (1.0f / 128.0f) + EPS) * factor;
        const u32x4* zp = reinterpret_cast<const u32x4*>(Z + (size_t)row * LDP + seg * 32);
        const f32x4* gp = reinterpret_cast<const f32x4*>(g + seg * 32);
        u32x4* yp = reinterpret_cast<u32x4*>(Y + (size_t)row * DM + seg * 32);
#pragma unroll
        for (int i = 0; i < 4; ++i) { const u32x4 w = zp[i]; const f32x4 g0 = gp[2 * i], g1 = gp[2 * i + 1]; const f32x4 a = x[2 * i], b = x[2 * i + 1];
            u32x4 o;
            o.x = cvt_pk_bf16(a[0] * rstd * g0[0] * silu_f(bf_lo(w.x)), a[1] * rstd * g0[1] * silu_f(bf_hi(w.x)));
            o.y = cvt_pk_bf16(a[2] * rstd * g0[2] * silu_f(bf_lo(w.y)), a[3] * rstd * g0[3] * silu_f(bf_hi(w.y)));
            o.z = cvt_pk_bf16(b[0] * rstd * g1[0] * silu_f(bf_lo(w.z)), b[1] * rstd * g1[1] * silu_f(bf_hi(w.z)));
            o.w = cvt_pk_bf16(b[2] * rstd * g1[2] * silu_f(bf_lo(w.w)), b[3] * rstd * g1[3] * silu_f(bf_hi(w.w)));
            yp[i] = o; }
    }
}

struct AttnArgs {
    const bf16_t* Q;
    const bf16_t *K1, *K2, *V1, *V2;
    int n1, n2, NT;
    int R0, kfirst;
    const float* rpb;
    const bf16_t* Z; bf16_t* Y; const float* g; float factor, lam;
};
template <int MODE>
__device__ __forceinline__ void attn_epilogue(LAS char* lds, const AttnArgs& a, f32x16 (&o)[4], float l_reg, LAS float* li_l, int map, int qg, int r32, int hi) {
    if (hi == 0) li_l[r32] = l_reg; asm volatile("s_waitcnt lgkmcnt(0)" ::: "memory");
    float rli[16];
#pragma unroll
    for (int r = 0; r < 16; ++r) rli[r] = __builtin_amdgcn_rcpf(li_l[crow(r, hi)]);
    __syncthreads();
    LAS float* X = (LAS float*)lds;
    if (MODE != 0 || map == 0) {
#pragma unroll
        for (int r = 0; r < 16; ++r)
#pragma unroll
            for (int d0 = 0; d0 < 4; ++d0) X[(qg * 32 + crow(r, hi)) * XS + d0 * 32 + r32] = o[d0][r] * rli[r];
    }
    __syncthreads();
    if (MODE == 0) {
        if (map == 1) {
#pragma unroll
            for (int r = 0; r < 16; ++r)
#pragma unroll
                for (int d0 = 0; d0 < 4; ++d0) { LAS float* xp = X + (qg * 32 + crow(r, hi)) * XS + d0 * 32 + r32; *xp = *xp - a.lam * (o[d0][r] * rli[r]); }
        }
        __syncthreads();
    }
    final_pass<false>(X, (MODE == 0) ? 128 : 256, a.Z, a.Y, a.g, a.factor, nullptr, nullptr);
    __syncthreads();
}
template <int MODE>
__device__ __forceinline__ void attn_unit(LAS char* lds, const AttnArgs& a) {
    constexpr int ND0 = (MODE == 0) ? 4 : 8;
    int tid_ = threadIdx.x; asm volatile("" : "+v"(tid_));
    const int tid = tid_, wid = __builtin_amdgcn_readfirstlane(tid >> 6), lane = tid & 63, r32 = lane & 31, hi = lane >> 5;
    const int map = (MODE == 0) ? (wid >> 2) : 0, qg = (MODE == 0) ? (wid & 3) : wid;
    LAS char* V_lds = lds; LAS char* K_lds = lds + 2 * SHM_V;
    LAS float* wsf = (LAS float*)(lds + WSF_OFF) + wid * 64; LAS float* li_l = wsf; LAS float* al_l = wsf + 32;
    float m_reg = -1e30f, l_reg = 0; f32x16 o[4] = {}; bf16x8 qr[ND0];
    const bf16_t* Qw = a.Q + (size_t)(qg * 32 + r32) * LDP + map * 64 + hi * 8;
#pragma unroll
    for (int d0 = 0; d0 < ND0; ++d0) qr[d0] = ld8(Qw + d0 * 16);
    const int sr = tid >> 4, sc = (tid & 15) * 8, vst0 = v_st(sr, sc), vst1 = v_st(32 + sr, sc);
    const int vb0 = (int)(uintptr_t)V_lds + v_rd_base(lane);
    const int n1 = a.n1, n2 = a.n2, NT = a.NT;
    struct { bf16x8 vs0, vs1, ks0, ks1; } sr_[2];
#define TILE_PTRS(j) const int _j = (j); const int _j2 = min(_j - n1, n2 - 1); \
    const bf16_t* _Kt = (_j < n1) ? a.K1 + (size_t)_j * 64 * LDP : a.K2 + (size_t)_j2 * 64 * LDP; \
    const bf16_t* _Vt = (_j < n1) ? a.V1 + (size_t)_j * 64 * LDP : a.V2 + (size_t)_j2 * 64 * LDP;
#define SLOAD(i, j) do { TILE_PTRS(j); sr_[i].vs0 = ld8(_Vt + (size_t)sr * LDP + sc); sr_[i].vs1 = ld8(_Vt + (size_t)(32 + sr) * LDP + sc); \
    sr_[i].ks0 = ld8(_Kt + (size_t)sr * LDP + sc); sr_[i].ks1 = ld8(_Kt + (size_t)(32 + sr) * LDP + sc); } while (0)
#define SWRITE(b, i) do { *(LAS bf16x8*)(V_lds + (b) * SHM_V + vst0) = sr_[i].vs0; *(LAS bf16x8*)(V_lds + (b) * SHM_V + vst1) = sr_[i].vs1; const int kc = sc * 2; \
    *(LAS bf16x8*)(K_lds + (b) * SHM_K + KSWZ(sr, kc)) = sr_[i].ks0; *(LAS bf16x8*)(K_lds + (b) * SHM_K + KSWZ(32 + sr, kc)) = sr_[i].ks1; } while (0)
#define SWAIT() asm volatile("s_waitcnt vmcnt(4)" ::: "memory")
#define RESC(al) do { if (__any((al) < 1.f)) { if (hi == 0) al_l[r32] = (al); asm volatile("s_waitcnt lgkmcnt(0)" ::: "memory"); \
    _Pragma("unroll") for (int d = 0; d < 4; ++d) _Pragma("unroll") for (int r = 0; r < 16; ++r) o[d][r] *= al_l[crow(r, hi)]; } } while (0)
#define PIN(X) asm volatile("" : "+v"(X))
#define PV_SM(VB, Q0, Q1, MNC, AL) do { \
    pv_one<0>(o[0], (VB), pa0, pa1, pa2, pa3); sm_max<MODE>(Q0, Q1, m_reg, MNC, AL); PIN(MNC); PIN(AL); \
    pv_one<1>(o[1], (VB), pa0, pa1, pa2, pa3); sm_scale<MODE>(Q0, MNC); sm_scale<MODE>(Q1, MNC); PIN(Q0); PIN(Q1); \
    pv_one<2>(o[2], (VB), pa0, pa1, pa2, pa3); sm_exp(Q0); PIN(Q0); \
    pv_one<3>(o[3], (VB), pa0, pa1, pa2, pa3); sm_exp(Q1); PIN(Q1); SBAR(); } while (0)
    f32x16 pA0, pA1, pB0, pB1; float mcA, mcB, alA, alB; bf16x8 pa0, pa1, pa2, pa3;
    SLOAD(0, 0); asm volatile("s_waitcnt vmcnt(0)" ::: "memory"); SWRITE(0, 0); __syncthreads();
    qkt<ND0>(pA0, pA1, K_lds, qr, r32, hi, map * 4);
    sm_max<MODE>(pA0, pA1, m_reg, mcA, alA); sm_scale<MODE>(pA0, mcA); sm_scale<MODE>(pA1, mcA); sm_exp(pA0); sm_exp(pA1);
    SLOAD(1, 1); if (2 < NT) SLOAD(0, 2);
    SWAIT(); SWRITE(1, 1); __syncthreads();
    for (int j = 1; j + 1 < NT; j += 2) {
        SBAR(); qkt<ND0>(pB0, pB1, K_lds + SHM_K, qr, r32, hi, map * 4);
        sm_finish(pA0, pA1, alA, l_reg, pa0, pa1, pa2, pa3); SBAR();
        SLOAD(1, j + 2); SBAR();
        PV_SM(vb0, pB0, pB1, mcB, alB);
        __syncthreads(); SWAIT(); SWRITE(0, 0);
        RESC(alB); __syncthreads();
        SBAR(); qkt<ND0>(pA0, pA1, K_lds, qr, r32, hi, map * 4);
        sm_finish(pB0, pB1, alB, l_reg, pa0, pa1, pa2, pa3); SBAR();
        if (j + 3 < NT) SLOAD(0, j + 3); SBAR();
        PV_SM(vb0 + SHM_V, pA0, pA1, mcA, alA);
        __syncthreads(); SWAIT(); SWRITE(1, 1);
        RESC(alA); __syncthreads();
    }
    SBAR(); qkt<ND0>(pB0, pB1, K_lds + SHM_K, qr, r32, hi, map * 4);
    sm_finish(pA0, pA1, alA, l_reg, pa0, pa1, pa2, pa3); SBAR();
    PV_SM(vb0, pB0, pB1, mcB, alB);
    RESC(alB);
    sm_finish(pB0, pB1, alB, l_reg, pa0, pa1, pa2, pa3); SBAR();
    pv_d0(o, vb0 + SHM_V, pa0, pa1, pa2, pa3);
    asm volatile("s_waitcnt vmcnt(0)" ::: "memory");
    attn_epilogue<MODE>(lds, a, o, l_reg, li_l, map, qg, r32, hi);
#undef TILE_PTRS
#undef SLOAD
#undef SWRITE
#undef SWAIT
#undef RESC
#undef PV_SM
#undef PIN
}

__device__ __forceinline__ void na_unit(LAS char* lds, const AttnArgs& a) {
    constexpr float SC = ModeC<1>::SC;
    int tid_ = threadIdx.x; asm volatile("" : "+v"(tid_));
    const int tid = tid_, wid = __builtin_amdgcn_readfirstlane(tid >> 6), lane = tid & 63, r32 = lane & 31, hi = lane >> 5;
    LAS char* V_lds = lds; LAS char* K_lds = lds + 2 * SHM_V;
    LAS float* wsf = (LAS float*)(lds + WSF_OFF) + wid * 64; LAS float* li_l = wsf; LAS float* al_l = wsf + 32;
    LAS float* bias_l = (LAS float*)(lds + BIAS_OFF);
    float m_reg = -1e30f, l_reg = 0; f32x16 o[4] = {}; bf16x8 qr[8];
    const bf16_t* Qw = a.Q + (size_t)(wid * 32 + r32) * LDP + hi * 8;
#pragma unroll
    for (int d0 = 0; d0 < 8; ++d0) qr[d0] = ld8(Qw + d0 * 16);
    const int nr = a.R0 + (wid >> 1), nqc = 32 * (wid & 1) + r32;
    const int ncs = min(max(nqc - 8, 0), 48), nrs = min(max(nr - 4, 0), 56);
    if (tid < 465) bias_l[tid] = a.rpb[tid] * (1.0f / SC);
    const int sr = tid >> 4, sc = (tid & 15) * 8, vst0 = v_st(sr, sc), vst1 = v_st(32 + sr, sc);
    const int vb0 = (int)(uintptr_t)V_lds + v_rd_base(lane);
    const int n1 = a.n1, NT = a.n1 + a.n2;
    bf16x8 vs0, vs1, ks0, ks1;
#define NA_SLOAD(j) do { const int _j = (j); const bf16_t* _Kt = (_j < n1) ? a.K1 + (size_t)_j * 64 * LDP : a.K2 + (size_t)(_j - n1) * 64 * LDP; \
    const bf16_t* _Vt = (_j < n1) ? a.V1 + (size_t)_j * 64 * LDP : a.V2 + (size_t)(_j - n1) * 64 * LDP; \
    vs0 = ld8(_Vt + (size_t)sr * LDP + sc); vs1 = ld8(_Vt + (size_t)(32 + sr) * LDP + sc); ks0 = ld8(_Kt + (size_t)sr * LDP + sc); ks1 = ld8(_Kt + (size_t)(32 + sr) * LDP + sc); } while (0)
    NA_SLOAD(0);
    for (int j = 0; j < NT; ++j) {
        const int buf = j & 1;
        { const int kc = sc * 2;
          *(LAS bf16x8*)(V_lds + buf * SHM_V + vst0) = vs0; *(LAS bf16x8*)(V_lds + buf * SHM_V + vst1) = vs1;
          *(LAS bf16x8*)(K_lds + buf * SHM_K + KSWZ(sr, kc)) = ks0; *(LAS bf16x8*)(K_lds + buf * SHM_K + KSWZ(32 + sr, kc)) = ks1; }
        if (j + 1 < NT) NA_SLOAD(j + 1);
        __syncthreads();
        const int kr = a.kfirst + j;
        const bool loc = j < n1;
        const bool act = loc ? (kr >= nrs && kr <= nrs + 7) : true;
        if (act) {
            f32x16 p0, p1; float mn, al; bf16x8 pa0, pa1, pa2, pa3;
            qkt<8>(p0, p1, K_lds + buf * SHM_K, qr, r32, hi, 0);
            if (loc) {
                const int rel = kr - nr + 7; const LAS float* bl = bias_l + rel * 31 + 15 - nqc;
#pragma unroll
                for (int r = 0; r < 16; ++r) { const int kc0 = crow(r, hi);
                    const bool v0 = (unsigned)(kc0 - ncs) < 16u; const float bb0 = bl[min(max(kc0, nqc - 15), nqc + 15)];
                    p0[r] = v0 ? p0[r] + bb0 : -1e30f; }
                asm volatile("" ::: "memory");
#pragma unroll
                for (int r = 0; r < 16; ++r) { const int kc1 = 32 + crow(r, hi);
                    const bool v1 = (unsigned)(kc1 - ncs) < 16u; const float bb1 = bl[min(max(kc1, nqc - 15), nqc + 15)];
                    p1[r] = v1 ? p1[r] + bb1 : -1e30f; }
            }
            partialSM<1>(p0, p1, m_reg, mn, al);
            if (__any(al < 1.f)) { if (hi == 0) al_l[r32] = al; asm volatile("s_waitcnt lgkmcnt(0)" ::: "memory");
#pragma unroll
                for (int d = 0; d < 4; ++d)
#pragma unroll
                    for (int r = 0; r < 16; ++r) o[d][r] *= al_l[crow(r, hi)]; }
            finishSM(p0, p1, al, l_reg, pa0, pa1, pa2, pa3);
            pv_d0(o, vb0 + buf * SHM_V, pa0, pa1, pa2, pa3);
        }
    }
#undef NA_SLOAD
    attn_epilogue<1>(lds, a, o, l_reg, li_l, 0, wid, r32, hi);
}

struct MlpArgs { const bf16_t* Prow; bf16_t* Yrow; const bf16_t* Wsb; const float *lng, *lnb, *bs, *mg; int g; };
__device__ __forceinline__ void mlp_unit(LAS char* lds, const MlpArgs& a) {
    int tid_ = threadIdx.x; asm volatile("" : "+v"(tid_));
    const int tid = tid_, wid = __builtin_amdgcn_readfirstlane(tid >> 6), lane = tid & 63, r32 = lane & 31, hi = lane >> 5;
    const int sr = tid >> 4, sc = (tid & 15) * 8, g = a.g;
    const f32x4 lg0 = *(const f32x4*)(a.lng + g * 128 + sc), lg1 = *(const f32x4*)(a.lng + g * 128 + sc + 4);
    const f32x4 lb0 = *(const f32x4*)(a.lnb + g * 128 + sc), lb1 = *(const f32x4*)(a.lnb + g * 128 + sc + 4);
#pragma unroll
    for (int t = 0; t < 4; ++t) {
        const int q = t * 32 + sr;
        const u32x4 w = *(const u32x4*)(a.Prow + (size_t)q * LDP + C_MV + g * 128 + sc);
        float v[8] = {bf_lo(w.x), bf_hi(w.x), bf_lo(w.y), bf_hi(w.y), bf_lo(w.z), bf_hi(w.z), bf_lo(w.w), bf_hi(w.w)};
        float s = 0.f;
#pragma unroll
        for (int e = 0; e < 8; ++e) s += v[e];
        s += __shfl_xor(s, 1); s += __shfl_xor(s, 2); s += __shfl_xor(s, 4); s += __shfl_xor(s, 8);
        const float mu = s * (1.0f / 128.0f); float qq = 0.f;
#pragma unroll
        for (int e = 0; e < 8; ++e) { v[e] -= mu; qq += v[e] * v[e]; }
        qq += __shfl_xor(qq, 1); qq += __shfl_xor(qq, 2); qq += __shfl_xor(qq, 4); qq += __shfl_xor(qq, 8);
        const float rstd = __builtin_amdgcn_rsqf(qq * (1.0f / 128.0f) + EPS);
        u32x4 ow;
        ow.x = cvt_pk_bf16(v[0] * rstd * lg0[0] + lb0[0], v[1] * rstd * lg0[1] + lb0[1]); ow.y = cvt_pk_bf16(v[2] * rstd * lg0[2] + lb0[2], v[3] * rstd * lg0[3] + lb0[3]);
        ow.z = cvt_pk_bf16(v[4] * rstd * lg1[0] + lb1[0], v[5] * rstd * lg1[1] + lb1[1]); ow.w = cvt_pk_bf16(v[6] * rstd * lg1[2] + lb1[2], v[7] * rstd * lg1[3] + lb1[3]);
        *(LAS u32x4*)(lds + (q >> 6) * SHM_V + v_st(q & 63, sc)) = ow;
    }
    const int prow0 = 32 * (wid & 3), dsel = wid >> 2;
    bf16x8 pa[8];
    const bf16_t* wp = a.Wsb + ((size_t)(g * 128 + prow0 + r32)) * 128 + 8 * hi;
#pragma unroll
    for (int s = 0; s < 8; ++s) pa[s] = ld8(wp + 16 * s);
    __syncthreads();
    f32x16 o0 = {}, o1 = {};
    const int vb0 = (int)(uintptr_t)lds + v_rd_base(lane);
    if (dsel == 0) { pv_one<0>(o0, vb0, pa[0], pa[1], pa[2], pa[3]); pv_one<1>(o1, vb0, pa[0], pa[1], pa[2], pa[3]);
                     pv_one<0>(o0, vb0 + SHM_V, pa[4], pa[5], pa[6], pa[7]); pv_one<1>(o1, vb0 + SHM_V, pa[4], pa[5], pa[6], pa[7]); }
    else           { pv_one<2>(o0, vb0, pa[0], pa[1], pa[2], pa[3]); pv_one<3>(o1, vb0, pa[0], pa[1], pa[2], pa[3]);
                     pv_one<2>(o0, vb0 + SHM_V, pa[4], pa[5], pa[6], pa[7]); pv_one<3>(o1, vb0 + SHM_V, pa[4], pa[5], pa[6], pa[7]); }
    __syncthreads();
    LAS float* X = (LAS float*)lds;
#pragma unroll
    for (int r = 0; r < 16; ++r) { X[(prow0 + crow(r, hi)) * XS + (2 * dsel) * 32 + r32] = o0[r]; X[(prow0 + crow(r, hi)) * XS + (2 * dsel + 1) * 32 + r32] = o1[r]; }
    __syncthreads();
    final_pass<true>(X, 128, a.Prow + C_MZ + g * 128, a.Yrow + 1536 + g * 128, a.mg + g * 128, 1.0f, a.Prow + C_MU + g * 128, a.bs + g * 128);
    __syncthreads();
}
}

__device__ __forceinline__ void p0_transpose_item(const float* W, int K, int N, bf16_t* WT, LAS float* scr, int item, int lane) {
    const int nblk = N / 32, kb = item / nblk, nb = item % nblk, k0 = 64 * kb, n0 = 32 * nb;
#pragma unroll 8
    for (int i = 0; i < 32; ++i) { const int kk = 2 * i + (lane >> 5); scr[kk * 33 + (lane & 31)] = W[(size_t)(k0 + kk) * N + n0 + (lane & 31)]; }
    asm volatile("s_waitcnt lgkmcnt(0)" ::: "memory");
    const int c = lane & 7;
#pragma unroll
    for (int j = 0; j < 4; ++j) { const int n = (lane >> 3) + 8 * j; const LAS float* s = scr + (8 * c) * 33 + n;
        u32x4 o; o.x = cvt_pk_bf16(s[0 * 33], s[1 * 33]); o.y = cvt_pk_bf16(s[2 * 33], s[3 * 33]); o.z = cvt_pk_bf16(s[4 * 33], s[5 * 33]); o.w = cvt_pk_bf16(s[6 * 33], s[7 * 33]);
        *(u32x4*)(WT + (size_t)(n0 + n) * K + k0 + 8 * c) = o; }
    asm volatile("s_waitcnt lgkmcnt(0)" ::: "memory");
}

__device__ __forceinline__ void phase0(const Params& p, LAS unsigned char* lds, int tid, int lane, int wave) {
    const int gw = blockIdx.x * 8 + wave, ngw = gridDim.x * 8;
    unsigned char* ws = p.ws;
    LAS float* scr = (LAS float*)(lds + wave * 16384);
    bf16_t* WinT = (bf16_t*)(ws + WS_WIN); bf16_t* WoutT = (bf16_t*)(ws + WS_WOUT);
    constexpr int I_IN = (DM / 64) * (INW / 32), I_OUT = (DM / 64) * (DM / 32), I_L = I_IN + I_OUT;
    for (int it = gw; it < 2 * I_L; it += ngw) {
        const int l = it / I_L, r = it % I_L;
        if (r < I_IN) p0_transpose_item(p.w_in + (size_t)l * DM * INW, DM, INW, WinT + (size_t)l * INW * DM, scr, r, lane);
        else p0_transpose_item(p.w_out + (size_t)l * DM * DM, DM, DM, WoutT + (size_t)l * DM * DM, scr, r - I_IN, lane);
    }
    float* mod = (float*)(ws + WS_CTL + CTL_MOD);
    for (int it = gw; it < 768; it += ngw) {
        const int l = it / 384, r = it % 384, kc = r / 24, nc = r % 24;
        const float* W = p.ada_w + (size_t)l * DM * 6144 + nc * 256 + lane * 4;
        f32x4 acc[5];
#pragma unroll
        for (int b = 0; b < 5; ++b) acc[b] = (f32x4){0.f, 0.f, 0.f, 0.f};
        for (int half = 0; half < 2; ++half) {
            const int k0 = kc * 128 + half * 64;
            float sv[5];
#pragma unroll
            for (int b = 0; b < 4; ++b) sv[b] = silu_f(p.c[b * DM + k0 + lane]);
            sv[4] = silu_f(p.c_ctx[k0 + lane]);
#pragma unroll 8
            for (int kk = 0; kk < 64; ++kk) {
                const f32x4 w4 = *(const f32x4*)(W + (size_t)(k0 + kk) * 6144);
#pragma unroll
                for (int b = 0; b < 5; ++b) { const float s = __uint_as_float(__builtin_amdgcn_readlane(__float_as_uint(sv[b]), kk)); acc[b] += w4 * s; }
            }
        }
        if (kc == 0) { const f32x4 bv = *(const f32x4*)(p.ada_b + l * 6144 + nc * 256 + lane * 4);
#pragma unroll
            for (int b = 0; b < 5; ++b) acc[b] += bv; }
#pragma unroll
        for (int b = 0; b < 5; ++b) { float* dst = mod + ((size_t)(l * 5 + b)) * 6144 + nc * 256 + lane * 4;
#pragma unroll
            for (int e = 0; e < 4; ++e) atomicAdd(dst + e, acc[b][e]); }
    }
    float* tab = (float*)(ws + WS_TAB);
    if (gw == ngw - 1) {
        for (int idx = lane; idx < 1024; idx += 64) { const int pos = idx >> 4, i = idx & 15;
            const float freq = powf(10000.0f, -(float)i / 16.0f); const float ang = (float)pos * freq;
            tab[idx] = cosf(ang); tab[1024 + idx] = sinf(ang); }
    }
    if (gw == ngw - 2) {
        for (int l = 0; l < 2; ++l) {
            const float s1 = wave_sum(p.lq1[l * 64 + lane] * p.lk1[l * 64 + lane]), s2 = wave_sum(p.lq2[l * 64 + lane] * p.lk2[l * 64 + lane]);
            const float lam_init = 0.8f - 0.6f * expf(-0.3f * (float)l);
            if (lane == 0) tab[2048 + l] = expf(s1) - expf(s2) + lam_init;
        }
    }
    { bf16_t* wsb = (bf16_t*)(ws + WS_WSB); const int gt = blockIdx.x * 512 + tid;
      if (gt < 16384) { const f32x4 a = *(const f32x4*)(p.mws + gt * 8), b = *(const f32x4*)(p.mws + gt * 8 + 4);
          u32x4 o; o.x = cvt_pk_bf16(a[0], a[1]); o.y = cvt_pk_bf16(a[2], a[3]); o.z = cvt_pk_bf16(b[0], b[1]); o.w = cvt_pk_bf16(b[2], b[3]); *(u32x4*)(wsb + gt * 8) = o; } }
}

template <int L>
__device__ __forceinline__ void norm_phase(const Params& p, int lane, int wave) {
    const int gw = blockIdx.x * 8 + wave, ngw = gridDim.x * 8;
    unsigned char* ws = p.ws;
    const float* mod = (const float*)(ws + WS_CTL + CTL_MOD);
    const float* rowss = (const float*)(ws + WS_CTL + CTL_ROWSS);
    const bf16_t* Y0 = (const bf16_t*)(ws + WS_Y0); const bf16_t* Y1 = (const bf16_t*)(ws + WS_P);
    bf16_t* H = (bf16_t*)(ws + WS_H);
    const int nrows = (L == 2) ? NLAT : MROWS;
    for (int row = gw; row < nrows; row += ngw) {
        const bool isctx = row >= NLAT; const int b = isctx ? 4 : (row >> 12);
        const float* xin = isctx ? p.ctx + (size_t)(row - NLAT) * DM : p.x + (size_t)row * DM;
        f32x4 v[4][2];
#pragma unroll
        for (int j = 0; j < 4; ++j) { v[j][0] = *(const f32x4*)(xin + 8 * lane + 512 * j); v[j][1] = *(const f32x4*)(xin + 8 * lane + 512 * j + 4); }
#pragma unroll
        for (int lp = 0; lp < 2; ++lp) {
            if (lp < L) {
                const float rs = __builtin_amdgcn_rsqf(rowss[lp * MROWS + row] * (1.0f / DM) + EPS);
                const float* gate = mod + ((size_t)(lp * 5 + b)) * 6144 + 4096;
                const float* pg = p.post_g + lp * DM;
                const bf16_t* Yb = (lp == 0) ? Y0 : Y1;
#pragma unroll
                for (int j = 0; j < 4; ++j) { const int cidx = 8 * lane + 512 * j;
                    const u32x4 w = *(const u32x4*)(Yb + (size_t)row * DM + cidx);
                    const f32x4 g0 = *(const f32x4*)(gate + cidx), g1 = *(const f32x4*)(gate + cidx + 4), q0 = *(const f32x4*)(pg + cidx), q1 = *(const f32x4*)(pg + cidx + 4);
                    const f32x4 y0 = {bf_lo(w.x), bf_hi(w.x), bf_lo(w.y), bf_hi(w.y)}, y1 = {bf_lo(w.z), bf_hi(w.z), bf_lo(w.w), bf_hi(w.w)};
                    v[j][0] = v[j][0] + g0 * (y0 * rs) * q0; v[j][1] = v[j][1] + g1 * (y1 * rs) * q1; }
            }
        }
        if (L == 2) {
            float* xo = p.out + (size_t)row * DM;
#pragma unroll
            for (int j = 0; j < 4; ++j) { *(f32x4*)(xo + 8 * lane + 512 * j) = v[j][0]; *(f32x4*)(xo + 8 * lane + 512 * j + 4) = v[j][1]; }
        } else {
            float ss = 0.f;
#pragma unroll
            for (int j = 0; j < 4; ++j)
#pragma unroll
                for (int e = 0; e < 2; ++e) ss += (v[j][e][0] * v[j][e][0] + v[j][e][1] * v[j][e][1]) + (v[j][e][2] * v[j][e][2] + v[j][e][3] * v[j][e][3]);
            ss = wave_sum(ss);
            const float rstd = __builtin_amdgcn_rsqf(ss * (1.0f / DM) + EPS);
            const float* shift = mod + ((size_t)(L * 5 + b)) * 6144; const float* scale = shift + 2048; const float* pg = p.pre_g + L * DM;
#pragma unroll
            for (int j = 0; j < 4; ++j) { const int cidx = 8 * lane + 512 * j;
                f32x4 hv[2];
#pragma unroll
                for (int e = 0; e < 2; ++e) { const f32x4 sh = *(const f32x4*)(shift + cidx + 4 * e), scv = *(const f32x4*)(scale + cidx + 4 * e), g4 = *(const f32x4*)(pg + cidx + 4 * e);
                    hv[e] = (v[j][e] * rstd) * g4 * (scv + 1.0f) + sh; }
                u32x4 w; w.x = cvt_pk_bf16(hv[0][0], hv[0][1]); w.y = cvt_pk_bf16(hv[0][2], hv[0][3]); w.z = cvt_pk_bf16(hv[1][0], hv[1][1]); w.w = cvt_pk_bf16(hv[1][2], hv[1][3]);
                *(u32x4*)(H + (size_t)row * DM + cidx) = w; }
        }
    }
}

template <int L>
__device__ __forceinline__ void mixer_phase(const Params& p, LAS unsigned char* lds8, int tid, int qslot, int umask) {
    LAS char* lds = (LAS char*)lds8;
    unsigned char* ws = p.ws;
    const bf16_t* P = (const bf16_t*)(ws + WS_P);
    bf16_t* Y = (bf16_t*)(ws + WS_H);
    const float* tab = (const float*)(ws + WS_TAB);
    const float lam = tab[2048 + L];
    const float lam_init = (L == 0) ? 0.2f : 0.35550906759096926f;
    unsigned* qctr = (unsigned*)(ws + WS_CTL + CTL_QCTR) + 64 * qslot;
    volatile LAS unsigned* misc = (volatile LAS unsigned*)(lds8 + MISC_OFF);
    constexpr int N_DIFF = NB * 6 * 32, N_NA = NB * 6 * 16, N_DIFFC = (L == 0) ? NB * 6 * 2 : 0, N_SMC = (L == 0) ? NB * 6 : 0, N_MLP = NB * 32 * 4, N_MLPC = (L == 0) ? NB * 2 * 4 : 0;
    constexpr int NU = N_DIFF + N_NA + N_DIFFC + N_SMC + N_MLP + N_MLPC;
#define PULL() do { if (tid == 0) misc[0] = atomicAdd(qctr, 1u); __syncthreads(); u = (int)misc[0]; __syncthreads(); } while (0)
    int u; PULL();
    constexpr int E_DIFF = N_DIFF, E_NA = E_DIFF + N_NA, E_DIFFC = E_NA + N_DIFFC, E_SMC = E_DIFFC + N_SMC;
    while (u < E_DIFF) { if (!(umask & 1)) { PULL(); continue; }
        const int qb = u & 31, h = (u >> 5) % 6, b = u / 192;
        att::AttnArgs a{};
        const size_t t0 = (size_t)b * SEQ, tq = t0 + qb * 128, tc = (size_t)NLAT + b * CTXL;
        a.Q = P + tq * LDP + C_AQ + h * HD;
        a.K1 = P + t0 * LDP + C_AK + h * HD; a.K2 = P + tc * LDP + C_AK + h * HD;
        a.V1 = P + t0 * LDP + C_AV + h * HD; a.V2 = P + tc * LDP + C_AV + h * HD;
        a.n1 = 64; a.n2 = 4; a.NT = 68;
        a.Z = P + tq * LDP + C_AZ + h * HD; a.Y = Y + tq * DM + h * HD; a.g = p.da_g + L * HD; a.factor = 1.0f - lam_init; a.lam = lam;
        att::attn_unit<0>(lds, a);
        PULL();
    }
    while (u >= E_DIFF && u < E_NA) { if (!(umask & 2)) { PULL(); continue; }
        const int v = u - E_DIFF; const int g4 = v & 15, h = (v >> 4) % 6, b = v / 96;
        att::AttnArgs a{};
        const int R0 = 4 * g4, kfirst = min(max(R0 - 4, 0), 56), klast = min(max(R0 - 1, 0), 56) + 7, nloc = klast - kfirst + 1;
        const size_t t0 = (size_t)b * SEQ, tq = t0 + R0 * 64, tk = t0 + kfirst * 64, tc = (size_t)NLAT + b * CTXL;
        a.Q = P + tq * LDP + C_NQ + h * HD;
        a.K1 = P + tk * LDP + C_NK + h * HD; a.K2 = P + tc * LDP + C_NK + h * HD;
        a.V1 = P + tk * LDP + C_NV + h * HD; a.V2 = P + tc * LDP + C_NV + h * HD;
        a.n1 = nloc; a.n2 = 4; a.NT = nloc + 4;
        a.R0 = R0; a.kfirst = kfirst; a.rpb = p.rpb + ((size_t)(L * 6 + h)) * 465;
        a.Z = P + tq * LDP + C_NZ + h * HD; a.Y = Y + tq * DM + 768 + h * HD; a.g = p.na_g + (L * 6 + h) * HD; a.factor = 1.0f; a.lam = 0.f;
        att::na_unit(lds, a);
        PULL();
    }
    while (L == 0 && u >= E_NA && u < E_DIFFC) { if (!(umask & 4)) { PULL(); continue; }
        const int v = u - E_NA; const int qb = v & 1, h = (v >> 1) % 6, b = v / 12;
        att::AttnArgs a{};
        const size_t tc = (size_t)NLAT + b * CTXL, tq = tc + qb * 128;
        a.Q = P + tq * LDP + C_AQ + h * HD;
        a.K1 = P + tc * LDP + C_AK + h * HD; a.K2 = a.K1; a.V1 = P + tc * LDP + C_AV + h * HD; a.V2 = a.V1;
        a.n1 = 4; a.n2 = 1; a.NT = 4;
        a.Z = P + tq * LDP + C_AZ + h * HD; a.Y = Y + tq * DM + h * HD; a.g = p.da_g + L * HD; a.factor = 1.0f - lam_init; a.lam = lam;
        att::attn_unit<0>(lds, a);
        PULL();
    }
    while (L == 0 && u >= E_DIFFC && u < E_SMC) { if (!(umask & 8)) { PULL(); continue; }
        const int v = u - E_DIFFC; const int h = v % 6, b = v / 6;
        att::AttnArgs a{};
        const size_t tc = (size_t)NLAT + b * CTXL;
        a.Q = P + tc * LDP + C_NQ + h * HD;
        a.K1 = P + tc * LDP + C_NK + h * HD; a.K2 = a.K1; a.V1 = P + tc * LDP + C_NV + h * HD; a.V2 = a.V1;
        a.n1 = 4; a.n2 = 1; a.NT = 4;
        a.Z = P + tc * LDP + C_NZ + h * HD; a.Y = Y + tc * DM + 768 + h * HD; a.g = p.na_g + (L * 6 + h) * HD; a.factor = 1.0f; a.lam = 0.f;
        att::attn_unit<2>(lds, a);
        PULL();
    }
    while (u >= E_SMC && u < NU) { if (!(umask & 16)) { PULL(); continue; }
        const int v = u - E_SMC;
        att::MlpArgs m{};
        size_t t0;
        if (v < N_MLP) { const int g = v & 3, ch = (v >> 2) & 31, b = v >> 7; t0 = (size_t)b * SEQ + ch * 128; m.g = g; }
        else { const int w = v - N_MLP; const int g = w & 3, ch = (w >> 2) & 1, b = w >> 3; t0 = (size_t)NLAT + b * CTXL + ch * 128; m.g = g; }
        m.Prow = P + t0 * LDP; m.Yrow = Y + t0 * DM; m.Wsb = (const bf16_t*)(ws + WS_WSB) + (size_t)L * 4 * 128 * 128;
        m.lng = p.ln_g + L * 512; m.lnb = p.ln_b + L * 512; m.bs = p.mbs + L * 512; m.mg = p.mlp_g + L * 512;
        att::mlp_unit(lds, m);
        PULL();
    }
#undef PULL
}

#define XB_TMO      128
#define XB_XCNT(j)  (256  + 64 * (j))
#define XB_XSUB(j)  (1280 + 64 * (j))
#define XB_XGEN(j)  (2304 + 64 * (j))
#define XB_TOP      3328
#define XB_TOPGEN   3392
#define XCD_BAR_WORDS 3456
#define XB_SPIN_CAP (1u << 22)
__device__ __forceinline__ unsigned xb_ld(unsigned* p)              { return __hip_atomic_load(p, __ATOMIC_RELAXED, __HIP_MEMORY_SCOPE_AGENT); }
__device__ __forceinline__ unsigned xb_add(unsigned* p, unsigned v) { return __hip_atomic_fetch_add(p, v, __ATOMIC_RELAXED, __HIP_MEMORY_SCOPE_AGENT); }
__device__ __forceinline__ unsigned xb_xcc_id() { return (unsigned)__builtin_amdgcn_s_getreg((3 << 11) | 20) & 0xFu; }
#define XB_SPIN(cond, bar) do { unsigned _sp = 0; while (cond) { __builtin_amdgcn_s_sleep(1); \
    if ((++_sp & 255u) == 0u) { if (xb_ld(&(bar)[XB_TMO])) break; if (_sp > XB_SPIN_CAP) { atomicAdd(&(bar)[XB_TMO], 1u); break; } } } } while (0)
struct XcdBarrier { unsigned* bar; unsigned x; volatile LAS unsigned* st; };
__device__ __forceinline__ XcdBarrier xcd_barrier_post(unsigned* bar, volatile LAS unsigned* st) {
    XcdBarrier b; b.bar = bar; b.x = xb_xcc_id(); b.st = st;
    if (threadIdx.x == 0) (void)xb_add(&bar[XB_XCNT(b.x)], 1u);
    return b;
}
__device__ __forceinline__ void xcd_barrier_complete(unsigned* bar, unsigned x, unsigned& nloc, unsigned& nx) {
    const unsigned G = gridDim.x * gridDim.y * gridDim.z;
    unsigned sum, cnt, mine, sp = 0u;
    for (;;) {
        sum = 0u; cnt = 0u; mine = 0u;
#pragma unroll
        for (unsigned j = 0; j < 16; ++j) { const unsigned c = xb_ld(&bar[XB_XCNT(j)]); sum += c; cnt += (c > 0u) ? 1u : 0u; mine = (j == x) ? c : mine; }
        if (sum == G) break;
        __builtin_amdgcn_s_sleep(1);
        if ((++sp & 255u) == 0u) { if (xb_ld(&bar[XB_TMO])) break; if (sp > XB_SPIN_CAP) { atomicAdd(&bar[XB_TMO], 1u); break; } }
    }
    nloc = mine > 0u ? mine : 1u; nx = cnt > 0u ? cnt : 1u;
}
__device__ __forceinline__ void xcd_barrier(const XcdBarrier& b) {
    asm volatile("s_waitcnt vmcnt(0)" ::: "memory");
    __syncthreads();
    if (threadIdx.x == 0) {
        unsigned* bar = b.bar;
        __builtin_amdgcn_s_waitcnt(0);
        unsigned nloc = b.st[0], nx = b.st[1];
        if (nloc == 0u) { xcd_barrier_complete(bar, b.x, nloc, nx); b.st[0] = nloc; b.st[1] = nx; }
        const unsigned old = xb_add(&bar[XB_XSUB(b.x)], 1u);
        const unsigned gen = old / nloc;
        if (old + 1u == (gen + 1u) * nloc) {
            __builtin_amdgcn_fence(__ATOMIC_RELEASE, "agent");
            asm volatile("s_waitcnt vmcnt(0)" ::: "memory");
            const unsigned og = xb_add(&bar[XB_TOP], 1u);
            const unsigned tg = og / nx;
            if (og + 1u == (tg + 1u) * nx) xb_add(&bar[XB_TOPGEN], 1u);
            else XB_SPIN(xb_ld(&bar[XB_TOPGEN]) == tg, bar);
            __builtin_amdgcn_fence(__ATOMIC_ACQUIRE, "agent");
            xb_add(&bar[XB_XGEN(b.x)], 1u);
            asm volatile("s_waitcnt vmcnt(0)" ::: "memory");
        } else {
            XB_SPIN(xb_ld(&bar[XB_XGEN(b.x)]) == gen, bar);
            __builtin_amdgcn_fence(__ATOMIC_ACQUIRE, "agent");
            asm volatile("s_waitcnt vmcnt(0)" ::: "memory");
        }
    }
    __syncthreads();
}

__global__ void __launch_bounds__(512, 2) mega_fwd(Params p) {
    extern __shared__ __attribute__((aligned(16))) unsigned char lds_raw[];
    LAS unsigned char* lds = (LAS unsigned char*)lds_raw;
    const int tid = threadIdx.x, lane = tid & 63, wave = __builtin_amdgcn_readfirstlane(tid >> 6);
    unsigned char* ws = p.ws;
    const int lo = p.ph_lo, hi = p.ph_hi;
    volatile LAS unsigned* MISC = (volatile LAS unsigned*)(lds + MISC_OFF);
    if (tid < 64) MISC[tid] = 0u;
    __syncthreads();
    XcdBarrier bar = xcd_barrier_post((unsigned*)(ws + WS_CTL + CTL_BAR), MISC + 8);
#ifndef PH_MASK
#define PH_MASK 0x3ff
#endif
#define IN(k) (((PH_MASK >> (k)) & 1) && lo <= (k) && (k) < hi)
#define SEAM(k) do { if (IN(k) && IN((k) + 1)) { xcd_barrier(bar); } } while (0)
    if (IN(0)) phase0(p, lds, tid, lane, wave);
    SEAM(0);
    if (IN(1)) norm_phase<0>(p, lane, wave);
    SEAM(1);
    if (IN(2)) for (int rep = 0; rep < ((DUP_PHASE == 2) ? 2 : 1); ++rep) { if (rep) xcd_barrier(bar); pg8::Gemm g{(const bf16_t*)(ws + WS_H), (const bf16_t*)(ws + WS_WIN), DM}; pg8::Sched S; S.init(68, 30, gridDim.x, blockIdx.x, 0);
        pg8::Epi1 E{(bf16_t*)(ws + WS_P), (const float*)(ws + WS_TAB), (const float*)(ws + WS_TAB) + 1024}; pg8::gemm_phase<pg8::Epi1>(lds, g, S, E); }
    SEAM(2);
    if (IN(3)) mixer_phase<0>(p, lds, tid, 0, UNIT_MASK);
    SEAM(3);
    if (IN(4)) { pg8::Gemm g{(const bf16_t*)(ws + WS_H), (const bf16_t*)(ws + WS_WOUT), DM}; pg8::Sched S; S.init(68, 8, gridDim.x, blockIdx.x, 0);
        pg8::Epi2 E{(bf16_t*)(ws + WS_Y0), (float*)(ws + WS_CTL + CTL_ROWSS)}; pg8::gemm_phase<pg8::Epi2>(lds, g, S, E); }
    SEAM(4);
    if (IN(5)) norm_phase<1>(p, lane, wave);
    if (DUP_PHASE == 5) { xcd_barrier(bar); norm_phase<1>(p, lane, wave); }
    SEAM(5);
    if (IN(6)) { pg8::Gemm g{(const bf16_t*)(ws + WS_H), (const bf16_t*)(ws + WS_WIN) + (size_t)INW * DM, DM}; pg8::Sched S; S.init(64, 30, gridDim.x, blockIdx.x, 48);
        pg8::Epi1 E{(bf16_t*)(ws + WS_P), (const float*)(ws + WS_TAB), (const float*)(ws + WS_TAB) + 1024}; pg8::gemm_phase<pg8::Epi1>(lds, g, S, E); }
    SEAM(6);
    if (IN(7)) mixer_phase<1>(p, lds, tid, 1, UNIT_MASK);
    if (DUP_PHASE == 7) { xcd_barrier(bar); mixer_phase<1>(p, lds, tid, 2, DUP_UMASK); }
    SEAM(7);
    if (IN(8)) { pg8::Gemm g{(const bf16_t*)(ws + WS_H), (const bf16_t*)(ws + WS_WOUT) + (size_t)DM * DM, DM}; pg8::Sched S; S.init(64, 8, gridDim.x, blockIdx.x, 0);
        pg8::Epi2 E{(bf16_t*)(ws + WS_P), (float*)(ws + WS_CTL + CTL_ROWSS) + MROWS}; pg8::gemm_phase<pg8::Epi2>(lds, g, S, E); }
    if (DUP_PHASE == 8) { xcd_barrier(bar); pg8::Gemm g{(const bf16_t*)(ws + WS_H), (const bf16_t*)(ws + WS_WOUT) + (size_t)DM * DM, DM}; pg8::Sched S; S.init(64, 8, gridDim.x, blockIdx.x, 0);
        pg8::Epi2 E{(bf16_t*)(ws + WS_P), (float*)(ws + WS_CTL + 786432)}; pg8::gemm_phase<pg8::Epi2>(lds, g, S, E); }
    SEAM(8);
    if (IN(9)) norm_phase<2>(p, lane, wave);
#undef IN
#undef SEAM
}

extern "C" void kernel_launch(void* const* d_in, const int* in_sizes, int n_in, void* d_out, int out_size, void* d_ws, size_t ws_size, hipStream_t stream) {
    static int grid = 0;
    if (grid == 0) {
        if (n_in != 22 || out_size != NLAT * DM || ws_size < WS_END) { fprintf(stderr, "kernel_launch: unexpected shapes (n_in %d out %d ws %zu)\n", n_in, out_size, ws_size); grid = -1; return; }
        int dev = 0, cus = 0, per_cu = 0;
        if (hipGetDevice(&dev) != hipSuccess || hipDeviceGetAttribute(&cus, hipDeviceAttributeMultiprocessorCount, dev) != hipSuccess) { grid = -1; return; }
        if (hipFuncSetAttribute((const void*)mega_fwd, hipFuncAttributeMaxDynamicSharedMemorySize, LDS_BYTES) != hipSuccess) { fprintf(stderr, "kernel_launch: hipFuncSetAttribute failed\n"); grid = -1; return; }
        if (hipOccupancyMaxActiveBlocksPerMultiprocessor(&per_cu, (const void*)mega_fwd, 512, LDS_BYTES) != hipSuccess || per_cu < 1) { fprintf(stderr, "kernel_launch: occupancy query says %d\n", per_cu); per_cu = 1; }
        (void)hipGetLastError();
        grid = cus * 1;
    }
    if (grid < 0) return;
    (void)hipMemsetAsync((char*)d_ws + WS_CTL, 0, CTL_BYTES, stream);
    Params p{};
    p.x = (const float*)d_in[0]; p.c = (const float*)d_in[1]; p.ctx = (const float*)d_in[2]; p.c_ctx = (const float*)d_in[3]; p.ada_w = (const float*)d_in[4]; p.ada_b = (const float*)d_in[5];
    p.pre_g = (const float*)d_in[6]; p.post_g = (const float*)d_in[7]; p.w_in = (const float*)d_in[8]; p.w_out = (const float*)d_in[9];
    p.lq1 = (const float*)d_in[10]; p.lk1 = (const float*)d_in[11]; p.lq2 = (const float*)d_in[12]; p.lk2 = (const float*)d_in[13];
    p.da_g = (const float*)d_in[14]; p.rpb = (const float*)d_in[15]; p.na_g = (const float*)d_in[16]; p.ln_g = (const float*)d_in[17]; p.ln_b = (const float*)d_in[18];
    p.mws = (const float*)d_in[19]; p.mbs = (const float*)d_in[20]; p.mlp_g = (const float*)d_in[21];
    p.out = (float*)d_out; p.ws = (unsigned char*)d_ws;
#if MK_SINGLE
    p.ph_lo = 0; p.ph_hi = 10;
    { void* args[] = {&p}; hipError_t e = hipLaunchCooperativeKernel((const void*)mega_fwd, dim3(grid), dim3(512), args, LDS_BYTES, stream);
      if (e != hipSuccess) fprintf(stderr, "kernel_launch: cooperative launch failed: %s (grid %d)\n", hipGetErrorString(e), grid); }
#else
    for (int ph = 0; ph < 10; ++ph) { p.ph_lo = ph; p.ph_hi = ph + 1; void* args[] = {&p};
        hipError_t e = hipLaunchCooperativeKernel((const void*)mega_fwd, dim3(grid), dim3(512), args, LDS_BYTES, stream);
        if (e != hipSuccess) { fprintf(stderr, "kernel_launch: launch %d failed: %s (grid %d)\n", ph, hipGetErrorString(e), grid); break; } }
#endif
}
```

```cpp
#include <hip/hip_runtime.h>
#include <hip/hip_cooperative_groups.h>
#include <cstdio>
#include <cstdint>
namespace cg = cooperative_groups;
#ifndef UNIT_MASK
#define UNIT_MASK 31
#endif
#ifndef DUP_PHASE
#define DUP_PHASE -1
#endif
#ifndef DUP_UMASK
#define DUP_UMASK 31
#endif

#ifndef MK_SINGLE
#define MK_SINGLE 1
#endif

#define LAS __attribute__((address_space(3)))
typedef unsigned short bf16_t;
typedef short bf16x8 __attribute__((ext_vector_type(8)));
typedef short s16x4 __attribute__((ext_vector_type(4)));
typedef float f32x2 __attribute__((ext_vector_type(2)));
typedef float f32x4 __attribute__((ext_vector_type(4)));
typedef float f32x8 __attribute__((ext_vector_type(8)));
typedef float f32x16 __attribute__((ext_vector_type(16)));
typedef unsigned u32x2 __attribute__((ext_vector_type(2)));
typedef unsigned u32x4 __attribute__((ext_vector_type(4)));

constexpr int DM = 2048, NB = 4, SEQ = 4096, CTXL = 256, NLAT = NB * SEQ, NCTX = NB * CTXL, MROWS = NLAT + NCTX;
constexpr int INW = 7680, LDP = INW, HD = 128;
constexpr int C_AQ = 0, C_AK = 768, C_AV = 1536, C_AZ = 2304, C_NQ = 3072, C_NK = 3840, C_NV = 4608, C_NZ = 5376, C_MU = 6144, C_MV = 6656, C_MZ = 7168;
constexpr float EPS = 1e-6f;
constexpr float LOG2E = 1.4426950408889634f;

constexpr size_t MiB = 1u << 20;
constexpr size_t WS_CTL = 0, CTL_BYTES = 1 * MiB;
constexpr size_t CTL_QCTR = 256;
constexpr size_t CTL_MOD = 4096;
constexpr size_t CTL_ROWSS = 262144;
constexpr size_t CTL_BAR = 524288;
constexpr size_t WS_TAB = 1 * MiB;
constexpr size_t WS_WSB = 1 * MiB + 65536;
constexpr size_t WS_WIN = 2 * MiB;
constexpr size_t WS_WOUT = 62 * MiB;
constexpr size_t WS_H = 78 * MiB;
constexpr size_t WS_XC1 = 146 * MiB;
constexpr size_t WS_P = 154 * MiB;
constexpr size_t WS_Y0 = 409 * MiB;
constexpr size_t WS_END = 477 * MiB;

constexpr int LDS_BYTES = 147456;
constexpr int MISC_OFF = 139264;


#ifndef PROBE_T
#define PROBE_T 0
#endif
#ifndef PROBE_TID
#define PROBE_TID 0
#endif
#define TPROBE_BEGIN(k) unsigned long long _tp##k = 0; if (PROBE_T == (k) && blockIdx.x == 0 && threadIdx.x == PROBE_TID) { _tp##k = wall_clock64(); }
#define TPROBE_END(k) if (PROBE_T == (k) && blockIdx.x == 0 && threadIdx.x == PROBE_TID) { const unsigned _d = (unsigned)(wall_clock64() - _tp##k); volatile LAS unsigned* _m = (volatile LAS unsigned*)((LAS unsigned char*)0 + MISC_OFF); _m[20] = _m[20] + _d; }

struct Params {
    const float *x, *c, *ctx, *c_ctx, *ada_w, *ada_b, *pre_g, *post_g, *w_in, *w_out, *lq1, *lk1, *lq2, *lk2, *da_g, *rpb, *na_g, *ln_g, *ln_b, *mws, *mbs, *mlp_g;
    float* out; unsigned char* ws; int ph_lo, ph_hi;
};

__device__ __forceinline__ unsigned cvt_pk_bf16(float lo, float hi) { unsigned r; asm volatile("v_cvt_pk_bf16_f32 %0, %1, %2" : "=v"(r) : "v"(lo), "v"(hi)); return r; }
__device__ __forceinline__ float bf_lo(unsigned w) { return __uint_as_float(w << 16); }
__device__ __forceinline__ float bf_hi(unsigned w) { return __uint_as_float(w & 0xffff0000u); }
__device__ __forceinline__ float wave_sum(float v) {
#pragma unroll
    for (int o = 1; o < 64; o <<= 1) v += __shfl_xor(v, o);
    return v;
}
__device__ __forceinline__ float silu_f(float z) { return z * __builtin_amdgcn_rcpf(1.0f + __builtin_amdgcn_exp2f(-z * LOG2E)); }
__device__ __forceinline__ float gelu_tanh(float x) {
    const float u = 0.7978845608028654f * (x + 0.044715f * x * x * x);
    return x * __builtin_amdgcn_rcpf(1.0f + __builtin_amdgcn_exp2f(-2.0f * LOG2E * u));
}

namespace pg8 {
constexpr int BM = 256, BK = 64, HALF = 128, HTB = HALF * BK * 2, STAGE_BYTES = 8 * HTB, NXCD = 8, WGM = 8;
__host__ __device__ __forceinline__ int lds_byte(int r, int c) { const int st = (r >> 4) * 2 + (c >> 5), rr = r & 15, cc = c & 31, ob = rr * 64 + cc * 2; return st * 1024 + (ob ^ (((ob >> 9) & 1) << 5)); }
__host__ __device__ __forceinline__ void stage_rc(int b, int& R, int& C) { const int st = b / 1024, sb = b % 1024, swz = sb ^ (((sb >> 9) & 1) << 5); R = (st >> 1) * 16 + swz / 64; C = (st & 1) * 32 + (swz % 64) / 2; }
__host__ __device__ __forceinline__ int perm32(int rho) { const int n = rho >> 4, i = rho & 15; return 8 * (i >> 2) + 4 * n + (i & 3); }

struct Unit { int pm, pn; };
struct Gemm { const bf16_t* A; const bf16_t* Bt; int K; };

struct Sched {
    int nM, nN, nwg, G, c, extra;
    __device__ void init(int nM_, int nN_, int G_, int c_, int extra_) { nM = nM_; nN = nN_; nwg = nM * nN; G = G_; c = c_; extra = extra_; }
    __device__ bool next(int i, Unit& u) const {
        const long L = (long)i * G + c;
        if (L < nwg) {
            int wgid = (int)L; { const int q = nwg / NXCD, r = nwg % NXCD, xcd = wgid % NXCD, off = wgid / NXCD; wgid = (xcd < r ? xcd * (q + 1) : r * (q + 1) + (xcd - r) * q) + off; }
            const int nig = WGM * nN, gid = wgid / nig, fm = gid * WGM, gsz = (nM - fm) < WGM ? (nM - fm) : WGM;
            u.pm = fm + ((wgid % nig) % gsz); u.pn = (wgid % nig) / gsz; return true;
        }
        const int e = (int)(L - nwg); if (e >= extra) return false;
        const int t = e >> 2; u.pm = 64 + (e & 3); u.pn = t < 6 ? 3 + t : 9 + t; return true;
    }
};

template <class Epi>
__device__ __forceinline__ void gemm_phase(LAS unsigned char* lds, const Gemm g, const Sched& S, const Epi& E) {
    const int tid = threadIdx.x, wid = __builtin_amdgcn_readfirstlane(tid >> 6), lane = tid & 63, wr = wid >> 2, wc = wid & 3, fr = lane & 15, fq = lane >> 4;
    const int K = g.K, nt = K / BK;
    unsigned voffA[2], voffB[2];
#pragma unroll
    for (int i = 0; i < 2; ++i) { int R, C; stage_rc(tid * 16 + i * 8192, R, C); const int Rb = Epi::PERM ? ((R & ~31) + perm32(R & 31)) : R;
        voffA[i] = (unsigned)(R * K + C) * 2u; voffB[i] = (unsigned)(Rb * K + C) * 2u; }
    const size_t kstep = (size_t)(BK * 2);
    const size_t hstep = (size_t)HALF * K * 2;
    const size_t tstep = 2 * hstep;
    const unsigned ldsw = (unsigned)wid * 1024u;
    const int aoff = lds_byte(wr * 64 + fr, fq * 8), boff = lds_byte(wc * 32 + fr, fq * 8);
#define PG8_SA(b, h) (((b) * 2 + (h)) * HTB)
#define PG8_SB(b, h) ((4 + (b) * 2 + (h)) * HTB)
#define PG8_STAGE(bufoff, gbase, voff) do { _Pragma("unroll") for (int _i = 0; _i < 2; ++_i) \
        __builtin_amdgcn_global_load_lds((const unsigned*)((const char*)(gbase) + (voff)[_i]), (LAS unsigned*)(lds + (bufoff) + ldsw + _i * 8192), 16, 0, 0); } while (0)
#define PG8_LDA(dst, b, h) do { _Pragma("unroll") for (int m = 0; m < 4; ++m) _Pragma("unroll") for (int k = 0; k < 2; ++k) dst[m][k] = *(const LAS bf16x8*)(lds + PG8_SA(b, h) + aoff + m * 2048 + k * 1024); } while (0)
#define PG8_LDB(dst, b, h) do { _Pragma("unroll") for (int n = 0; n < 2; ++n) _Pragma("unroll") for (int k = 0; k < 2; ++k) dst[n][k] = *(const LAS bf16x8*)(lds + PG8_SB(b, h) + boff + n * 2048 + k * 1024); } while (0)
#define PG8_MMA(ai, bj, At, Bt) do { __builtin_amdgcn_s_setprio(1); _Pragma("unroll") for (int m = 0; m < 4; ++m) _Pragma("unroll") for (int n = 0; n < 2; ++n) _Pragma("unroll") for (int k = 0; k < 2; ++k) \
        acc[ai][bj][m][n] = __builtin_amdgcn_mfma_f32_16x16x32_bf16(Bt[n][k], At[m][k], acc[ai][bj][m][n], 0, 0, 0); __builtin_amdgcn_s_setprio(0); } while (0)
#define PG8_WAIT_V(n) asm volatile("s_waitcnt vmcnt(" #n ")" ::: "memory")
#define PG8_WAIT_L(n) asm volatile("s_waitcnt lgkmcnt(" #n ")" ::: "memory")
#define PG8_BAR __builtin_amdgcn_s_barrier()
#define PG8_SCHED __builtin_amdgcn_sched_barrier(0)
    Unit cur, nxt; int ui = 0;
    if (!S.next(0, cur)) return;
    f32x4 acc[2][2][4][2];
#pragma unroll
    for (int a = 0; a < 2; ++a)
#pragma unroll
        for (int b = 0; b < 2; ++b)
#pragma unroll
            for (int m = 0; m < 4; ++m)
#pragma unroll
                for (int n = 0; n < 2; ++n) acc[a][b][m][n] = (f32x4){0.f, 0.f, 0.f, 0.f};
    bf16x8 At[4][2], B0[2][2], B1[2][2];
    const char* cA = (const char*)g.A + (size_t)cur.pm * tstep; const char* cB = (const char*)g.Bt + (size_t)cur.pn * tstep;
    PG8_STAGE(PG8_SB(0, 0), cB, voffB); PG8_STAGE(PG8_SB(0, 1), cB + hstep, voffB); PG8_STAGE(PG8_SA(0, 0), cA, voffA); PG8_STAGE(PG8_SA(0, 1), cA + hstep, voffA);
    if (wr == 1) PG8_BAR;
    PG8_WAIT_V(2); PG8_BAR;
    PG8_STAGE(PG8_SB(1, 0), cB + kstep, voffB); PG8_STAGE(PG8_SA(1, 0), cA + kstep, voffA); PG8_STAGE(PG8_SB(1, 1), cB + hstep + kstep, voffB);
    PG8_WAIT_V(6); PG8_BAR;
    for (;;) {
        const bool has_next = S.next(ui + 1, nxt);
        const char* nA = has_next ? (const char*)g.A + (size_t)nxt.pm * tstep : cA; const char* nB = has_next ? (const char*)g.Bt + (size_t)nxt.pn * tstep : cB;
        for (int t = 0; t < nt; t += 2) {
            const bool last = (t == nt - 2);
            const char* a1 = cA + (size_t)(t + 1) * kstep;
            const char* a2 = last ? nA : cA + (size_t)(t + 2) * kstep; const char* b2 = last ? nB : cB + (size_t)(t + 2) * kstep;
            const char* a3 = a2 + kstep; const char* b3 = b2 + kstep;
            PG8_LDB(B0, 0, 0); PG8_LDB(B1, 0, 1); PG8_SCHED; PG8_LDA(At, 0, 0); PG8_STAGE(PG8_SA(1, 1), a1 + hstep, voffA);
            PG8_WAIT_V(8); PG8_WAIT_L(0); PG8_BAR; PG8_MMA(0, 0, At, B0); PG8_MMA(0, 1, At, B1); PG8_BAR; PG8_SCHED;
            PG8_LDA(At, 0, 1); PG8_STAGE(PG8_SB(0, 0), b2, voffB); PG8_STAGE(PG8_SB(0, 1), b2 + hstep, voffB); PG8_STAGE(PG8_SA(0, 0), a2, voffA);
            PG8_WAIT_V(8); PG8_WAIT_L(0); PG8_BAR; PG8_MMA(1, 0, At, B0); PG8_MMA(1, 1, At, B1); PG8_BAR; PG8_SCHED;
            PG8_LDB(B0, 1, 0); PG8_LDB(B1, 1, 1); PG8_SCHED; PG8_LDA(At, 1, 0); PG8_STAGE(PG8_SA(0, 1), a2 + hstep, voffA);
            PG8_WAIT_V(8); PG8_WAIT_L(0); PG8_BAR; PG8_MMA(0, 0, At, B0); PG8_MMA(0, 1, At, B1); PG8_BAR; PG8_SCHED;
            PG8_LDA(At, 1, 1); PG8_STAGE(PG8_SB(1, 0), b3, voffB); PG8_STAGE(PG8_SB(1, 1), b3 + hstep, voffB); PG8_STAGE(PG8_SA(1, 0), a3, voffA);
            PG8_WAIT_V(8); PG8_WAIT_L(0); PG8_BAR; PG8_MMA(1, 0, At, B0); PG8_MMA(1, 1, At, B1); PG8_BAR; PG8_SCHED;
        }
        if (wr == 0) PG8_BAR;
        E(acc, cur, wr, wc, fr, fq);
        if (!has_next) break;
#pragma unroll
        for (int a = 0; a < 2; ++a)
#pragma unroll
            for (int b = 0; b < 2; ++b)
#pragma unroll
                for (int m = 0; m < 4; ++m)
#pragma unroll
                    for (int n = 0; n < 2; ++n) acc[a][b][m][n] = (f32x4){0.f, 0.f, 0.f, 0.f};
        cur = nxt; cA = nA; cB = nB; ++ui;
        if (wr == 1) PG8_BAR;
    }
    PG8_WAIT_V(0);
    PG8_BAR;
#undef PG8_SA
#undef PG8_SB
#undef PG8_STAGE
#undef PG8_LDA
#undef PG8_LDB
#undef PG8_MMA
#undef PG8_WAIT_V
#undef PG8_WAIT_L
#undef PG8_BAR
#undef PG8_SCHED
}

struct Epi1 {
    static constexpr bool PERM = true;
    bf16_t* O; const float* cs; const float* sn;
    __device__ __forceinline__ void operator()(const f32x4 (&acc)[2][2][4][2], const Unit& u, int wr, int wc, int fr, int fq) const {
        const int row0 = u.pm * BM + wr * 64 + fr, col0 = u.pn * BM + wc * 32 + 8 * fq;
        const bool rope = (u.pn < 6) && (u.pm < 64), gelu = (u.pn >= 24) && (u.pn < 28);
        const float qs = (u.pn < 3) ? 0.125f * LOG2E : 1.0f;
        const float sgn = (fq < 2) ? -1.f : 1.f;
#pragma unroll
        for (int ai = 0; ai < 2; ++ai)
#pragma unroll
            for (int m = 0; m < 4; ++m) {
                const int row = row0 + ai * HALF + m * 16;
                bf16_t* rowp = O + (size_t)row * LDP + col0;
                f32x4 c0 = {1.f, 1.f, 1.f, 1.f}, c1 = c0, s0 = {0.f, 0.f, 0.f, 0.f}, s1 = s0;
                if (rope) { const int s = row & (SEQ - 1); const int pos = (wc & 1) ? (s & 63) : (s >> 6); const int ti = pos * 16 + 8 * (fq & 1);
                    c0 = *(const f32x4*)(cs + ti); c1 = *(const f32x4*)(cs + ti + 4); s0 = *(const f32x4*)(sn + ti); s1 = *(const f32x4*)(sn + ti + 4);
                    s0 = s0 * sgn; s1 = s1 * sgn; }
#pragma unroll
                for (int bj = 0; bj < 2; ++bj) { f32x4 v0 = acc[ai][bj][m][0], v1 = acc[ai][bj][m][1];
                    if (rope) { f32x4 q0, q1;
#pragma unroll
                        for (int e = 0; e < 4; ++e) { q0[e] = __shfl_xor(v0[e], 32); q1[e] = __shfl_xor(v1[e], 32); }
                        v0 = v0 * c0 + q0 * s0; v1 = v1 * c1 + q1 * s1; }
                    if (gelu) {
#pragma unroll
                        for (int e = 0; e < 4; ++e) { v0[e] = gelu_tanh(v0[e]); v1[e] = gelu_tanh(v1[e]); } }
                    v0 = v0 * qs; v1 = v1 * qs;
                    u32x4 w; w.x = cvt_pk_bf16(v0[0], v0[1]); w.y = cvt_pk_bf16(v0[2], v0[3]); w.z = cvt_pk_bf16(v1[0], v1[1]); w.w = cvt_pk_bf16(v1[2], v1[3]);
                    *(u32x4*)(rowp + bj * HALF) = w; } }
    }
};
struct Epi2 {
    static constexpr bool PERM = true;
    bf16_t* Yb; float* rowss;
    __device__ __forceinline__ void operator()(const f32x4 (&acc)[2][2][4][2], const Unit& u, int wr, int wc, int fr, int fq) const {
        const int row0 = u.pm * BM + wr * 64 + fr, col0 = u.pn * BM + wc * 32 + 8 * fq;
#pragma unroll
        for (int ai = 0; ai < 2; ++ai)
#pragma unroll
            for (int m = 0; m < 4; ++m) { const int row = row0 + ai * HALF + m * 16; bf16_t* rowp = Yb + (size_t)row * DM + col0; float ss = 0.f;
#pragma unroll
                for (int bj = 0; bj < 2; ++bj) { const f32x4 v0 = acc[ai][bj][m][0], v1 = acc[ai][bj][m][1];
                    ss += (v0[0] * v0[0] + v0[1] * v0[1]) + (v0[2] * v0[2] + v0[3] * v0[3]) + (v1[0] * v1[0] + v1[1] * v1[1]) + (v1[2] * v1[2] + v1[3] * v1[3]);
                    u32x4 w; w.x = cvt_pk_bf16(v0[0], v0[1]); w.y = cvt_pk_bf16(v0[2], v0[3]); w.z = cvt_pk_bf16(v1[0], v1[1]); w.w = cvt_pk_bf16(v1[2], v1[3]);
                    *(u32x4*)(rowp + bj * HALF) = w; }
                ss += __shfl_xor(ss, 16); ss += __shfl_xor(ss, 32);
                if (fq == 0) atomicAdd(rowss + row, ss); }
    }
};
}

namespace att {
constexpr int SHM_V = 64 * 128 * 2, SHM_K = 64 * 128 * 2;
constexpr int WSF_OFF = 2 * SHM_V + 2 * SHM_K;
constexpr int BIAS_OFF = WSF_OFF + 2048;
constexpr int XS = 132;
constexpr float THR = 8.f;
#define KSWZ(row, colB) ((row) * 256 + ((colB) ^ (((row) & 15) << 4)))
#define SBAR() __builtin_amdgcn_sched_barrier(0)
__device__ __forceinline__ int crow(int r, int hi) { return (r & 3) + 8 * (r >> 2) + 4 * hi; }
__device__ __forceinline__ bf16x8 ld8(const bf16_t* p) { return *reinterpret_cast<const bf16x8*>(p); }

template <int MODE> struct ModeC { static constexpr float SC = (MODE == 0) ? 0.125f : 0.08838834764831845f; };

template <int MODE>
__device__ __forceinline__ void partialSM(f32x16& p0, f32x16& p1, float& m_reg, float& mn, float& alpha) {
    constexpr float C = ModeC<MODE>::SC * LOG2E;
    float pmax = p0[0];
#pragma unroll
    for (int r = 1; r < 16; ++r) pmax = fmaxf(pmax, p0[r]);
#pragma unroll
    for (int r = 0; r < 16; ++r) pmax = fmaxf(pmax, p1[r]);
    { auto rr = __builtin_amdgcn_permlane32_swap(__float_as_uint(pmax), __float_as_uint(pmax), false, false);
      pmax = fmaxf(__uint_as_float(rr[0]), __uint_as_float(rr[1])); }
    if (__builtin_expect(__all(pmax - m_reg <= THR / ModeC<MODE>::SC), 1)) { mn = m_reg; alpha = 1.f; }
    else { mn = fmaxf(m_reg, pmax); alpha = __builtin_amdgcn_exp2f((m_reg - mn) * C); m_reg = mn; }
    const float mnC = -mn * C;
#pragma unroll
    for (int r = 0; r < 16; ++r) p0[r] = fmaf(p0[r], C, mnC);
#pragma unroll
    for (int r = 0; r < 16; ++r) p1[r] = fmaf(p1[r], C, mnC);
#pragma unroll
    for (int r = 0; r < 16; ++r) p0[r] = __builtin_amdgcn_exp2f(p0[r]);
}
__device__ __forceinline__ void finishSM(f32x16& p0, f32x16& p1, float alpha, float& l_reg, bf16x8& pa0, bf16x8& pa1, bf16x8& pa2, bf16x8& pa3) {
#pragma unroll
    for (int r = 0; r < 16; ++r) p1[r] = __builtin_amdgcn_exp2f(p1[r]);
    float ps = 0;
#pragma unroll
    for (int r = 0; r < 16; ++r) ps += p0[r];
#pragma unroll
    for (int r = 0; r < 16; ++r) ps += p1[r];
    { auto rr = __builtin_amdgcn_permlane32_swap(__float_as_uint(ps), __float_as_uint(ps), false, false);
      ps = __uint_as_float(rr[0]) + __uint_as_float(rr[1]); }
    l_reg = l_reg * alpha + ps;
#define PK4(P, BASE, OUT) do { unsigned a0 = cvt_pk_bf16(P[BASE + 0], P[BASE + 1]), a1 = cvt_pk_bf16(P[BASE + 2], P[BASE + 3]);   \
    unsigned b0 = cvt_pk_bf16(P[BASE + 4], P[BASE + 5]), b1 = cvt_pk_bf16(P[BASE + 6], P[BASE + 7]);                              \
    auto r0 = __builtin_amdgcn_permlane32_swap(a0, b0, false, false); auto r1 = __builtin_amdgcn_permlane32_swap(a1, b1, false, false); \
    u32x4 w = {r0[0], r1[0], r0[1], r1[1]}; OUT = *reinterpret_cast<bf16x8*>(&w); } while (0)
    PK4(p0, 0, pa0); PK4(p0, 8, pa1); PK4(p1, 0, pa2); PK4(p1, 8, pa3);
#undef PK4
}
template <int MODE>
__device__ __forceinline__ void sm_max(const f32x16& p0, const f32x16& p1, float& m_reg, float& mnC, float& alpha) {
    constexpr float C = ModeC<MODE>::SC * LOG2E;
    float pmax = p0[0];
#pragma unroll
    for (int r = 1; r < 16; ++r) pmax = fmaxf(pmax, p0[r]);
#pragma unroll
    for (int r = 0; r < 16; ++r) pmax = fmaxf(pmax, p1[r]);
    { auto rr = __builtin_amdgcn_permlane32_swap(__float_as_uint(pmax), __float_as_uint(pmax), false, false);
      pmax = fmaxf(__uint_as_float(rr[0]), __uint_as_float(rr[1])); }
    const bool keep = __all(pmax - m_reg <= THR / ModeC<MODE>::SC);
    const float mn = keep ? m_reg : fmaxf(m_reg, pmax);
    alpha = __builtin_amdgcn_exp2f((m_reg - mn) * C);
    m_reg = mn; mnC = -mn * C;
}
template <int MODE>
__device__ __forceinline__ void sm_scale(f32x16& p, float mnC) {
    constexpr float C = ModeC<MODE>::SC * LOG2E;
#pragma unroll
    for (int r = 0; r < 16; ++r) p[r] = fmaf(p[r], C, mnC);
}
__device__ __forceinline__ void sm_exp(f32x16& p) {
#pragma unroll
    for (int r = 0; r < 16; ++r) p[r] = __builtin_amdgcn_exp2f(p[r]);
}
__device__ __forceinline__ void sm_finish(f32x16& p0, f32x16& p1, float alpha, float& l_reg, bf16x8& pa0, bf16x8& pa1, bf16x8& pa2, bf16x8& pa3) {
    float ps = 0;
#pragma unroll
    for (int r = 0; r < 16; ++r) ps += p0[r];
#pragma unroll
    for (int r = 0; r < 16; ++r) ps += p1[r];
    { auto rr = __builtin_amdgcn_permlane32_swap(__float_as_uint(ps), __float_as_uint(ps), false, false);
      ps = __uint_as_float(rr[0]) + __uint_as_float(rr[1]); }
    l_reg = l_reg * alpha + ps;
#define PK4(P, BASE, OUT) do { unsigned a0 = cvt_pk_bf16(P[BASE + 0], P[BASE + 1]), a1 = cvt_pk_bf16(P[BASE + 2], P[BASE + 3]);   \
    unsigned b0 = cvt_pk_bf16(P[BASE + 4], P[BASE + 5]), b1 = cvt_pk_bf16(P[BASE + 6], P[BASE + 7]);                              \
    auto r0 = __builtin_amdgcn_permlane32_swap(a0, b0, false, false); auto r1 = __builtin_amdgcn_permlane32_swap(a1, b1, false, false); \
    u32x4 w = {r0[0], r1[0], r0[1], r1[1]}; OUT = *reinterpret_cast<bf16x8*>(&w); } while (0)
    PK4(p0, 0, pa0); PK4(p0, 8, pa1); PK4(p1, 0, pa2); PK4(p1, 8, pa3);
#undef PK4
}
template <int ND0>
__device__ __forceinline__ void qkt(f32x16& p0, f32x16& p1, const LAS char* Ks, const bf16x8* qr, int r32, int hi, int dbase) {
    p0 = f32x16{}; p1 = f32x16{};
#pragma unroll
    for (int d0 = 0; d0 < ND0; ++d0) { const int cb = ((dbase + d0) * 16 + hi * 8) * 2;
        const bf16x8 b0 = *reinterpret_cast<const LAS bf16x8*>(Ks + KSWZ(r32, cb));
        const bf16x8 b1 = *reinterpret_cast<const LAS bf16x8*>(Ks + KSWZ(32 + r32, cb));
        p0 = __builtin_amdgcn_mfma_f32_32x32x16_bf16(b0, qr[d0], p0, 0, 0, 0);
        p1 = __builtin_amdgcn_mfma_f32_32x32x16_bf16(b1, qr[d0], p1, 0, 0, 0); }
}
__device__ __forceinline__ int v_st(int k, int c) { const int kk = (k & ~0xC) | ((k & 4) << 1) | ((k & 8) >> 1); return ((kk >> 3) * 4 + (c >> 5)) * 512 + ((kk & 7) * 32 + (c & 31)) * 2; }
__device__ __forceinline__ int v_rd_base(int lane) { return ((lane & 3) << 3) | (((lane >> 2) & 3) << 6) | (((lane >> 4) & 1) << 5) | (((lane >> 5) & 1) << 8); }
constexpr int v_rd_off(int d0, int ks, int half) { return d0 * 512 + ks * 4096 + half * 2048; }
template <int OFF> __device__ __forceinline__ s16x4 tr_read(int vb) {
    s16x4 r; asm volatile("ds_read_b64_tr_b16 %0, %1 offset:%2" : "=&v"(r) : "v"(vb), "i"(OFF) : "memory"); return r;
}
template <int D0> __device__ __forceinline__ void pv_one(f32x16& od, int vb, bf16x8 pa0, bf16x8 pa1, bf16x8 pa2, bf16x8 pa3) {
    const s16x4 l0 = tr_read<v_rd_off(D0, 0, 0)>(vb), h0 = tr_read<v_rd_off(D0, 0, 1)>(vb), l1 = tr_read<v_rd_off(D0, 1, 0)>(vb), h1 = tr_read<v_rd_off(D0, 1, 1)>(vb);
    const s16x4 l2 = tr_read<v_rd_off(D0, 2, 0)>(vb), h2 = tr_read<v_rd_off(D0, 2, 1)>(vb), l3 = tr_read<v_rd_off(D0, 3, 0)>(vb), h3 = tr_read<v_rd_off(D0, 3, 1)>(vb);
    asm volatile("s_waitcnt lgkmcnt(0)" ::: "memory"); SBAR();
#define PKV(L, H) (bf16x8){L[0], L[1], L[2], L[3], H[0], H[1], H[2], H[3]}
    od = __builtin_amdgcn_mfma_f32_32x32x16_bf16(pa0, PKV(l0, h0), od, 0, 0, 0);
    od = __builtin_amdgcn_mfma_f32_32x32x16_bf16(pa1, PKV(l1, h1), od, 0, 0, 0);
    od = __builtin_amdgcn_mfma_f32_32x32x16_bf16(pa2, PKV(l2, h2), od, 0, 0, 0);
    od = __builtin_amdgcn_mfma_f32_32x32x16_bf16(pa3, PKV(l3, h3), od, 0, 0, 0);
#undef PKV
}
__device__ __forceinline__ void pv_d0(f32x16* o, int vb, bf16x8 pa0, bf16x8 pa1, bf16x8 pa2, bf16x8 pa3) {
    pv_one<0>(o[0], vb, pa0, pa1, pa2, pa3); pv_one<1>(o[1], vb, pa0, pa1, pa2, pa3); pv_one<2>(o[2], vb, pa0, pa1, pa2, pa3); pv_one<3>(o[3], vb, pa0, pa1, pa2, pa3);
}

template <int KS> __device__ __forceinline__ void pv_ks(f32x16* o, int vb, bf16x8 pa) {
    const s16x4 l0 = tr_read<v_rd_off(0, KS, 0)>(vb), h0 = tr_read<v_rd_off(0, KS, 1)>(vb), l1 = tr_read<v_rd_off(1, KS, 0)>(vb), h1 = tr_read<v_rd_off(1, KS, 1)>(vb);
    const s16x4 l2 = tr_read<v_rd_off(2, KS, 0)>(vb), h2 = tr_read<v_rd_off(2, KS, 1)>(vb), l3 = tr_read<v_rd_off(3, KS, 0)>(vb), h3 = tr_read<v_rd_off(3, KS, 1)>(vb);
#if defined(PROBE_DUPTR)
    { s16x4 d0_ = tr_read<v_rd_off(0, KS, 0)>(vb), d1_ = tr_read<v_rd_off(0, KS, 1)>(vb), d2_ = tr_read<v_rd_off(1, KS, 0)>(vb), d3_ = tr_read<v_rd_off(1, KS, 1)>(vb);
      s16x4 d4_ = tr_read<v_rd_off(2, KS, 0)>(vb), d5_ = tr_read<v_rd_off(2, KS, 1)>(vb), d6_ = tr_read<v_rd_off(3, KS, 0)>(vb), d7_ = tr_read<v_rd_off(3, KS, 1)>(vb);
      asm volatile("" :: "v"(d0_), "v"(d1_), "v"(d2_), "v"(d3_), "v"(d4_), "v"(d5_), "v"(d6_), "v"(d7_)); }
#endif
    asm volatile("s_waitcnt lgkmcnt(0)" ::: "memory"); SBAR();
#define PKV(L, H) (bf16x8){L[0], L[1], L[2], L[3], H[0], H[1], H[2], H[3]}
    o[0] = __builtin_amdgcn_mfma_f32_32x32x16_bf16(pa, PKV(l0, h0), o[0], 0, 0, 0);
    o[1] = __builtin_amdgcn_mfma_f32_32x32x16_bf16(pa, PKV(l1, h1), o[1], 0, 0, 0);
    o[2] = __builtin_amdgcn_mfma_f32_32x32x16_bf16(pa, PKV(l2, h2), o[2], 0, 0, 0);
    o[3] = __builtin_amdgcn_mfma_f32_32x32x16_bf16(pa, PKV(l3, h3), o[3], 0, 0, 0);
#undef PKV
}
__device__ __forceinline__ void pv_k4(f32x16* o, int vb, bf16x8 pa0, bf16x8 pa1, bf16x8 pa2, bf16x8 pa3) {
    pv_ks<0>(o, vb, pa0); pv_ks<1>(o, vb, pa1); pv_ks<2>(o, vb, pa2); pv_ks<3>(o, vb, pa3);
}

template <bool MLP>
__device__ __forceinline__ void final_pass(const LAS float* X, int nrows, const bf16_t* Z, bf16_t* Y, const float* g, float factor, const bf16_t* U, const float* rowb) {
    int t_ = threadIdx.x; asm volatile("" : "+v"(t_));
    for (int idx = t_; idx < nrows * 4; idx += 512) {
        const int row = idx >> 2, seg = idx & 3;
        f32x4 x[8];
#pragma unroll
        for (int i = 0; i < 8; ++i) x[i] = *reinterpret_cast<const LAS f32x4*>(X + row * XS + seg * 32 + 4 * i);
        if (MLP) { const float rb = rowb[row]; const u32x4* up = reinterpret_cast<const u32x4*>(U + (size_t)row * LDP + seg * 32);
#pragma unroll
            for (int i = 0; i < 4; ++i) { const u32x4 w = up[i];
                x[2 * i][0] = (x[2 * i][0] + rb) * bf_lo(w.x); x[2 * i][1] = (x[2 * i][1] + rb) * bf_hi(w.x); x[2 * i][2] = (x[2 * i][2] + rb) * bf_lo(w.y); x[2 * i][3] = (x[2 * i][3] + rb) * bf_hi(w.y);
                x[2 * i + 1][0] = (x[2 * i + 1][0] + rb) * bf_lo(w.z); x[2 * i + 1][1] = (x[2 * i + 1][1] + rb) * bf_hi(w.z); x[2 * i + 1][2] = (x[2 * i + 1][2] + rb) * bf_lo(w.w); x[2 * i + 1][3] = (x[2 * i + 1][3] + rb) * bf_hi(w.w); } }
        float ss = 0.f;
#pragma unroll
        for (int i = 0; i < 8; ++i) ss += (x[i][0] * x[i][0] + x[i][1] * x[i][1]) + (x[i][2] * x[i][2] + x[i][3] * x[i][3]);
        ss += __shfl_xor(ss, 1); ss += __shfl_xor(ss, 2);
        const float rstd = __builtin_amdgcn_rsqf(ss * (1.0f / 128.0f) + EPS) * factor;
        const u32x4* zp = reinterpret_cast<const u32x4*>(Z + (size_t)row * LDP + seg * 32);
        const f32x4* gp = reinterpret_cast<const f32x4*>(g + seg * 32);
        u32x4* yp = reinterpret_cast<u32x4*>(Y + (size_t)row * DM + seg * 32);
#pragma unroll
        for (int i = 0; i < 4; ++i) { const u32x4 w = zp[i]; const f32x4 g0 = gp[2 * i], g1 = gp[2 * i + 1]; const f32x4 a = x[2 * i], b = x[2 * i + 1];
            u32x4 o;
            o.x = cvt_pk_bf16(a[0] * rstd * g0[0] * silu_f(bf_lo(w.x)), a[1] * rstd * g0[1] * silu_f(bf_hi(w.x)));
            o.y = cvt_pk_bf16(a[2] * rstd * g0[2] * silu_f(bf_lo(w.y)), a[3] * rstd * g0[3] * silu_f(bf_hi(w.y)));
            o.z = cvt_pk_bf16(b[0] * rstd * g1[0] * silu_f(bf_lo(w.z)), b[1] * rstd * g1[1] * silu_f(bf_hi(w.z)));
            o.w = cvt_pk_bf16(b[2] * rstd * g1[2] * silu_f(bf_lo(w.w)), b[3] * rstd * g1[3] * silu_f(bf_hi(w.w)));
            yp[i] = o; }
    }
}

struct AttnArgs {
    const bf16_t* Q;
    const bf16_t *K1, *K2, *V1, *V2;
    int n1, n2, NT;
    int R0, kfirst;
    const float* rpb;
    const bf16_t* Z; bf16_t* Y; const float* g; float factor, lam;
};
template <int MODE>
__device__ __forceinline__ void attn_epilogue(LAS char* lds, const AttnArgs& a, f32x16 (&o)[4], float l_reg, LAS float* li_l, int map, int qg, int r32, int hi) {
    if (hi == 0) li_l[r32] = l_reg; asm volatile("s_waitcnt lgkmcnt(0)" ::: "memory");
    float rli[16];
#pragma unroll
    for (int r = 0; r < 16; ++r) rli[r] = __builtin_amdgcn_rcpf(li_l[crow(r, hi)]);
    __syncthreads();
    LAS float* X = (LAS float*)lds;
    if (MODE != 0 || map == 0) {
#pragma unroll
        for (int r = 0; r < 16; ++r)
#pragma unroll
            for (int d0 = 0; d0 < 4; ++d0) X[(qg * 32 + crow(r, hi)) * XS + d0 * 32 + r32] = o[d0][r] * rli[r];
    }
    __syncthreads();
    if (MODE == 0) {
        if (map == 1) {
#pragma unroll
            for (int r = 0; r < 16; ++r)
#pragma unroll
                for (int d0 = 0; d0 < 4; ++d0) { LAS float* xp = X + (qg * 32 + crow(r, hi)) * XS + d0 * 32 + r32; *xp = *xp - a.lam * (o[d0][r] * rli[r]); }
        }
        __syncthreads();
    }
    final_pass<false>(X, (MODE == 0) ? 128 : 256, a.Z, a.Y, a.g, a.factor, nullptr, nullptr);
    __syncthreads();
}
constexpr int V3_OFF = 0, K3_OFF = 3 * SHM_V, WSF3_OFF = 3 * SHM_V + 3 * SHM_K;
constexpr float THRL = 10.f;
__device__ __forceinline__ void qkt_c(f32x16& p0, f32x16& p1, const LAS char* Ks, const bf16x8* qr, const f32x16& negm, int r32, int hi, int dbase) {
#pragma unroll
    for (int d0 = 0; d0 < 4; ++d0) { const int cb = ((dbase + d0) * 16 + hi * 8) * 2;
        const bf16x8 b0 = *reinterpret_cast<const LAS bf16x8*>(Ks + KSWZ(r32, cb));
        const bf16x8 b1 = *reinterpret_cast<const LAS bf16x8*>(Ks + KSWZ(32 + r32, cb));
        if (d0 == 0) { p0 = __builtin_amdgcn_mfma_f32_32x32x16_bf16(b0, qr[0], negm, 0, 0, 0); p1 = __builtin_amdgcn_mfma_f32_32x32x16_bf16(b1, qr[0], negm, 0, 0, 0); }
        else { p0 = __builtin_amdgcn_mfma_f32_32x32x16_bf16(b0, qr[d0], p0, 0, 0, 0); p1 = __builtin_amdgcn_mfma_f32_32x32x16_bf16(b1, qr[d0], p1, 0, 0, 0); } }
}
__device__ __forceinline__ bf16x8 lds_rd128(int addr) { bf16x8 r; asm volatile("ds_read_b128 %0, %1" : "=&v"(r) : "v"(addr) : "memory"); return r; }
__device__ __forceinline__ bf16x8 lds_rd128_hi(int addr) { bf16x8 r; asm volatile("ds_read_b128 %0, %1 offset:8192" : "=&v"(r) : "v"(addr) : "memory"); return r; }
__device__ __forceinline__ void qkt_cb(f32x16& p0, f32x16& p1, const int (&ka)[4], const bf16x8* qr, const f32x16& negm) {
    const bf16x8 a0 = lds_rd128(ka[0]), b0 = lds_rd128_hi(ka[0]), a1 = lds_rd128(ka[1]), b1 = lds_rd128_hi(ka[1]);
    const bf16x8 a2 = lds_rd128(ka[2]), b2 = lds_rd128_hi(ka[2]), a3 = lds_rd128(ka[3]), b3 = lds_rd128_hi(ka[3]);
    asm volatile("s_waitcnt lgkmcnt(6)" ::: "memory"); SBAR();
    p0 = __builtin_amdgcn_mfma_f32_32x32x16_bf16(a0, qr[0], negm, 0, 0, 0); p1 = __builtin_amdgcn_mfma_f32_32x32x16_bf16(b0, qr[0], negm, 0, 0, 0);
    asm volatile("s_waitcnt lgkmcnt(4)" ::: "memory"); SBAR();
    p0 = __builtin_amdgcn_mfma_f32_32x32x16_bf16(a1, qr[1], p0, 0, 0, 0); p1 = __builtin_amdgcn_mfma_f32_32x32x16_bf16(b1, qr[1], p1, 0, 0, 0);
    asm volatile("s_waitcnt lgkmcnt(2)" ::: "memory"); SBAR();
    p0 = __builtin_amdgcn_mfma_f32_32x32x16_bf16(a2, qr[2], p0, 0, 0, 0); p1 = __builtin_amdgcn_mfma_f32_32x32x16_bf16(b2, qr[2], p1, 0, 0, 0);
    asm volatile("s_waitcnt lgkmcnt(0)" ::: "memory"); SBAR();
    p0 = __builtin_amdgcn_mfma_f32_32x32x16_bf16(a3, qr[3], p0, 0, 0, 0); p1 = __builtin_amdgcn_mfma_f32_32x32x16_bf16(b3, qr[3], p1, 0, 0, 0);
}
struct VSet { s16x4 l0, h0, l1, h1, l2, h2, l3, h3; };
template <int KS> __device__ __forceinline__ void tr_group(VSet& s, int vb) {
    s.l0 = tr_read<v_rd_off(0, KS, 0)>(vb); s.h0 = tr_read<v_rd_off(0, KS, 1)>(vb); s.l1 = tr_read<v_rd_off(1, KS, 0)>(vb); s.h1 = tr_read<v_rd_off(1, KS, 1)>(vb);
    s.l2 = tr_read<v_rd_off(2, KS, 0)>(vb); s.h2 = tr_read<v_rd_off(2, KS, 1)>(vb); s.l3 = tr_read<v_rd_off(3, KS, 0)>(vb); s.h3 = tr_read<v_rd_off(3, KS, 1)>(vb);
}
__device__ __forceinline__ void mm_group(f32x16* o, bf16x8 pa, const VSet& s) {
#define PKV(L, H) (bf16x8){L[0], L[1], L[2], L[3], H[0], H[1], H[2], H[3]}
    o[0] = __builtin_amdgcn_mfma_f32_32x32x16_bf16(pa, PKV(s.l0, s.h0), o[0], 0, 0, 0);
    o[1] = __builtin_amdgcn_mfma_f32_32x32x16_bf16(pa, PKV(s.l1, s.h1), o[1], 0, 0, 0);
    o[2] = __builtin_amdgcn_mfma_f32_32x32x16_bf16(pa, PKV(s.l2, s.h2), o[2], 0, 0, 0);
    o[3] = __builtin_amdgcn_mfma_f32_32x32x16_bf16(pa, PKV(s.l3, s.h3), o[3], 0, 0, 0);
#undef PKV
}
#define LWAIT(n) do { asm volatile("s_waitcnt lgkmcnt(" #n ")" ::: "memory"); SBAR(); } while (0)
__device__ __forceinline__ void segm_body(f32x16& p0, f32x16& p1, f32x16* o, const int (&ka)[4], int vb, const bf16x8* qr, const f32x16& negm, bf16x8 pa0, bf16x8 pa1, bf16x8 pa2, bf16x8 pa3) {
    const bf16x8 a0 = lds_rd128(ka[0]), b0 = lds_rd128_hi(ka[0]), a1 = lds_rd128(ka[1]), b1 = lds_rd128_hi(ka[1]);
    const bf16x8 a2 = lds_rd128(ka[2]), b2 = lds_rd128_hi(ka[2]), a3 = lds_rd128(ka[3]), b3 = lds_rd128_hi(ka[3]);
    VSet sa, sb;
    tr_group<0>(sa, vb);
    LWAIT(14);
    p0 = __builtin_amdgcn_mfma_f32_32x32x16_bf16(a0, qr[0], negm, 0, 0, 0); p1 = __builtin_amdgcn_mfma_f32_32x32x16_bf16(b0, qr[0], negm, 0, 0, 0);
    LWAIT(12);
    p0 = __builtin_amdgcn_mfma_f32_32x32x16_bf16(a1, qr[1], p0, 0, 0, 0); p1 = __builtin_amdgcn_mfma_f32_32x32x16_bf16(b1, qr[1], p1, 0, 0, 0);
    LWAIT(10);
    p0 = __builtin_amdgcn_mfma_f32_32x32x16_bf16(a2, qr[2], p0, 0, 0, 0); p1 = __builtin_amdgcn_mfma_f32_32x32x16_bf16(b2, qr[2], p1, 0, 0, 0);
    LWAIT(8);
    p0 = __builtin_amdgcn_mfma_f32_32x32x16_bf16(a3, qr[3], p0, 0, 0, 0); p1 = __builtin_amdgcn_mfma_f32_32x32x16_bf16(b3, qr[3], p1, 0, 0, 0);
    tr_group<1>(sb, vb);
    LWAIT(8);
    mm_group(o, pa0, sa);
    tr_group<2>(sa, vb);
    LWAIT(8);
    mm_group(o, pa1, sb);
    tr_group<3>(sb, vb);
    LWAIT(8);
    mm_group(o, pa2, sa);
    LWAIT(0);
    mm_group(o, pa3, sb);
}
__device__ __forceinline__ void diff_unit(LAS char* lds, const AttnArgs& a) {
    int tid_ = threadIdx.x; asm volatile("" : "+v"(tid_));
    const int tid = tid_, wid = __builtin_amdgcn_readfirstlane(tid >> 6), lane = tid & 63, r32 = lane & 31, hi = lane >> 5;
    const int half = wid >> 2, map = wid >> 2, qg = wid & 3;
    LAS char* V_lds = lds + V3_OFF; LAS char* K_lds = lds + K3_OFF;
    LAS float* wsf = (LAS float*)(lds + WSF3_OFF) + wid * 64; LAS float* li_l = wsf; LAS float* al_l = wsf + 32;
    float mref = 0.f, l_reg = 0; f32x16 o[4] = {}; bf16x8 qr[4]; f32x16 negm = {};
    const bf16_t* Qw = a.Q + (size_t)(qg * 32 + r32) * LDP + map * 64 + hi * 8;
#pragma unroll
    for (int d0 = 0; d0 < 4; ++d0) qr[d0] = ld8(Qw + d0 * 16);
    const int sr = tid >> 4, sc = (tid & 15) * 8, vst0 = v_st(sr, sc), vst1 = v_st(32 + sr, sc);
    const unsigned go0 = (unsigned)(sr * LDP + sc) * 2u, go1 = (unsigned)((32 + sr) * LDP + sc) * 2u;
    const int vb0 = (int)(uintptr_t)V_lds + v_rd_base(lane);
    int kb_[4];
#pragma unroll
    for (int d0 = 0; d0 < 4; ++d0) kb_[d0] = (int)(uintptr_t)K_lds + KSWZ(r32, ((map * 4 + d0) * 16 + hi * 8) * 2);
    const int n1 = a.n1, n2 = a.n2, NT = a.NT;
    bf16x8 vs0, vs1, ks0, ks1;
#define SLOAD(j) do { const int _j = (j); const int _j2 = min(_j - n1, n2 - 1); \
    const char* _Kt = (const char*)((_j < n1) ? a.K1 + (size_t)_j * 64 * LDP : a.K2 + (size_t)_j2 * 64 * LDP); \
    const char* _Vt = (const char*)((_j < n1) ? a.V1 + (size_t)_j * 64 * LDP : a.V2 + (size_t)_j2 * 64 * LDP); \
    vs0 = *(const bf16x8*)(_Vt + go0); vs1 = *(const bf16x8*)(_Vt + go1); ks0 = *(const bf16x8*)(_Kt + go0); ks1 = *(const bf16x8*)(_Kt + go1); } while (0)
#define SWRITE(so) do { *(LAS bf16x8*)(V_lds + (so) + vst0) = vs0; *(LAS bf16x8*)(V_lds + (so) + vst1) = vs1; const int kc = sc * 2; \
    *(LAS bf16x8*)(K_lds + (so) + KSWZ(sr, kc)) = ks0; *(LAS bf16x8*)(K_lds + (so) + KSWZ(32 + sr, kc)) = ks1; } while (0)
#define BAR() do { SBAR(); asm volatile("s_waitcnt lgkmcnt(0)" ::: "memory"); __builtin_amdgcn_s_barrier(); SBAR(); } while (0)
#define PIN(X) asm volatile("" : "+v"(X))
#define SEGV(X0, X1, t) do { \
    float rm = X0[0]; \
    _Pragma("unroll") for (int r = 1; r < 16; ++r) rm = fmaxf(rm, X0[r]); \
    _Pragma("unroll") for (int r = 0; r < 16; ++r) rm = fmaxf(rm, X1[r]); \
    { auto rr = __builtin_amdgcn_permlane32_swap(__float_as_uint(rm), __float_as_uint(rm), false, false); rm = fmaxf(__uint_as_float(rr[0]), __uint_as_float(rr[1])); } \
    if (__builtin_expect((t) == 0 || __any(rm > THRL), 0)) { const float dl = ((t) == 0) ? rm : fmaxf(rm, 0.f); mref += dl; \
        _Pragma("unroll") for (int r = 0; r < 16; ++r) { X0[r] -= dl; X1[r] -= dl; } \
        _Pragma("unroll") for (int r = 0; r < 16; ++r) negm[r] = -mref; \
        const float f = __builtin_amdgcn_exp2f(-dl); l_reg *= f; if (hi == 0) al_l[r32] = f; asm volatile("s_waitcnt lgkmcnt(0)" ::: "memory"); \
        _Pragma("unroll") for (int d = 0; d < 4; ++d) _Pragma("unroll") for (int r = 0; r < 16; ++r) o[d][r] *= al_l[crow(r, hi)]; } \
    sm_exp(X0); sm_exp(X1); \
    sm_finish(X0, X1, 1.0f, l_reg, pa0, pa1, pa2, pa3); \
    PIN(pa0); PIN(pa1); PIN(pa2); PIN(pa3); \
    if ((t) + 1 + half < NT) { SWRITE(s_w); } \
    if ((t) + 2 + half < NT) { SLOAD((t) + 2 + half); } \
    s_w = (s_w == 2 * SHM_V) ? 0 : s_w + SHM_V; } while (0)
#if defined(PROBE_DUPQK)
#define PROBE_DUPQK_STMT(X0, X1) { int ka_[4]; _Pragma("unroll") for (int d0 = 0; d0 < 4; ++d0) ka_[d0] = kb_[d0] + s_k; qkt_cb(X0, X1, ka_, qr, negm); } PIN(X0); PIN(X1);
#else
#define PROBE_DUPQK_STMT(X0, X1)
#endif
#define SEGM(X0, X1, t) do { \
    PROBE_DUPQK_STMT(X0, X1) \
    { int ka_[4]; _Pragma("unroll") for (int d0 = 0; d0 < 4; ++d0) ka_[d0] = kb_[d0] + s_k; segm_body(X0, X1, o, ka_, vb0 + s_v, qr, negm, pa0, pa1, pa2, pa3); }     \
    s_v = s_k; s_k = (s_k == 2 * SHM_V) ? 0 : s_k + SHM_V; } while (0)
    f32x16 pA0, pA1; bf16x8 pa0, pa1, pa2, pa3;
    SLOAD(0); SWRITE(0);
    if (half) { SLOAD(1); SWRITE(SHM_V); }
    SLOAD(1 + half);
    BAR();
    qkt_c(pA0, pA1, K_lds, qr, negm, r32, hi, map * 4);
    if (half) { __builtin_amdgcn_s_setprio(1); BAR(); }
    int s_w = (1 + half) * SHM_V;
    int s_v = 0, s_k = SHM_V;
    for (int t = 0; t < NT; ++t) {
        { TPROBE_BEGIN(3); SEGV(pA0, pA1, t); TPROBE_END(3); }  { TPROBE_BEGIN(5); BAR(); TPROBE_END(5); }
        { TPROBE_BEGIN(4); SEGM(pA0, pA1, t); TPROBE_END(4); }  { TPROBE_BEGIN(5); BAR(); TPROBE_END(5); }
    }
    if (!half) BAR();
    __builtin_amdgcn_s_setprio(0);
    asm volatile("s_waitcnt vmcnt(0)" ::: "memory");
    attn_epilogue<0>(lds, a, o, l_reg, li_l, map, qg, r32, hi);
#undef SLOAD
#undef SWRITE
#undef BAR
#undef PIN
#undef SEGV
#undef SEGM
}

template <int OFF> __device__ __forceinline__ float lds_rd32(int addr) { float r; asm volatile("ds_read_b32 %0, %1 offset:%2" : "=&v"(r) : "v"(addr), "i"(OFF) : "memory"); return r; }
__device__ __forceinline__ void na_unit(LAS char* lds, const AttnArgs& a) {
    constexpr float SC = ModeC<1>::SC;
    int tid_ = threadIdx.x; asm volatile("" : "+v"(tid_));
    const int tid = tid_, wid = __builtin_amdgcn_readfirstlane(tid >> 6), lane = tid & 63, r32 = lane & 31, hi = lane >> 5;
    LAS char* V_lds = lds; LAS char* K_lds = lds + 2 * SHM_V;
    LAS float* wsf = (LAS float*)(lds + WSF_OFF) + wid * 64; LAS float* li_l = wsf; LAS float* al_l = wsf + 32;
    LAS float* bias_l = (LAS float*)(lds + BIAS_OFF);
    float m_reg = -1e30f, l_reg = 0; f32x16 o[4] = {}; bf16x8 qr[8];
    const bf16_t* Qw = a.Q + (size_t)(wid * 32 + r32) * LDP + hi * 8;
#pragma unroll
    for (int d0 = 0; d0 < 8; ++d0) qr[d0] = ld8(Qw + d0 * 16);
    const int nr = a.R0 + (wid >> 1), nqc = 32 * (wid & 1) + r32;
    const int ncs = min(max(nqc - 8, 0), 48), nrs = min(max(nr - 4, 0), 56);
    if (tid < 465) bias_l[tid] = a.rpb[tid] * (1.0f / SC);
    const int sr = tid >> 4, sc = (tid & 15) * 8, vst0 = v_st(sr, sc), vst1 = v_st(32 + sr, sc);
    const int vb0 = (int)(uintptr_t)V_lds + v_rd_base(lane);
    const int n1 = a.n1, NT = a.n1 + a.n2;
    struct { bf16x8 vs0, vs1, ks0, ks1; } st_[2];
#define NA_SLOAD(i, j) do { const int _j = (j); const bf16_t* _Kt = (_j < n1) ? a.K1 + (size_t)_j * 64 * LDP : a.K2 + (size_t)(_j - n1) * 64 * LDP; \
    const bf16_t* _Vt = (_j < n1) ? a.V1 + (size_t)_j * 64 * LDP : a.V2 + (size_t)(_j - n1) * 64 * LDP; \
    st_[i].vs0 = ld8(_Vt + (size_t)sr * LDP + sc); st_[i].vs1 = ld8(_Vt + (size_t)(32 + sr) * LDP + sc); st_[i].ks0 = ld8(_Kt + (size_t)sr * LDP + sc); st_[i].ks1 = ld8(_Kt + (size_t)(32 + sr) * LDP + sc); } while (0)
#define NA_SWRITE(i, buf) do { const int kc = sc * 2; \
    *(LAS bf16x8*)(V_lds + (buf) * SHM_V + vst0) = st_[i].vs0; *(LAS bf16x8*)(V_lds + (buf) * SHM_V + vst1) = st_[i].vs1; \
    *(LAS bf16x8*)(K_lds + (buf) * SHM_K + KSWZ(sr, kc)) = st_[i].ks0; *(LAS bf16x8*)(K_lds + (buf) * SHM_K + KSWZ(32 + sr, kc)) = st_[i].ks1; } while (0)
    NA_SLOAD(0, 0); if (1 < NT) NA_SLOAD(1, 1);
    TPROBE_BEGIN(14);
    for (int j = 0; j < NT; ++j) {
        const int buf = j & 1;
        if (buf == 0) { NA_SWRITE(0, 0); if (j + 2 < NT) NA_SLOAD(0, j + 2); }
        else          { NA_SWRITE(1, 1); if (j + 2 < NT) NA_SLOAD(1, j + 2); }
        __syncthreads();
        const int kr = a.kfirst + j;
        const bool loc = j < n1;
        const bool act = loc ? (kr >= nrs && kr <= nrs + 7) : true;
        TPROBE_BEGIN(13);
        if (act) {
            f32x16 p0, p1; float mn, al; bf16x8 pa0, pa1, pa2, pa3;
            {
              const int kx = (int)(uintptr_t)(K_lds + buf * SHM_K) + r32 * 256, x0 = (hi * 16) ^ ((r32 & 15) << 4);
              const bf16x8 a0 = lds_rd128(kx + (x0 ^ 0)), b0 = lds_rd128_hi(kx + (x0 ^ 0)), a1 = lds_rd128(kx + (x0 ^ 32)), b1 = lds_rd128_hi(kx + (x0 ^ 32));
              const bf16x8 a2 = lds_rd128(kx + (x0 ^ 64)), b2 = lds_rd128_hi(kx + (x0 ^ 64)), a3 = lds_rd128(kx + (x0 ^ 96)), b3 = lds_rd128_hi(kx + (x0 ^ 96));
              const bf16x8 a4 = lds_rd128(kx + (x0 ^ 128)), b4 = lds_rd128_hi(kx + (x0 ^ 128)), a5 = lds_rd128(kx + (x0 ^ 160)), b5 = lds_rd128_hi(kx + (x0 ^ 160));
              const bf16x8 a6 = lds_rd128(kx + (x0 ^ 192)), b6 = lds_rd128_hi(kx + (x0 ^ 192)), a7 = lds_rd128(kx + (x0 ^ 224)), b7 = lds_rd128_hi(kx + (x0 ^ 224));
              const f32x16 z = {};
              LWAIT(14); p0 = __builtin_amdgcn_mfma_f32_32x32x16_bf16(a0, qr[0], z, 0, 0, 0); p1 = __builtin_amdgcn_mfma_f32_32x32x16_bf16(b0, qr[0], z, 0, 0, 0);
              LWAIT(12); p0 = __builtin_amdgcn_mfma_f32_32x32x16_bf16(a1, qr[1], p0, 0, 0, 0); p1 = __builtin_amdgcn_mfma_f32_32x32x16_bf16(b1, qr[1], p1, 0, 0, 0);
              LWAIT(10); p0 = __builtin_amdgcn_mfma_f32_32x32x16_bf16(a2, qr[2], p0, 0, 0, 0); p1 = __builtin_amdgcn_mfma_f32_32x32x16_bf16(b2, qr[2], p1, 0, 0, 0);
              LWAIT(8);  p0 = __builtin_amdgcn_mfma_f32_32x32x16_bf16(a3, qr[3], p0, 0, 0, 0); p1 = __builtin_amdgcn_mfma_f32_32x32x16_bf16(b3, qr[3], p1, 0, 0, 0);
              LWAIT(6);  p0 = __builtin_amdgcn_mfma_f32_32x32x16_bf16(a4, qr[4], p0, 0, 0, 0); p1 = __builtin_amdgcn_mfma_f32_32x32x16_bf16(b4, qr[4], p1, 0, 0, 0);
              LWAIT(4);  p0 = __builtin_amdgcn_mfma_f32_32x32x16_bf16(a5, qr[5], p0, 0, 0, 0); p1 = __builtin_amdgcn_mfma_f32_32x32x16_bf16(b5, qr[5], p1, 0, 0, 0);
              LWAIT(2);  p0 = __builtin_amdgcn_mfma_f32_32x32x16_bf16(a6, qr[6], p0, 0, 0, 0); p1 = __builtin_amdgcn_mfma_f32_32x32x16_bf16(b6, qr[6], p1, 0, 0, 0);
              LWAIT(0);  p0 = __builtin_amdgcn_mfma_f32_32x32x16_bf16(a7, qr[7], p0, 0, 0, 0); p1 = __builtin_amdgcn_mfma_f32_32x32x16_bf16(b7, qr[7], p1, 0, 0, 0); }
            if (loc) {
                const int rel = kr - nr + 7; const int bb = (int)(uintptr_t)bias_l + 4 * (rel * 31 + 15 - nqc + 4 * hi);
                float bv0[16], bv1[16];
#define BRD(r) bv0[r] = lds_rd32<4 * (((r) & 3) + 8 * ((r) >> 2))>(bb); bv1[r] = lds_rd32<4 * (((r) & 3) + 8 * ((r) >> 2)) + 128>(bb);
                BRD(0) BRD(1) BRD(2) BRD(3) BRD(4) BRD(5) BRD(6) BRD(7) BRD(8) BRD(9) BRD(10) BRD(11) BRD(12) BRD(13) BRD(14) BRD(15)
#undef BRD
                asm volatile("s_waitcnt lgkmcnt(0)" ::: "memory"); SBAR();
#pragma unroll
                for (int r = 0; r < 16; ++r) { const int kc0 = crow(r, hi), kc1 = 32 + kc0;
                    const bool v0 = (unsigned)(kc0 - ncs) < 16u, v1 = (unsigned)(kc1 - ncs) < 16u;
                    p0[r] = v0 ? p0[r] + bv0[r] : -1e30f; p1[r] = v1 ? p1[r] + bv1[r] : -1e30f; }
            }
            partialSM<1>(p0, p1, m_reg, mn, al);
            if (__any(al < 1.f)) { if (hi == 0) al_l[r32] = al; asm volatile("s_waitcnt lgkmcnt(0)" ::: "memory");
#pragma unroll
                for (int d = 0; d < 4; ++d)
#pragma unroll
                    for (int r = 0; r < 16; ++r) o[d][r] *= al_l[crow(r, hi)]; }
            finishSM(p0, p1, al, l_reg, pa0, pa1, pa2, pa3);
            pv_d0(o, vb0 + buf * SHM_V, pa0, pa1, pa2, pa3);
        }
        TPROBE_END(13);
    }
    TPROBE_END(14);
#undef NA_SLOAD
#undef NA_SWRITE
    attn_epilogue<1>(lds, a, o, l_reg, li_l, 0, wid, r32, hi);
}

struct MlpArgs { const bf16_t* Prow; bf16_t* Yrow; const bf16_t* Wsb; const float *lng, *lnb, *bs, *mg; int g; };
__device__ __forceinline__ void mlp_unit(LAS char* lds, const MlpArgs& a) {
    int tid_ = threadIdx.x; asm volatile("" : "+v"(tid_));
    const int tid = tid_, wid = __builtin_amdgcn_readfirstlane(tid >> 6), lane = tid & 63, r32 = lane & 31, hi = lane >> 5;
    const int sr = tid >> 4, sc = (tid & 15) * 8, g = a.g;
    const f32x4 lg0 = *(const f32x4*)(a.lng + g * 128 + sc), lg1 = *(const f32x4*)(a.lng + g * 128 + sc + 4);
    const f32x4 lb0 = *(const f32x4*)(a.lnb + g * 128 + sc), lb1 = *(const f32x4*)(a.lnb + g * 128 + sc + 4);
#pragma unroll
    for (int t = 0; t < 4; ++t) {
        const int q = t * 32 + sr;
        const u32x4 w = *(const u32x4*)(a.Prow + (size_t)q * LDP + C_MV + g * 128 + sc);
        float v[8] = {bf_lo(w.x), bf_hi(w.x), bf_lo(w.y), bf_hi(w.y), bf_lo(w.z), bf_hi(w.z), bf_lo(w.w), bf_hi(w.w)};
        float s = 0.f;
#pragma unroll
        for (int e = 0; e < 8; ++e) s += v[e];
        s += __shfl_xor(s, 1); s += __shfl_xor(s, 2); s += __shfl_xor(s, 4); s += __shfl_xor(s, 8);
        const float mu = s * (1.0f / 128.0f); float qq = 0.f;
#pragma unroll
        for (int e = 0; e < 8; ++e) { v[e] -= mu; qq += v[e] * v[e]; }
        qq += __shfl_xor(qq, 1); qq += __shfl_xor(qq, 2); qq += __shfl_xor(qq, 4); qq += __shfl_xor(qq, 8);
        const float rstd = __builtin_amdgcn_rsqf(qq * (1.0f / 128.0f) + EPS);
        u32x4 ow;
        ow.x = cvt_pk_bf16(v[0] * rstd * lg0[0] + lb0[0], v[1] * rstd * lg0[1] + lb0[1]); ow.y = cvt_pk_bf16(v[2] * rstd * lg0[2] + lb0[2], v[3] * rstd * lg0[3] + lb0[3]);
        ow.z = cvt_pk_bf16(v[4] * rstd * lg1[0] + lb1[0], v[5] * rstd * lg1[1] + lb1[1]); ow.w = cvt_pk_bf16(v[6] * rstd * lg1[2] + lb1[2], v[7] * rstd * lg1[3] + lb1[3]);
        *(LAS u32x4*)(lds + (q >> 6) * SHM_V + v_st(q & 63, sc)) = ow;
    }
    const int prow0 = 32 * (wid & 3), dsel = wid >> 2;
    bf16x8 pa[8];
    const bf16_t* wp = a.Wsb + ((size_t)(g * 128 + prow0 + r32)) * 128 + 8 * hi;
#pragma unroll
    for (int s = 0; s < 8; ++s) pa[s] = ld8(wp + 16 * s);
    __syncthreads();
    f32x16 o0 = {}, o1 = {};
    const int vb0 = (int)(uintptr_t)lds + v_rd_base(lane);
    if (dsel == 0) { pv_one<0>(o0, vb0, pa[0], pa[1], pa[2], pa[3]); pv_one<1>(o1, vb0, pa[0], pa[1], pa[2], pa[3]);
                     pv_one<0>(o0, vb0 + SHM_V, pa[4], pa[5], pa[6], pa[7]); pv_one<1>(o1, vb0 + SHM_V, pa[4], pa[5], pa[6], pa[7]); }
    else           { pv_one<2>(o0, vb0, pa[0], pa[1], pa[2], pa[3]); pv_one<3>(o1, vb0, pa[0], pa[1], pa[2], pa[3]);
                     pv_one<2>(o0, vb0 + SHM_V, pa[4], pa[5], pa[6], pa[7]); pv_one<3>(o1, vb0 + SHM_V, pa[4], pa[5], pa[6], pa[7]); }
    __syncthreads();
    LAS float* X = (LAS float*)lds;
#pragma unroll
    for (int r = 0; r < 16; ++r) { X[(prow0 + crow(r, hi)) * XS + (2 * dsel) * 32 + r32] = o0[r]; X[(prow0 + crow(r, hi)) * XS + (2 * dsel + 1) * 32 + r32] = o1[r]; }
    __syncthreads();
    final_pass<true>(X, 128, a.Prow + C_MZ + g * 128, a.Yrow + 1536 + g * 128, a.mg + g * 128, 1.0f, a.Prow + C_MU + g * 128, a.bs + g * 128);
    __syncthreads();
}
}

__device__ __forceinline__ void p0_transpose_item(const float* W, int K, int N, bf16_t* WT, LAS float* scr, int item, int lane) {
    const int nblk = N / 32, kb = item / nblk, nb = item % nblk, k0 = 64 * kb, n0 = 32 * nb;
#pragma unroll 8
    for (int i = 0; i < 32; ++i) { const int kk = 2 * i + (lane >> 5); scr[kk * 33 + (lane & 31)] = W[(size_t)(k0 + kk) * N + n0 + (lane & 31)]; }
    asm volatile("s_waitcnt lgkmcnt(0)" ::: "memory");
    const int c = lane & 7;
#pragma unroll
    for (int j = 0; j < 4; ++j) { const int n = (lane >> 3) + 8 * j; const LAS float* s = scr + (8 * c) * 33 + n;
        u32x4 o; o.x = cvt_pk_bf16(s[0 * 33], s[1 * 33]); o.y = cvt_pk_bf16(s[2 * 33], s[3 * 33]); o.z = cvt_pk_bf16(s[4 * 33], s[5 * 33]); o.w = cvt_pk_bf16(s[6 * 33], s[7 * 33]);
        *(u32x4*)(WT + (size_t)(n0 + n) * K + k0 + 8 * c) = o; }
    asm volatile("s_waitcnt lgkmcnt(0)" ::: "memory");
}

__device__ __forceinline__ void phase0a(const Params& p, LAS unsigned char* lds, int tid, int lane, int wave) {
    const int gw = blockIdx.x * 8 + wave, ngw = gridDim.x * 8;
    unsigned char* ws = p.ws;
    LAS float* scr = (LAS float*)(lds + wave * 16384);
    float* mod = (float*)(ws + WS_CTL + CTL_MOD);
    for (int it = (int)blockIdx.x + (int)gridDim.x * wave; it < 768; it += (int)gridDim.x * 8) {
        const int l = it / 384, r = it % 384, kc = r / 24, nc = r % 24;
        const float* W = p.ada_w + (size_t)l * DM * 6144 + nc * 256 + lane * 4;
        f32x4 acc[5];
#pragma unroll
        for (int b = 0; b < 5; ++b) acc[b] = (f32x4){0.f, 0.f, 0.f, 0.f};
        for (int half = 0; half < 2; ++half) {
            const int k0 = kc * 128 + half * 64;
            float sv[5];
#pragma unroll
            for (int b = 0; b < 4; ++b) sv[b] = silu_f(p.c[b * DM + k0 + lane]);
            sv[4] = silu_f(p.c_ctx[k0 + lane]);
#pragma unroll 8
            for (int kk = 0; kk < 64; ++kk) {
                const f32x4 w4 = *(const f32x4*)(W + (size_t)(k0 + kk) * 6144);
#pragma unroll
                for (int b = 0; b < 5; ++b) { const float s = __uint_as_float(__builtin_amdgcn_readlane(__float_as_uint(sv[b]), kk)); acc[b] += w4 * s; }
            }
        }
        if (kc == 0) { const f32x4 bv = *(const f32x4*)(p.ada_b + l * 6144 + nc * 256 + lane * 4);
#pragma unroll
            for (int b = 0; b < 5; ++b) acc[b] += bv; }
#pragma unroll
        for (int b = 0; b < 5; ++b) { float* dst = mod + ((size_t)(l * 5 + b)) * 6144 + nc * 256 + lane * 4;
#pragma unroll
            for (int e = 0; e < 4; ++e) atomicAdd(dst + e, acc[b][e]); }
    }
    float* tab = (float*)(ws + WS_TAB);
    if (gw == ngw - 1) {
        for (int idx = lane; idx < 1024; idx += 64) { const int pos = idx >> 4, i = idx & 15;
            const float freq = powf(10000.0f, -(float)i / 16.0f); const float ang = (float)pos * freq;
            tab[idx] = cosf(ang); tab[1024 + idx] = sinf(ang); }
    }
    if (gw == ngw - 2) {
        for (int l = 0; l < 2; ++l) {
            const float s1 = wave_sum(p.lq1[l * 64 + lane] * p.lk1[l * 64 + lane]), s2 = wave_sum(p.lq2[l * 64 + lane] * p.lk2[l * 64 + lane]);
            const float lam_init = 0.8f - 0.6f * expf(-0.3f * (float)l);
            if (lane == 0) tab[2048 + l] = expf(s1) - expf(s2) + lam_init;
        }
    }
    { bf16_t* wsb = (bf16_t*)(ws + WS_WSB); const int gt = blockIdx.x * 512 + tid;
      if (gt < 16384) { const f32x4 a = *(const f32x4*)(p.mws + gt * 8), b = *(const f32x4*)(p.mws + gt * 8 + 4);
          u32x4 o; o.x = cvt_pk_bf16(a[0], a[1]); o.y = cvt_pk_bf16(a[2], a[3]); o.z = cvt_pk_bf16(b[0], b[1]); o.w = cvt_pk_bf16(b[2], b[3]); *(u32x4*)(wsb + gt * 8) = o; } }
}

__device__ __forceinline__ void phase0b(const Params& p, LAS unsigned char* lds, int tid, int lane, int wave) {
    const int gw = blockIdx.x * 8 + wave, ngw = gridDim.x * 8;
    unsigned char* ws = p.ws;
    LAS float* scr = (LAS float*)(lds + wave * 16384);
    bf16_t* WinT = (bf16_t*)(ws + WS_WIN); bf16_t* WoutT = (bf16_t*)(ws + WS_WOUT);
    constexpr int I_IN = (DM / 64) * (INW / 32), I_OUT = (DM / 64) * (DM / 32), I_L = I_IN + I_OUT;
    for (int it = gw; it < 2 * I_L; it += ngw) {
        const int l = it / I_L, r = it % I_L;
        if (r < I_IN) p0_transpose_item(p.w_in + (size_t)l * DM * INW, DM, INW, WinT + (size_t)l * INW * DM, scr, r, lane);
        else p0_transpose_item(p.w_out + (size_t)l * DM * DM, DM, DM, WoutT + (size_t)l * DM * DM, scr, r - I_IN, lane);
    }
}

template <int L>
__device__ __forceinline__ void norm_phase(const Params& p, int lane, int wave) {
    const int gw = blockIdx.x * 8 + wave, ngw = gridDim.x * 8;
    unsigned char* ws = p.ws;
    const float* mod = (const float*)(ws + WS_CTL + CTL_MOD);
    const float* rowss = (const float*)(ws + WS_CTL + CTL_ROWSS);
    const bf16_t* Y0 = (const bf16_t*)(ws + WS_Y0); const bf16_t* Y1 = (const bf16_t*)(ws + WS_P);
    bf16_t* H = (bf16_t*)(ws + WS_H);
    const int nrows = (L == 2) ? NLAT : MROWS;
    int bcur2 = -1; f32x4 ga[4][2], gb[4][2];
    int bcur = -1; f32x4 gq[2][4][2];
    for (int row = gw; row < nrows; row += ngw) {
        const bool isctx = row >= NLAT; const int b = isctx ? 4 : (row >> 12);
        const float* xin = isctx ? p.ctx + (size_t)(row - NLAT) * DM : p.x + (size_t)row * DM;
        f32x4 v[4][2];
#pragma unroll
        for (int j = 0; j < 4; ++j) { v[j][0] = *(const f32x4*)(xin + 8 * lane + 512 * j); v[j][1] = *(const f32x4*)(xin + 8 * lane + 512 * j + 4); }
        if (L >= 1 && b != bcur) { bcur = b;
#pragma unroll
            for (int lp = 0; lp < 2; ++lp) if (lp < L) {
                const float* gate = mod + ((size_t)(lp * 5 + b)) * 6144 + 4096; const float* pg = p.post_g + lp * DM;
#pragma unroll
                for (int j = 0; j < 4; ++j)
#pragma unroll
                    for (int e = 0; e < 2; ++e) { const int cidx = 8 * lane + 512 * j + 4 * e; gq[lp][j][e] = *(const f32x4*)(gate + cidx) * *(const f32x4*)(pg + cidx); } } }
#pragma unroll
        for (int lp = 0; lp < 2; ++lp) {
            if (lp < L) {
                const float rs = __builtin_amdgcn_rsqf(rowss[lp * MROWS + row] * (1.0f / DM) + EPS);
                const bf16_t* Yb = (lp == 0) ? Y0 : Y1;
#pragma unroll
                for (int j = 0; j < 4; ++j) { const int cidx = 8 * lane + 512 * j;
                    const u32x4 w = *(const u32x4*)(Yb + (size_t)row * DM + cidx);
                    const f32x4 y0 = {bf_lo(w.x), bf_hi(w.x), bf_lo(w.y), bf_hi(w.y)}, y1 = {bf_lo(w.z), bf_hi(w.z), bf_lo(w.w), bf_hi(w.w)};
                    v[j][0] = v[j][0] + gq[lp][j][0] * (y0 * rs); v[j][1] = v[j][1] + gq[lp][j][1] * (y1 * rs); }
            }
        }
        if (L == 2) {
            float* xo = p.out + (size_t)row * DM;
#pragma unroll
            for (int j = 0; j < 4; ++j) { *(f32x4*)(xo + 8 * lane + 512 * j) = v[j][0]; *(f32x4*)(xo + 8 * lane + 512 * j + 4) = v[j][1]; }
        } else {
            float ss = 0.f;
#pragma unroll
            for (int j = 0; j < 4; ++j)
#pragma unroll
                for (int e = 0; e < 2; ++e) ss += (v[j][e][0] * v[j][e][0] + v[j][e][1] * v[j][e][1]) + (v[j][e][2] * v[j][e][2] + v[j][e][3] * v[j][e][3]);
            ss = wave_sum(ss);
            const float rstd = __builtin_amdgcn_rsqf(ss * (1.0f / DM) + EPS);
            if (b != bcur2) { bcur2 = b;
                const float* shift = mod + ((size_t)(L * 5 + b)) * 6144; const float* scale = shift + 2048; const float* pg = p.pre_g + L * DM;
#pragma unroll
                for (int j = 0; j < 4; ++j)
#pragma unroll
                    for (int e = 0; e < 2; ++e) { const int cidx = 8 * lane + 512 * j + 4 * e; ga[j][e] = *(const f32x4*)(pg + cidx) * (*(const f32x4*)(scale + cidx) + 1.0f); gb[j][e] = *(const f32x4*)(shift + cidx); } }
#pragma unroll
            for (int j = 0; j < 4; ++j) { const int cidx = 8 * lane + 512 * j;
                f32x4 hv[2];
#pragma unroll
                for (int e = 0; e < 2; ++e) { hv[e] = (v[j][e] * rstd) * ga[j][e] + gb[j][e]; }
                u32x4 w; w.x = cvt_pk_bf16(hv[0][0], hv[0][1]); w.y = cvt_pk_bf16(hv[0][2], hv[0][3]); w.z = cvt_pk_bf16(hv[1][0], hv[1][1]); w.w = cvt_pk_bf16(hv[1][2], hv[1][3]);
                *(u32x4*)(H + (size_t)row * DM + cidx) = w; }
        }
    }
}

template <int L>
__device__ __forceinline__ void mixer_phase(const Params& p, LAS unsigned char* lds8, int tid, int qslot, int umask) {
    LAS char* lds = (LAS char*)lds8;
    unsigned char* ws = p.ws;
    const bf16_t* P = (const bf16_t*)(ws + WS_P);
    bf16_t* Y = (bf16_t*)(ws + WS_H);
    const float* tab = (const float*)(ws + WS_TAB);
    const float lam = tab[2048 + L];
    const float lam_init = (L == 0) ? 0.2f : 0.35550906759096926f;
    unsigned* qctr = (unsigned*)(ws + WS_CTL + CTL_QCTR) + 64 * qslot;
    volatile LAS unsigned* misc = (volatile LAS unsigned*)(lds8 + MISC_OFF);
    constexpr int N_DIFF = NB * 6 * 32, N_NA = NB * 6 * 16, N_DIFFC = (L == 0) ? NB * 6 * 2 : 0, N_SMC = (L == 0) ? NB * 6 : 0, N_MLP = NB * 32 * 4, N_MLPC = (L == 0) ? NB * 2 * 4 : 0;
    constexpr int NU = N_DIFF + N_NA + N_DIFFC + N_SMC + N_MLP + N_MLPC;
#define PULL() do { if (tid == 0) misc[0] = atomicAdd(qctr, 1u); __syncthreads(); u = (int)misc[0]; __syncthreads(); } while (0)
    int u; PULL();
    constexpr int E_DIFF = N_DIFF, E_NA = E_DIFF + N_NA, E_DIFFC = E_NA + N_DIFFC, E_SMC = E_DIFFC + N_SMC;
    TPROBE_BEGIN(6); unsigned long long _tl = 0; if (PROBE_T == 30 + L && blockIdx.x == 0 && threadIdx.x == 0) _tl = wall_clock64();
    while (u < E_DIFF) { if (!(umask & 1)) { PULL(); continue; }
        if ((PROBE_T == 7 || PROBE_T == 34 + L) && blockIdx.x == 0 && threadIdx.x == 0) { misc[20] = misc[20] + 5000u; }
        const int qb = u & 31, h = (u >> 5) % 6, b = u / 192;
        att::AttnArgs a{};
        const size_t t0 = (size_t)b * SEQ, tq = t0 + qb * 128, tc = (size_t)NLAT + b * CTXL;
        a.Q = P + tq * LDP + C_AQ + h * HD;
        a.K1 = P + t0 * LDP + C_AK + h * HD; a.K2 = P + tc * LDP + C_AK + h * HD;
        a.V1 = P + t0 * LDP + C_AV + h * HD; a.V2 = P + tc * LDP + C_AV + h * HD;
        a.n1 = 64; a.n2 = 4; a.NT = 68;
        a.Z = P + tq * LDP + C_AZ + h * HD; a.Y = Y + tq * DM + h * HD; a.g = p.da_g + L * HD; a.factor = 1.0f - lam_init; a.lam = lam;
        { TPROBE_BEGIN(1); att::diff_unit(lds, a); TPROBE_END(1); }
        PULL();
    }
    TPROBE_END(6); if (PROBE_T == 30 + L && blockIdx.x == 0 && threadIdx.x == 0) { misc[20] = misc[20] + (unsigned)(wall_clock64() - _tl); }
    if (PROBE_T == 32 + L && blockIdx.x == 0 && threadIdx.x == 0) { misc[20] = misc[20] + 5000u * 0u; }
    TPROBE_BEGIN(8);
    while (u >= E_DIFF && u < E_NA) { if (!(umask & 2)) { PULL(); continue; }
        if (PROBE_T == 9 && blockIdx.x == 0 && threadIdx.x == 0) { misc[20] = misc[20] + 5000u; }
        const int v = u - E_DIFF; const int g4 = v & 15, h = (v >> 4) % 6, b = v / 96;
        att::AttnArgs a{};
        const int R0 = 4 * g4, kfirst = min(max(R0 - 4, 0), 56), klast = min(max(R0 - 1, 0), 56) + 7, nloc = klast - kfirst + 1;
        const size_t t0 = (size_t)b * SEQ, tq = t0 + R0 * 64, tk = t0 + kfirst * 64, tc = (size_t)NLAT + b * CTXL;
        a.Q = P + tq * LDP + C_NQ + h * HD;
        a.K1 = P + tk * LDP + C_NK + h * HD; a.K2 = P + tc * LDP + C_NK + h * HD;
        a.V1 = P + tk * LDP + C_NV + h * HD; a.V2 = P + tc * LDP + C_NV + h * HD;
        a.n1 = nloc; a.n2 = 4; a.NT = nloc + 4;
        a.R0 = R0; a.kfirst = kfirst; a.rpb = p.rpb + ((size_t)(L * 6 + h)) * 465;
        a.Z = P + tq * LDP + C_NZ + h * HD; a.Y = Y + tq * DM + 768 + h * HD; a.g = p.na_g + (L * 6 + h) * HD; a.factor = 1.0f; a.lam = 0.f;
        att::na_unit(lds, a);
        PULL();
    }
    TPROBE_END(8);
    while (L == 0 && u >= E_NA && u < E_DIFFC) { if (!(umask & 4)) { PULL(); continue; }
        const int v = u - E_NA; const int qb = v & 1, h = (v >> 1) % 6, b = v / 12;
        att::AttnArgs a{};
        const size_t tc = (size_t)NLAT + b * CTXL, tq = tc + qb * 128;
        a.Q = P + tq * LDP + C_AQ + h * HD;
        a.K1 = P + tc * LDP + C_AK + h * HD; a.K2 = a.K1; a.V1 = P + tc * LDP + C_AV + h * HD; a.V2 = a.V1;
        a.n1 = 4; a.n2 = 1; a.NT = 4;
        a.Z = P + tq * LDP + C_AZ + h * HD; a.Y = Y + tq * DM + h * HD; a.g = p.da_g + L * HD; a.factor = 1.0f - lam_init; a.lam = lam;
        att::diff_unit(lds, a);
        PULL();
    }
    while (L == 0 && u >= E_DIFFC && u < E_SMC) { if (!(umask & 8)) { PULL(); continue; }
        const int v = u - E_DIFFC; const int h = v % 6, b = v / 6;
        att::AttnArgs a{};
        const size_t tc = (size_t)NLAT + b * CTXL;
        a.Q = P + tc * LDP + C_NQ + h * HD;
        a.K1 = P + tc * LDP + C_NK + h * HD; a.K2 = a.K1; a.V1 = P + tc * LDP + C_NV + h * HD; a.V2 = a.V1;
        a.n1 = 0; a.n2 = 4; a.NT = 4; a.rpb = p.rpb;
        a.Z = P + tc * LDP + C_NZ + h * HD; a.Y = Y + tc * DM + 768 + h * HD; a.g = p.na_g + (L * 6 + h) * HD; a.factor = 1.0f; a.lam = 0.f;
        att::na_unit(lds, a);
        PULL();
    }
    TPROBE_BEGIN(12);
    while (u >= E_SMC && u < NU) { if (!(umask & 16)) { PULL(); continue; }
        const int v = u - E_SMC;
        att::MlpArgs m{};
        size_t t0;
        if (v < N_MLP) { const int g = v & 3, ch = (v >> 2) & 31, b = v >> 7; t0 = (size_t)b * SEQ + ch * 128; m.g = g; }
        else { const int w = v - N_MLP; const int g = w & 3, ch = (w >> 2) & 1, b = w >> 3; t0 = (size_t)NLAT + b * CTXL + ch * 128; m.g = g; }
        m.Prow = P + t0 * LDP; m.Yrow = Y + t0 * DM; m.Wsb = (const bf16_t*)(ws + WS_WSB) + (size_t)L * 4 * 128 * 128;
        m.lng = p.ln_g + L * 512; m.lnb = p.ln_b + L * 512; m.bs = p.mbs + L * 512; m.mg = p.mlp_g + L * 512;
        att::mlp_unit(lds, m);
        PULL();
    }
    TPROBE_END(12);
#undef PULL
}

#define XB_TMO      128
#define XB_XCNT(j)  (256  + 64 * (j))
#define XB_XSUB(j)  (1280 + 64 * (j))
#define XB_XGEN(j)  (2304 + 64 * (j))
#define XB_TOP      3328
#define XB_TOPGEN   3392
#define XCD_BAR_WORDS 3456
#define XB_SPIN_CAP (1u << 22)
__device__ __forceinline__ unsigned xb_ld(unsigned* p)              { return __hip_atomic_load(p, __ATOMIC_RELAXED, __HIP_MEMORY_SCOPE_AGENT); }
__device__ __forceinline__ unsigned xb_add(unsigned* p, unsigned v) { return __hip_atomic_fetch_add(p, v, __ATOMIC_RELAXED, __HIP_MEMORY_SCOPE_AGENT); }
__device__ __forceinline__ unsigned xb_xcc_id() { return (unsigned)__builtin_amdgcn_s_getreg((3 << 11) | 20) & 0xFu; }
#define XB_SPIN(cond, bar) do { unsigned _sp = 0; while (cond) { __builtin_amdgcn_s_sleep(1); \
    if ((++_sp & 255u) == 0u) { if (xb_ld(&(bar)[XB_TMO])) break; if (_sp > XB_SPIN_CAP) { atomicAdd(&(bar)[XB_TMO], 1u); break; } } } } while (0)
struct XcdBarrier { unsigned* bar; unsigned x; volatile LAS unsigned* st; };
__device__ __forceinline__ XcdBarrier xcd_barrier_post(unsigned* bar, volatile LAS unsigned* st) {
    XcdBarrier b; b.bar = bar; b.x = xb_xcc_id(); b.st = st;
    if (threadIdx.x == 0) (void)xb_add(&bar[XB_XCNT(b.x)], 1u);
    return b;
}
__device__ __forceinline__ void xcd_barrier_complete(unsigned* bar, unsigned x, unsigned& nloc, unsigned& nx) {
    const unsigned G = gridDim.x * gridDim.y * gridDim.z;
    unsigned sum, cnt, mine, sp = 0u;
    for (;;) {
        sum = 0u; cnt = 0u; mine = 0u;
#pragma unroll
        for (unsigned j = 0; j < 16; ++j) { const unsigned c = xb_ld(&bar[XB_XCNT(j)]); sum += c; cnt += (c > 0u) ? 1u : 0u; mine = (j == x) ? c : mine; }
        if (sum == G) break;
        __builtin_amdgcn_s_sleep(1);
        if ((++sp & 255u) == 0u) { if (xb_ld(&bar[XB_TMO])) break; if (sp > XB_SPIN_CAP) { atomicAdd(&bar[XB_TMO], 1u); break; } }
    }
    nloc = mine > 0u ? mine : 1u; nx = cnt > 0u ? cnt : 1u;
}
__device__ __forceinline__ void xcd_barrier(const XcdBarrier& b) {
    asm volatile("s_waitcnt vmcnt(0)" ::: "memory");
    __syncthreads();
    if (threadIdx.x == 0) {
        unsigned* bar = b.bar;
        __builtin_amdgcn_s_waitcnt(0);
        unsigned nloc = b.st[0], nx = b.st[1];
        if (nloc == 0u) { xcd_barrier_complete(bar, b.x, nloc, nx); b.st[0] = nloc; b.st[1] = nx; }
        const unsigned old = xb_add(&bar[XB_XSUB(b.x)], 1u);
        const unsigned gen = old / nloc;
        if (old + 1u == (gen + 1u) * nloc) {
            __builtin_amdgcn_fence(__ATOMIC_RELEASE, "agent");
            asm volatile("s_waitcnt vmcnt(0)" ::: "memory");
            const unsigned og = xb_add(&bar[XB_TOP], 1u);
            const unsigned tg = og / nx;
            if (og + 1u == (tg + 1u) * nx) xb_add(&bar[XB_TOPGEN], 1u);
            else XB_SPIN(xb_ld(&bar[XB_TOPGEN]) == tg, bar);
            __builtin_amdgcn_fence(__ATOMIC_ACQUIRE, "agent");
            xb_add(&bar[XB_XGEN(b.x)], 1u);
            asm volatile("s_waitcnt vmcnt(0)" ::: "memory");
        } else {
            XB_SPIN(xb_ld(&bar[XB_XGEN(b.x)]) == gen, bar);
            __builtin_amdgcn_fence(__ATOMIC_ACQUIRE, "agent");
            asm volatile("s_waitcnt vmcnt(0)" ::: "memory");
        }
    }
    __syncthreads();
}

__global__ void __launch_bounds__(512, 2) mega_fwd(Params p) {
    extern __shared__ __attribute__((aligned(16))) unsigned char lds_raw[];
    LAS unsigned char* lds = (LAS unsigned char*)lds_raw;
    const int tid = threadIdx.x, lane = tid & 63, wave = __builtin_amdgcn_readfirstlane(tid >> 6);
    unsigned char* ws = p.ws;
    const int lo = p.ph_lo, hi = p.ph_hi;
    volatile LAS unsigned* MISC = (volatile LAS unsigned*)(lds + MISC_OFF);
    if (tid < 64) MISC[tid] = 0u;
    __syncthreads();
    XcdBarrier bar = xcd_barrier_post((unsigned*)(ws + WS_CTL + CTL_BAR), MISC + 8);
#ifndef PH_MASK
#define PH_MASK 0x3ff
#endif
#define IN(k) (((PH_MASK >> (k)) & 1) && lo <= (k) && (k) < hi)
#define SEAM(k) do { if (IN(k) && IN((k) + 1)) { xcd_barrier(bar); } } while (0)
    TPROBE_BEGIN(20);
    if (IN(0)) phase0a(p, lds, tid, lane, wave);
    SEAM(0);
    TPROBE_END(20);
    TPROBE_BEGIN(21);
    if (IN(1)) { norm_phase<0>(p, lane, wave); phase0b(p, lds, tid, lane, wave); }
    SEAM(1);
    TPROBE_END(21);
    TPROBE_BEGIN(22);
    if (IN(2)) for (int rep = 0; rep < ((DUP_PHASE == 2) ? 2 : 1); ++rep) { if (rep) xcd_barrier(bar); pg8::Gemm g{(const bf16_t*)(ws + WS_H), (const bf16_t*)(ws + WS_WIN), DM}; pg8::Sched S; S.init(68, 30, gridDim.x, blockIdx.x, 0);
        pg8::Epi1 E{(bf16_t*)(ws + WS_P), (const float*)(ws + WS_TAB), (const float*)(ws + WS_TAB) + 1024}; pg8::gemm_phase<pg8::Epi1>(lds, g, S, E); }
    SEAM(2);
    TPROBE_END(22);
    TPROBE_BEGIN(23);
    if (IN(3)) mixer_phase<0>(p, lds, tid, 0, UNIT_MASK);
    if (DUP_PHASE == 3) { xcd_barrier(bar); mixer_phase<0>(p, lds, tid, 3, DUP_UMASK); }
    SEAM(3);
    TPROBE_END(23);
    TPROBE_BEGIN(24);
    if (IN(4)) { pg8::Gemm g{(const bf16_t*)(ws + WS_H), (const bf16_t*)(ws + WS_WOUT), DM}; pg8::Sched S; S.init(68, 8, gridDim.x, blockIdx.x, 0);
        pg8::Epi2 E{(bf16_t*)(ws + WS_Y0), (float*)(ws + WS_CTL + CTL_ROWSS)}; pg8::gemm_phase<pg8::Epi2>(lds, g, S, E); }
    SEAM(4);
    TPROBE_END(24);
    TPROBE_BEGIN(25);
    if (IN(5)) norm_phase<1>(p, lane, wave);
    if (DUP_PHASE == 5) { xcd_barrier(bar); norm_phase<1>(p, lane, wave); }
    SEAM(5);
    TPROBE_END(25);
    TPROBE_BEGIN(26);
    if (IN(6)) { pg8::Gemm g{(const bf16_t*)(ws + WS_H), (const bf16_t*)(ws + WS_WIN) + (size_t)INW * DM, DM}; pg8::Sched S; S.init(64, 30, gridDim.x, blockIdx.x, 48);
        pg8::Epi1 E{(bf16_t*)(ws + WS_P), (const float*)(ws + WS_TAB), (const float*)(ws + WS_TAB) + 1024}; pg8::gemm_phase<pg8::Epi1>(lds, g, S, E); }
    SEAM(6);
    TPROBE_END(26);
    { TPROBE_BEGIN(10); if (IN(7)) mixer_phase<1>(p, lds, tid, 1, UNIT_MASK); TPROBE_END(10);
      TPROBE_BEGIN(11); if (PROBE_T == 11) xcd_barrier(bar); TPROBE_END(11); }
    if (DUP_PHASE == 7) { xcd_barrier(bar); mixer_phase<1>(p, lds, tid, 2, DUP_UMASK); }
    SEAM(7);
    TPROBE_BEGIN(28);
    if (IN(8)) { pg8::Gemm g{(const bf16_t*)(ws + WS_H), (const bf16_t*)(ws + WS_WOUT) + (size_t)DM * DM, DM}; pg8::Sched S; S.init(64, 8, gridDim.x, blockIdx.x, 0);
        pg8::Epi2 E{(bf16_t*)(ws + WS_P), (float*)(ws + WS_CTL + CTL_ROWSS) + MROWS}; pg8::gemm_phase<pg8::Epi2>(lds, g, S, E); }
    if (DUP_PHASE == 8) { xcd_barrier(bar); pg8::Gemm g{(const bf16_t*)(ws + WS_H), (const bf16_t*)(ws + WS_WOUT) + (size_t)DM * DM, DM}; pg8::Sched S; S.init(64, 8, gridDim.x, blockIdx.x, 0);
        pg8::Epi2 E{(bf16_t*)(ws + WS_P), (float*)(ws + WS_CTL + 786432)}; pg8::gemm_phase<pg8::Epi2>(lds, g, S, E); }
    SEAM(8);
    TPROBE_END(28);
    TPROBE_BEGIN(29);
    if (IN(9)) norm_phase<2>(p, lane, wave);
    TPROBE_END(29);
    if (PROBE_T != 0 && blockIdx.x == 0 && tid == PROBE_TID) { const unsigned want = MISC[20]; const unsigned long long t0 = wall_clock64(); while ((unsigned)(wall_clock64() - t0) < want) __builtin_amdgcn_s_sleep(8); }
#undef IN
#undef SEAM
}

extern "C" void kernel_launch(void* const* d_in, const int* in_sizes, int n_in, void* d_out, int out_size, void* d_ws, size_t ws_size, hipStream_t stream) {
    static int grid = 0;
    if (grid == 0) {
        if (n_in != 22 || out_size != NLAT * DM || ws_size < WS_END) { fprintf(stderr, "kernel_launch: unexpected shapes (n_in %d out %d ws %zu)\n", n_in, out_size, ws_size); grid = -1; return; }
        int dev = 0, cus = 0, per_cu = 0;
        if (hipGetDevice(&dev) != hipSuccess || hipDeviceGetAttribute(&cus, hipDeviceAttributeMultiprocessorCount, dev) != hipSuccess) { grid = -1; return; }
        if (hipFuncSetAttribute((const void*)mega_fwd, hipFuncAttributeMaxDynamicSharedMemorySize, LDS_BYTES) != hipSuccess) { fprintf(stderr, "kernel_launch: hipFuncSetAttribute failed\n"); grid = -1; return; }
        if (hipOccupancyMaxActiveBlocksPerMultiprocessor(&per_cu, (const void*)mega_fwd, 512, LDS_BYTES) != hipSuccess || per_cu < 1) { fprintf(stderr, "kernel_launch: occupancy query says %d\n", per_cu); per_cu = 1; }
        (void)hipGetLastError();
        grid = cus * 1;
    }
    if (grid < 0) return;
    (void)hipMemsetAsync((char*)d_ws + WS_CTL, 0, CTL_BYTES, stream);
    Params p{};
    p.x = (const float*)d_in[0]; p.c = (const float*)d_in[1]; p.ctx = (const float*)d_in[2]; p.c_ctx = (const float*)d_in[3]; p.ada_w = (const float*)d_in[4]; p.ada_b = (const float*)d_in[5];
    p.pre_g = (const float*)d_in[6]; p.post_g = (const float*)d_in[7]; p.w_in = (const float*)d_in[8]; p.w_out = (const float*)d_in[9];
    p.lq1 = (const float*)d_in[10]; p.lk1 = (const float*)d_in[11]; p.lq2 = (const float*)d_in[12]; p.lk2 = (const float*)d_in[13];
    p.da_g = (const float*)d_in[14]; p.rpb = (const float*)d_in[15]; p.na_g = (const float*)d_in[16]; p.ln_g = (const float*)d_in[17]; p.ln_b = (const float*)d_in[18];
    p.mws = (const float*)d_in[19]; p.mbs = (const float*)d_in[20]; p.mlp_g = (const float*)d_in[21];
    p.out = (float*)d_out; p.ws = (unsigned char*)d_ws;
#if MK_SINGLE
    p.ph_lo = 0; p.ph_hi = 10;
    { void* args[] = {&p}; hipError_t e = hipLaunchCooperativeKernel((const void*)mega_fwd, dim3(grid), dim3(512), args, LDS_BYTES, stream);
      if (e != hipSuccess) fprintf(stderr, "kernel_launch: cooperative launch failed: %s (grid %d)\n", hipGetErrorString(e), grid); }
#else
    for (int ph = 0; ph < 10; ++ph) { p.ph_lo = ph; p.ph_hi = ph + 1; void* args[] = {&p};
        hipError_t e = hipLaunchCooperativeKernel((const void*)mega_fwd, dim3(grid), dim3(512), args, LDS_BYTES, stream);
        if (e != hipSuccess) { fprintf(stderr, "kernel_launch: launch %d failed: %s (grid %d)\n", ph, hipGetErrorString(e), grid); break; } }
#endif
}
```

```cpp
#include <hip/hip_runtime.h>
#include <hip/hip_cooperative_groups.h>
#include <cstdio>
#include <cstdint>
namespace cg = cooperative_groups;
#ifndef UNIT_MASK
#define UNIT_MASK 31
#endif
#ifndef DUP_PHASE
#define DUP_PHASE -1
#endif
#ifndef DUP_UMASK
#define DUP_UMASK 31
#endif

#ifndef MK_SINGLE
#define MK_SINGLE 1
#endif

#define LAS __attribute__((address_space(3)))
typedef unsigned short bf16_t;
typedef short bf16x8 __attribute__((ext_vector_type(8)));
typedef short s16x4 __attribute__((ext_vector_type(4)));
typedef float f32x2 __attribute__((ext_vector_type(2)));
typedef float f32x4 __attribute__((ext_vector_type(4)));
typedef float f32x8 __attribute__((ext_vector_type(8)));
typedef float f32x16 __attribute__((ext_vector_type(16)));
typedef unsigned u32x2 __attribute__((ext_vector_type(2)));
typedef unsigned u32x4 __attribute__((ext_vector_type(4)));

constexpr int DM = 2048, NB = 4, SEQ = 4096, CTXL = 256, NLAT = NB * SEQ, NCTX = NB * CTXL, MROWS = NLAT + NCTX;
constexpr int INW = 7680, LDP = INW, HD = 128;
constexpr int C_AQ = 0, C_AK = 768, C_AV = 1536, C_AZ = 2304, C_NQ = 3072, C_NK = 3840, C_NV = 4608, C_NZ = 5376, C_MU = 6144, C_MV = 6656, C_MZ = 7168;
constexpr float EPS = 1e-6f;
constexpr float LOG2E = 1.4426950408889634f;

constexpr size_t MiB = 1u << 20;
constexpr size_t WS_CTL = 0, CTL_BYTES = 1 * MiB;
constexpr size_t CTL_QCTR = 256;
constexpr size_t CTL_MOD = 4096;
constexpr size_t CTL_ROWSS = 262144;
constexpr size_t CTL_BAR = 524288;
constexpr size_t WS_TAB = 1 * MiB;
constexpr size_t WS_WSB = 1 * MiB + 65536;
constexpr size_t WS_WIN = 2 * MiB;
constexpr size_t WS_WOUT = 62 * MiB;
constexpr size_t WS_H = 78 * MiB;
constexpr size_t WS_XC1 = 146 * MiB;
constexpr size_t WS_P = 154 * MiB;
constexpr size_t WS_Y0 = 409 * MiB;
constexpr size_t WS_END = 477 * MiB;

constexpr int LDS_BYTES = 147456;
constexpr int MISC_OFF = 139264;


#ifndef PROBE_T
#define PROBE_T 0
#endif
#ifndef PROBE_TID
#define PROBE_TID 0
#endif
#define TPROBE_BEGIN(k) unsigned long long _tp##k = 0; if (PROBE_T == (k) && blockIdx.x == 0 && threadIdx.x == PROBE_TID) { _tp##k = wall_clock64(); }
#define TPROBE_END(k) if (PROBE_T == (k) && blockIdx.x == 0 && threadIdx.x == PROBE_TID) { const unsigned _d = (unsigned)(wall_clock64() - _tp##k); volatile LAS unsigned* _m = (volatile LAS unsigned*)((LAS unsigned char*)0 + MISC_OFF); _m[20] = _m[20] + _d; }

struct Params {
    const float *x, *c, *ctx, *c_ctx, *ada_w, *ada_b, *pre_g, *post_g, *w_in, *w_out, *lq1, *lk1, *lq2, *lk2, *da_g, *rpb, *na_g, *ln_g, *ln_b, *mws, *mbs, *mlp_g;
    float* out; unsigned char* ws; int ph_lo, ph_hi;
};

__device__ __forceinline__ unsigned cvt_pk_bf16(float lo, float hi) { unsigned r; asm volatile("v_cvt_pk_bf16_f32 %0, %1, %2" : "=v"(r) : "v"(lo), "v"(hi)); return r; }
__device__ __forceinline__ float bf_lo(unsigned w) { return __uint_as_float(w << 16); }
__device__ __forceinline__ float bf_hi(unsigned w) { return __uint_as_float(w & 0xffff0000u); }
__device__ __forceinline__ float wave_sum(float v) {
#pragma unroll
    for (int o = 1; o < 64; o <<= 1) v += __shfl_xor(v, o);
    return v;
}
__device__ __forceinline__ float silu_f(float z) { return z * __builtin_amdgcn_rcpf(1.0f + __builtin_amdgcn_exp2f(-z * LOG2E)); }
__device__ __forceinline__ float gelu_tanh(float x) {
    const float u = 0.7978845608028654f * (x + 0.044715f * x * x * x);
    return x * __builtin_amdgcn_rcpf(1.0f + __builtin_amdgcn_exp2f(-2.0f * LOG2E * u));
}

namespace pg8 {
constexpr int BM = 256, BK = 64, HALF = 128, HTB = HALF * BK * 2, STAGE_BYTES = 8 * HTB, NXCD = 8, WGM = 4;
__host__ __device__ __forceinline__ int lds_byte(int r, int c) { const int st = (r >> 4) * 2 + (c >> 5), rr = r & 15, cc = c & 31, ob = rr * 64 + cc * 2; return st * 1024 + (ob ^ (((ob >> 9) & 1) << 5)); }
__host__ __device__ __forceinline__ void stage_rc(int b, int& R, int& C) { const int st = b / 1024, sb = b % 1024, swz = sb ^ (((sb >> 9) & 1) << 5); R = (st >> 1) * 16 + swz / 64; C = (st & 1) * 32 + (swz % 64) / 2; }
__host__ __device__ __forceinline__ int perm32(int rho) { const int n = rho >> 4, i = rho & 15; return 8 * (i >> 2) + 4 * n + (i & 3); }

struct Unit { int pm, pn; };
struct Gemm { const bf16_t* A; const bf16_t* Bt; int K; };

struct Sched {
    int nM, nN, nwg, G, c, extra;
    __device__ void init(int nM_, int nN_, int G_, int c_, int extra_) { nM = nM_; nN = nN_; nwg = nM * nN; G = G_; c = c_; extra = extra_; }
    __device__ bool next(int i, Unit& u) const {
        const long L = (long)i * G + c;
        if (L < nwg) {
            int wgid = (int)L; { const int q = nwg / NXCD, r = nwg % NXCD, xcd = wgid % NXCD, off = wgid / NXCD; wgid = (xcd < r ? xcd * (q + 1) : r * (q + 1) + (xcd - r) * q) + off; }
            const int nig = WGM * nN, gid = wgid / nig, fm = gid * WGM, gsz = (nM - fm) < WGM ? (nM - fm) : WGM;
            u.pm = fm + ((wgid % nig) % gsz); u.pn = (wgid % nig) / gsz; return true;
        }
        const int e = (int)(L - nwg); if (e >= extra) return false;
        const int t = e >> 2; u.pm = 64 + (e & 3); u.pn = t < 6 ? 3 + t : 9 + t; return true;
    }
};

template <class Epi>
__device__ __forceinline__ void gemm_phase(LAS unsigned char* lds, const Gemm g, const Sched& S, const Epi& E) {
    const int tid = threadIdx.x, wid = __builtin_amdgcn_readfirstlane(tid >> 6), lane = tid & 63, wr = wid >> 2, wc = wid & 3, fr = lane & 15, fq = lane >> 4;
    const int K = g.K, nt = K / BK;
    unsigned voffA[2], voffB[2];
#pragma unroll
    for (int i = 0; i < 2; ++i) { int R, C; stage_rc(tid * 16 + i * 8192, R, C); const int Rb = Epi::PERM ? ((R & ~31) + perm32(R & 31)) : R;
        voffA[i] = (unsigned)(R * K + C) * 2u; voffB[i] = (unsigned)(Rb * K + C) * 2u; }
    const size_t kstep = (size_t)(BK * 2);
    const size_t hstep = (size_t)HALF * K * 2;
    const size_t tstep = 2 * hstep;
    const unsigned ldsw = (unsigned)wid * 1024u;
    const int aoff = lds_byte(wr * 64 + fr, fq * 8), boff = lds_byte(wc * 32 + fr, fq * 8);
#define PG8_SA(b, h) (((b) * 2 + (h)) * HTB)
#define PG8_SB(b, h) ((4 + (b) * 2 + (h)) * HTB)
#define PG8_STAGE(bufoff, gbase, voff) do { _Pragma("unroll") for (int _i = 0; _i < 2; ++_i) \
        __builtin_amdgcn_global_load_lds((const unsigned*)((const char*)(gbase) + (voff)[_i]), (LAS unsigned*)(lds + (bufoff) + ldsw + _i * 8192), 16, 0, 0); } while (0)
#define PG8_LDA(dst, b, h) do { _Pragma("unroll") for (int m = 0; m < 4; ++m) _Pragma("unroll") for (int k = 0; k < 2; ++k) dst[m][k] = *(const LAS bf16x8*)(lds + PG8_SA(b, h) + aoff + m * 2048 + k * 1024); } while (0)
#define PG8_LDB(dst, b, h) do { _Pragma("unroll") for (int n = 0; n < 2; ++n) _Pragma("unroll") for (int k = 0; k < 2; ++k) dst[n][k] = *(const LAS bf16x8*)(lds + PG8_SB(b, h) + boff + n * 2048 + k * 1024); } while (0)
#define PG8_MMA(ai, bj, At, Bt) do { __builtin_amdgcn_s_setprio(1); _Pragma("unroll") for (int m = 0; m < 4; ++m) _Pragma("unroll") for (int n = 0; n < 2; ++n) _Pragma("unroll") for (int k = 0; k < 2; ++k) \
        acc[ai][bj][m][n] = __builtin_amdgcn_mfma_f32_16x16x32_bf16(Bt[n][k], At[m][k], acc[ai][bj][m][n], 0, 0, 0); __builtin_amdgcn_s_setprio(0); } while (0)
#define PG8_WAIT_V(n) asm volatile("s_waitcnt vmcnt(" #n ")" ::: "memory")
#define PG8_WAIT_L(n) asm volatile("s_waitcnt lgkmcnt(" #n ")" ::: "memory")
#define PG8_BAR __builtin_amdgcn_s_barrier()
#define PG8_SCHED __builtin_amdgcn_sched_barrier(0)
    Unit cur, nxt; int ui = 0;
    if (!S.next(0, cur)) return;
    f32x4 acc[2][2][4][2];
#pragma unroll
    for (int a = 0; a < 2; ++a)
#pragma unroll
        for (int b = 0; b < 2; ++b)
#pragma unroll
            for (int m = 0; m < 4; ++m)
#pragma unroll
                for (int n = 0; n < 2; ++n) acc[a][b][m][n] = (f32x4){0.f, 0.f, 0.f, 0.f};
    bf16x8 At[4][2], B0[2][2], B1[2][2];
    const char* cA = (const char*)g.A + (size_t)cur.pm * tstep; const char* cB = (const char*)g.Bt + (size_t)cur.pn * tstep;
    PG8_STAGE(PG8_SB(0, 0), cB, voffB); PG8_STAGE(PG8_SB(0, 1), cB + hstep, voffB); PG8_STAGE(PG8_SA(0, 0), cA, voffA); PG8_STAGE(PG8_SA(0, 1), cA + hstep, voffA);
    if (wr == 1) PG8_BAR;
    PG8_WAIT_V(2); PG8_BAR;
    PG8_STAGE(PG8_SB(1, 0), cB + kstep, voffB); PG8_STAGE(PG8_SA(1, 0), cA + kstep, voffA); PG8_STAGE(PG8_SB(1, 1), cB + hstep + kstep, voffB);
    PG8_WAIT_V(6); PG8_BAR;
    for (;;) {
        const bool has_next = S.next(ui + 1, nxt);
        const char* nA = has_next ? (const char*)g.A + (size_t)nxt.pm * tstep : cA; const char* nB = has_next ? (const char*)g.Bt + (size_t)nxt.pn * tstep : cB;
        for (int t = 0; t < nt; t += 2) {
            const bool last = (t == nt - 2);
            const char* a1 = cA + (size_t)(t + 1) * kstep;
            const char* a2 = last ? nA : cA + (size_t)(t + 2) * kstep; const char* b2 = last ? nB : cB + (size_t)(t + 2) * kstep;
            const char* a3 = a2 + kstep; const char* b3 = b2 + kstep;
            PG8_LDB(B0, 0, 0); PG8_LDB(B1, 0, 1); PG8_SCHED; PG8_LDA(At, 0, 0); PG8_STAGE(PG8_SA(1, 1), a1 + hstep, voffA);
            PG8_WAIT_V(8); PG8_WAIT_L(0); PG8_BAR; PG8_MMA(0, 0, At, B0); PG8_MMA(0, 1, At, B1); PG8_BAR; PG8_SCHED;
            PG8_LDA(At, 0, 1); PG8_STAGE(PG8_SB(0, 0), b2, voffB); PG8_STAGE(PG8_SB(0, 1), b2 + hstep, voffB); PG8_STAGE(PG8_SA(0, 0), a2, voffA);
            PG8_WAIT_V(8); PG8_WAIT_L(0); PG8_BAR; PG8_MMA(1, 0, At, B0); PG8_MMA(1, 1, At, B1); PG8_BAR; PG8_SCHED;
            PG8_LDB(B0, 1, 0); PG8_LDB(B1, 1, 1); PG8_SCHED; PG8_LDA(At, 1, 0); PG8_STAGE(PG8_SA(0, 1), a2 + hstep, voffA);
            PG8_WAIT_V(8); PG8_WAIT_L(0); PG8_BAR; PG8_MMA(0, 0, At, B0); PG8_MMA(0, 1, At, B1); PG8_BAR; PG8_SCHED;
            PG8_LDA(At, 1, 1); PG8_STAGE(PG8_SB(1, 0), b3, voffB); PG8_STAGE(PG8_SB(1, 1), b3 + hstep, voffB); PG8_STAGE(PG8_SA(1, 0), a3, voffA);
            PG8_WAIT_V(8); PG8_WAIT_L(0); PG8_BAR; PG8_MMA(1, 0, At, B0); PG8_MMA(1, 1, At, B1); PG8_BAR; PG8_SCHED;
        }
        if (wr == 0) PG8_BAR;
        E(acc, cur, wr, wc, fr, fq);
        if (!has_next) break;
#pragma unroll
        for (int a = 0; a < 2; ++a)
#pragma unroll
            for (int b = 0; b < 2; ++b)
#pragma unroll
                for (int m = 0; m < 4; ++m)
#pragma unroll
                    for (int n = 0; n < 2; ++n) acc[a][b][m][n] = (f32x4){0.f, 0.f, 0.f, 0.f};
        cur = nxt; cA = nA; cB = nB; ++ui;
        if (wr == 1) PG8_BAR;
    }
    PG8_WAIT_V(0);
    PG8_BAR;
#undef PG8_SA
#undef PG8_SB
#undef PG8_STAGE
#undef PG8_LDA
#undef PG8_LDB
#undef PG8_MMA
#undef PG8_WAIT_V
#undef PG8_WAIT_L
#undef PG8_BAR
#undef PG8_SCHED
}

struct Epi1 {
    static constexpr bool PERM = true;
    bf16_t* O; const float* cs; const float* sn;
    __device__ __forceinline__ void operator()(const f32x4 (&acc)[2][2][4][2], const Unit& u, int wr, int wc, int fr, int fq) const {
        const int row0 = u.pm * BM + wr * 64 + fr, col0 = u.pn * BM + wc * 32 + 8 * fq;
        const bool rope = (u.pn < 6) && (u.pm < 64), gelu = (u.pn >= 24) && (u.pn < 28);
        const float qs = (u.pn < 3) ? 0.125f * LOG2E : 1.0f;
        const float sgn = (fq < 2) ? -1.f : 1.f;
#pragma unroll
        for (int ai = 0; ai < 2; ++ai)
#pragma unroll
            for (int m = 0; m < 4; ++m) {
                const int row = row0 + ai * HALF + m * 16;
                bf16_t* rowp = O + (size_t)row * LDP + col0;
                f32x4 c0 = {1.f, 1.f, 1.f, 1.f}, c1 = c0, s0 = {0.f, 0.f, 0.f, 0.f}, s1 = s0;
                if (rope) { const int s = row & (SEQ - 1); const int pos = (wc & 1) ? (s & 63) : (s >> 6); const int ti = pos * 16 + 8 * (fq & 1);
                    c0 = *(const f32x4*)(cs + ti); c1 = *(const f32x4*)(cs + ti + 4); s0 = *(const f32x4*)(sn + ti); s1 = *(const f32x4*)(sn + ti + 4);
                    s0 = s0 * sgn; s1 = s1 * sgn; }
#pragma unroll
                for (int bj = 0; bj < 2; ++bj) { f32x4 v0 = acc[ai][bj][m][0], v1 = acc[ai][bj][m][1];
                    if (rope) { f32x4 q0, q1;
#pragma unroll
                        for (int e = 0; e < 4; ++e) { q0[e] = __shfl_xor(v0[e], 32); q1[e] = __shfl_xor(v1[e], 32); }
                        v0 = v0 * c0 + q0 * s0; v1 = v1 * c1 + q1 * s1; }
                    if (gelu) {
#pragma unroll
                        for (int e = 0; e < 4; ++e) { v0[e] = gelu_tanh(v0[e]); v1[e] = gelu_tanh(v1[e]); } }
                    v0 = v0 * qs; v1 = v1 * qs;
                    u32x4 w; w.x = cvt_pk_bf16(v0[0], v0[1]); w.y = cvt_pk_bf16(v0[2], v0[3]); w.z = cvt_pk_bf16(v1[0], v1[1]); w.w = cvt_pk_bf16(v1[2], v1[3]);
                    *(u32x4*)(rowp + bj * HALF) = w; } }
    }
};
struct Epi2 {
    static constexpr bool PERM = true;
    bf16_t* Yb; float* rowss;
    __device__ __forceinline__ void operator()(const f32x4 (&acc)[2][2][4][2], const Unit& u, int wr, int wc, int fr, int fq) const {
        const int row0 = u.pm * BM + wr * 64 + fr, col0 = u.pn * BM + wc * 32 + 8 * fq;
#pragma unroll
        for (int ai = 0; ai < 2; ++ai)
#pragma unroll
            for (int m = 0; m < 4; ++m) { const int row = row0 + ai * HALF + m * 16; bf16_t* rowp = Yb + (size_t)row * DM + col0; float ss = 0.f;
#pragma unroll
                for (int bj = 0; bj < 2; ++bj) { const f32x4 v0 = acc[ai][bj][m][0], v1 = acc[ai][bj][m][1];
                    ss += (v0[0] * v0[0] + v0[1] * v0[1]) + (v0[2] * v0[2] + v0[3] * v0[3]) + (v1[0] * v1[0] + v1[1] * v1[1]) + (v1[2] * v1[2] + v1[3] * v1[3]);
                    u32x4 w; w.x = cvt_pk_bf16(v0[0], v0[1]); w.y = cvt_pk_bf16(v0[2], v0[3]); w.z = cvt_pk_bf16(v1[0], v1[1]); w.w = cvt_pk_bf16(v1[2], v1[3]);
                    *(u32x4*)(rowp + bj * HALF) = w; }
                ss += __shfl_xor(ss, 16); ss += __shfl_xor(ss, 32);
                if (fq == 0) atomicAdd(rowss + row, ss); }
    }
};
}

namespace att {
constexpr int SHM_V = 64 * 128 * 2, SHM_K = 64 * 128 * 2;
constexpr int WSF_OFF = 2 * SHM_V + 2 * SHM_K;
constexpr int BIAS_OFF = WSF_OFF + 2048;
constexpr int XS = 132;
constexpr float THR = 8.f;
#define KSWZ(row, colB) ((row) * 256 + ((colB) ^ (((row) & 15) << 4)))
#define SBAR() __builtin_amdgcn_sched_barrier(0)
__device__ __forceinline__ int crow(int r, int hi) { return (r & 3) + 8 * (r >> 2) + 4 * hi; }
__device__ __forceinline__ bf16x8 ld8(const bf16_t* p) { return *reinterpret_cast<const bf16x8*>(p); }

template <int MODE> struct ModeC { static constexpr float SC = (MODE == 0) ? 0.125f : 0.08838834764831845f; };

template <int MODE>
__device__ __forceinline__ void partialSM(f32x16& p0, f32x16& p1, float& m_reg, float& mn, float& alpha) {
    constexpr float C = ModeC<MODE>::SC * LOG2E;
    float pmax = p0[0];
#pragma unroll
    for (int r = 1; r < 16; ++r) pmax = fmaxf(pmax, p0[r]);
#pragma unroll
    for (int r = 0; r < 16; ++r) pmax = fmaxf(pmax, p1[r]);
    { auto rr = __builtin_amdgcn_permlane32_swap(__float_as_uint(pmax), __float_as_uint(pmax), false, false);
      pmax = fmaxf(__uint_as_float(rr[0]), __uint_as_float(rr[1])); }
    if (__builtin_expect(__all(pmax - m_reg <= THR / ModeC<MODE>::SC), 1)) { mn = m_reg; alpha = 1.f; }
    else { mn = fmaxf(m_reg, pmax); alpha = __builtin_amdgcn_exp2f((m_reg - mn) * C); m_reg = mn; }
    const float mnC = -mn * C;
#pragma unroll
    for (int r = 0; r < 16; ++r) p0[r] = fmaf(p0[r], C, mnC);
#pragma unroll
    for (int r = 0; r < 16; ++r) p1[r] = fmaf(p1[r], C, mnC);
#pragma unroll
    for (int r = 0; r < 16; ++r) p0[r] = __builtin_amdgcn_exp2f(p0[r]);
}
__device__ __forceinline__ void finishSM(f32x16& p0, f32x16& p1, float alpha, float& l_reg, bf16x8& pa0, bf16x8& pa1, bf16x8& pa2, bf16x8& pa3) {
#pragma unroll
    for (int r = 0; r < 16; ++r) p1[r] = __builtin_amdgcn_exp2f(p1[r]);
    float ps = 0;
#pragma unroll
    for (int r = 0; r < 16; ++r) ps += p0[r];
#pragma unroll
    for (int r = 0; r < 16; ++r) ps += p1[r];
    { auto rr = __builtin_amdgcn_permlane32_swap(__float_as_uint(ps), __float_as_uint(ps), false, false);
      ps = __uint_as_float(rr[0]) + __uint_as_float(rr[1]); }
    l_reg = l_reg * alpha + ps;
#define PK4(P, BASE, OUT) do { unsigned a0 = cvt_pk_bf16(P[BASE + 0], P[BASE + 1]), a1 = cvt_pk_bf16(P[BASE + 2], P[BASE + 3]);   \
    unsigned b0 = cvt_pk_bf16(P[BASE + 4], P[BASE + 5]), b1 = cvt_pk_bf16(P[BASE + 6], P[BASE + 7]);                              \
    auto r0 = __builtin_amdgcn_permlane32_swap(a0, b0, false, false); auto r1 = __builtin_amdgcn_permlane32_swap(a1, b1, false, false); \
    u32x4 w = {r0[0], r1[0], r0[1], r1[1]}; OUT = *reinterpret_cast<bf16x8*>(&w); } while (0)
    PK4(p0, 0, pa0); PK4(p0, 8, pa1); PK4(p1, 0, pa2); PK4(p1, 8, pa3);
#undef PK4
}
template <int MODE>
__device__ __forceinline__ void sm_max(const f32x16& p0, const f32x16& p1, float& m_reg, float& mnC, float& alpha) {
    constexpr float C = ModeC<MODE>::SC * LOG2E;
    float pmax = p0[0];
#pragma unroll
    for (int r = 1; r < 16; ++r) pmax = fmaxf(pmax, p0[r]);
#pragma unroll
    for (int r = 0; r < 16; ++r) pmax = fmaxf(pmax, p1[r]);
    { auto rr = __builtin_amdgcn_permlane32_swap(__float_as_uint(pmax), __float_as_uint(pmax), false, false);
      pmax = fmaxf(__uint_as_float(rr[0]), __uint_as_float(rr[1])); }
    const bool keep = __all(pmax - m_reg <= THR / ModeC<MODE>::SC);
    const float mn = keep ? m_reg : fmaxf(m_reg, pmax);
    alpha = __builtin_amdgcn_exp2f((m_reg - mn) * C);
    m_reg = mn; mnC = -mn * C;
}
template <int MODE>
__device__ __forceinline__ void sm_scale(f32x16& p, float mnC) {
    constexpr float C = ModeC<MODE>::SC * LOG2E;
#pragma unroll
    for (int r = 0; r < 16; ++r) p[r] = fmaf(p[r], C, mnC);
}
__device__ __forceinline__ void sm_exp(f32x16& p) {
#pragma unroll
    for (int r = 0; r < 16; ++r) p[r] = __builtin_amdgcn_exp2f(p[r]);
}
__device__ __forceinline__ void sm_finish(f32x16& p0, f32x16& p1, float alpha, float& l_reg, bf16x8& pa0, bf16x8& pa1, bf16x8& pa2, bf16x8& pa3) {
    float ps = 0;
#pragma unroll
    for (int r = 0; r < 16; ++r) ps += p0[r];
#pragma unroll
    for (int r = 0; r < 16; ++r) ps += p1[r];
    { auto rr = __builtin_amdgcn_permlane32_swap(__float_as_uint(ps), __float_as_uint(ps), false, false);
      ps = __uint_as_float(rr[0]) + __uint_as_float(rr[1]); }
    l_reg = l_reg * alpha + ps;
#define PK4(P, BASE, OUT) do { unsigned a0 = cvt_pk_bf16(P[BASE + 0], P[BASE + 1]), a1 = cvt_pk_bf16(P[BASE + 2], P[BASE + 3]);   \
    unsigned b0 = cvt_pk_bf16(P[BASE + 4], P[BASE + 5]), b1 = cvt_pk_bf16(P[BASE + 6], P[BASE + 7]);                              \
    auto r0 = __builtin_amdgcn_permlane32_swap(a0, b0, false, false); auto r1 = __builtin_amdgcn_permlane32_swap(a1, b1, false, false); \
    u32x4 w = {r0[0], r1[0], r0[1], r1[1]}; OUT = *reinterpret_cast<bf16x8*>(&w); } while (0)
    PK4(p0, 0, pa0); PK4(p0, 8, pa1); PK4(p1, 0, pa2); PK4(p1, 8, pa3);
#undef PK4
}
template <int ND0>
__device__ __forceinline__ void qkt(f32x16& p0, f32x16& p1, const LAS char* Ks, const bf16x8* qr, int r32, int hi, int dbase) {
    p0 = f32x16{}; p1 = f32x16{};
#pragma unroll
    for (int d0 = 0; d0 < ND0; ++d0) { const int cb = ((dbase + d0) * 16 + hi * 8) * 2;
        const bf16x8 b0 = *reinterpret_cast<const LAS bf16x8*>(Ks + KSWZ(r32, cb));
        const bf16x8 b1 = *reinterpret_cast<const LAS bf16x8*>(Ks + KSWZ(32 + r32, cb));
        p0 = __builtin_amdgcn_mfma_f32_32x32x16_bf16(b0, qr[d0], p0, 0, 0, 0);
        p1 = __builtin_amdgcn_mfma_f32_32x32x16_bf16(b1, qr[d0], p1, 0, 0, 0); }
}
__device__ __forceinline__ int v_st(int k, int c) { const int kk = (k & ~0xC) | ((k & 4) << 1) | ((k & 8) >> 1); return ((kk >> 3) * 4 + (c >> 5)) * 512 + ((kk & 7) * 32 + (c & 31)) * 2; }
__device__ __forceinline__ int v_rd_base(int lane) { return ((lane & 3) << 3) | (((lane >> 2) & 3) << 6) | (((lane >> 4) & 1) << 5) | (((lane >> 5) & 1) << 8); }
constexpr int v_rd_off(int d0, int ks, int half) { return d0 * 512 + ks * 4096 + half * 2048; }
template <int OFF> __device__ __forceinline__ s16x4 tr_read(int vb) {
    s16x4 r; asm volatile("ds_read_b64_tr_b16 %0, %1 offset:%2" : "=&v"(r) : "v"(vb), "i"(OFF) : "memory"); return r;
}
template <int D0> __device__ __forceinline__ void pv_one(f32x16& od, int vb, bf16x8 pa0, bf16x8 pa1, bf16x8 pa2, bf16x8 pa3) {
    const s16x4 l0 = tr_read<v_rd_off(D0, 0, 0)>(vb), h0 = tr_read<v_rd_off(D0, 0, 1)>(vb), l1 = tr_read<v_rd_off(D0, 1, 0)>(vb), h1 = tr_read<v_rd_off(D0, 1, 1)>(vb);
    const s16x4 l2 = tr_read<v_rd_off(D0, 2, 0)>(vb), h2 = tr_read<v_rd_off(D0, 2, 1)>(vb), l3 = tr_read<v_rd_off(D0, 3, 0)>(vb), h3 = tr_read<v_rd_off(D0, 3, 1)>(vb);
    asm volatile("s_waitcnt lgkmcnt(0)" ::: "memory"); SBAR();
#define PKV(L, H) (bf16x8){L[0], L[1], L[2], L[3], H[0], H[1], H[2], H[3]}
    od = __builtin_amdgcn_mfma_f32_32x32x16_bf16(pa0, PKV(l0, h0), od, 0, 0, 0);
    od = __builtin_amdgcn_mfma_f32_32x32x16_bf16(pa1, PKV(l1, h1), od, 0, 0, 0);
    od = __builtin_amdgcn_mfma_f32_32x32x16_bf16(pa2, PKV(l2, h2), od, 0, 0, 0);
    od = __builtin_amdgcn_mfma_f32_32x32x16_bf16(pa3, PKV(l3, h3), od, 0, 0, 0);
#undef PKV
}
__device__ __forceinline__ void pv_d0(f32x16* o, int vb, bf16x8 pa0, bf16x8 pa1, bf16x8 pa2, bf16x8 pa3) {
    pv_one<0>(o[0], vb, pa0, pa1, pa2, pa3); pv_one<1>(o[1], vb, pa0, pa1, pa2, pa3); pv_one<2>(o[2], vb, pa0, pa1, pa2, pa3); pv_one<3>(o[3], vb, pa0, pa1, pa2, pa3);
}

template <int KS> __device__ __forceinline__ void pv_ks(f32x16* o, int vb, bf16x8 pa) {
    const s16x4 l0 = tr_read<v_rd_off(0, KS, 0)>(vb), h0 = tr_read<v_rd_off(0, KS, 1)>(vb), l1 = tr_read<v_rd_off(1, KS, 0)>(vb), h1 = tr_read<v_rd_off(1, KS, 1)>(vb);
    const s16x4 l2 = tr_read<v_rd_off(2, KS, 0)>(vb), h2 = tr_read<v_rd_off(2, KS, 1)>(vb), l3 = tr_read<v_rd_off(3, KS, 0)>(vb), h3 = tr_read<v_rd_off(3, KS, 1)>(vb);
#if defined(PROBE_DUPTR)
    { s16x4 d0_ = tr_read<v_rd_off(0, KS, 0)>(vb), d1_ = tr_read<v_rd_off(0, KS, 1)>(vb), d2_ = tr_read<v_rd_off(1, KS, 0)>(vb), d3_ = tr_read<v_rd_off(1, KS, 1)>(vb);
      s16x4 d4_ = tr_read<v_rd_off(2, KS, 0)>(vb), d5_ = tr_read<v_rd_off(2, KS, 1)>(vb), d6_ = tr_read<v_rd_off(3, KS, 0)>(vb), d7_ = tr_read<v_rd_off(3, KS, 1)>(vb);
      asm volatile("" :: "v"(d0_), "v"(d1_), "v"(d2_), "v"(d3_), "v"(d4_), "v"(d5_), "v"(d6_), "v"(d7_)); }
#endif
    asm volatile("s_waitcnt lgkmcnt(0)" ::: "memory"); SBAR();
#define PKV(L, H) (bf16x8){L[0], L[1], L[2], L[3], H[0], H[1], H[2], H[3]}
    o[0] = __builtin_amdgcn_mfma_f32_32x32x16_bf16(pa, PKV(l0, h0), o[0], 0, 0, 0);
    o[1] = __builtin_amdgcn_mfma_f32_32x32x16_bf16(pa, PKV(l1, h1), o[1], 0, 0, 0);
    o[2] = __builtin_amdgcn_mfma_f32_32x32x16_bf16(pa, PKV(l2, h2), o[2], 0, 0, 0);
    o[3] = __builtin_amdgcn_mfma_f32_32x32x16_bf16(pa, PKV(l3, h3), o[3], 0, 0, 0);
#undef PKV
}
__device__ __forceinline__ void pv_k4(f32x16* o, int vb, bf16x8 pa0, bf16x8 pa1, bf16x8 pa2, bf16x8 pa3) {
    pv_ks<0>(o, vb, pa0); pv_ks<1>(o, vb, pa1); pv_ks<2>(o, vb, pa2); pv_ks<3>(o, vb, pa3);
}

template <bool MLP>
__device__ __forceinline__ void final_pass(const LAS float* X, int nrows, const bf16_t* Z, bf16_t* Y, const float* g, float factor, const bf16_t* U, const float* rowb) {
    int t_ = threadIdx.x; asm volatile("" : "+v"(t_));
    for (int idx = t_; idx < nrows * 4; idx += 512) {
        const int row = idx >> 2, seg = idx & 3;
        f32x4 x[8];
#pragma unroll
        for (int i = 0; i < 8; ++i) x[i] = *reinterpret_cast<const LAS f32x4*>(X + row * XS + seg * 32 + 4 * i);
        if (MLP) { const float rb = rowb[row]; const u32x4* up = reinterpret_cast<const u32x4*>(U + (size_t)row * LDP + seg * 32);
#pragma unroll
            for (int i = 0; i < 4; ++i) { const u32x4 w = up[i];
                x[2 * i][0] = (x[2 * i][0] + rb) * bf_lo(w.x); x[2 * i][1] = (x[2 * i][1] + rb) * bf_hi(w.x); x[2 * i][2] = (x[2 * i][2] + rb) * bf_lo(w.y); x[2 * i][3] = (x[2 * i][3] + rb) * bf_hi(w.y);
                x[2 * i + 1][0] = (x[2 * i + 1][0] + rb) * bf_lo(w.z); x[2 * i + 1][1] = (x[2 * i + 1][1] + rb) * bf_hi(w.z); x[2 * i + 1][2] = (x[2 * i + 1][2] + rb) * bf_lo(w.w); x[2 * i + 1][3] = (x[2 * i + 1][3] + rb) * bf_hi(w.w); } }
        float ss = 0.f;
#pragma unroll
        for (int i = 0; i < 8; ++i) ss += (x[i][0] * x[i][0] + x[i][1] * x[i][1]) + (x[i][2] * x[i][2] + x[i][3] * x[i][3]);
        ss += __shfl_xor(ss, 1); ss += __shfl_xor(ss, 2);
        const float rstd = __builtin_amdgcn_rsqf(ss * (1.0f / 128.0f) + EPS) * factor;
        const u32x4* zp = reinterpret_cast<const u32x4*>(Z + (size_t)row * LDP + seg * 32);
        const f32x4* gp = reinterpret_cast<const f32x4*>(g + seg * 32);
        u32x4* yp = reinterpret_cast<u32x4*>(Y + (size_t)row * DM + seg * 32);
#pragma unroll
        for (int i = 0; i < 4; ++i) { const u32x4 w = zp[i]; const f32x4 g0 = gp[2 * i], g1 = gp[2 * i + 1]; const f32x4 a = x[2 * i], b = x[2 * i + 1];
            u32x4 o;
            o.x = cvt_pk_bf16(a[0] * rstd * g0[0] * silu_f(bf_lo(w.x)), a[1] * rstd * g0[1] * silu_f(bf_hi(w.x)));
            o.y = cvt_pk_bf16(a[2] * rstd * g0[2] * silu_f(bf_lo(w.y)), a[3] * rstd * g0[3] * silu_f(bf_hi(w.y)));
            o.z = cvt_pk_bf16(b[0] * rstd * g1[0] * silu_f(bf_lo(w.z)), b[1] * rstd * g1[1] * silu_f(bf_hi(w.z)));
            o.w = cvt_pk_bf16(b[2] * rstd * g1[2] * silu_f(bf_lo(w.w)), b[3] * rstd * g1[3] * silu_f(bf_hi(w.w)));
            yp[i] = o; }
    }
}

struct AttnArgs {
    const bf16_t* Q;
    const bf16_t *K1, *K2, *V1, *V2;
    int n1, n2, NT;
    int R0, kfirst;
    const float* rpb;
    const bf16_t* Z; bf16_t* Y; const float* g; float factor, lam;
};
template <int MODE>
__device__ __forceinline__ void attn_epilogue(LAS char* lds, const AttnArgs& a, f32x16 (&o)[4], float l_reg, LAS float* li_l, int map, int qg, int r32, int hi) {
    if (hi == 0) li_l[r32] = l_reg; asm volatile("s_waitcnt lgkmcnt(0)" ::: "memory");
    float rli[16];
#pragma unroll
    for (int r = 0; r < 16; ++r) rli[r] = __builtin_amdgcn_rcpf(li_l[crow(r, hi)]);
    __syncthreads();
    LAS float* X = (LAS float*)lds;
    if (MODE != 0 || map == 0) {
#pragma unroll
        for (int r = 0; r < 16; ++r)
#pragma unroll
            for (int d0 = 0; d0 < 4; ++d0) X[(qg * 32 + crow(r, hi)) * XS + d0 * 32 + r32] = o[d0][r] * rli[r];
    }
    __syncthreads();
    if (MODE == 0) {
        if (map == 1) {
#pragma unroll
            for (int r = 0; r < 16; ++r)
#pragma unroll
                for (int d0 = 0; d0 < 4; ++d0) { LAS float* xp = X + (qg * 32 + crow(r, hi)) * XS + d0 * 32 + r32; *xp = *xp - a.lam * (o[d0][r] * rli[r]); }
        }
        __syncthreads();
    }
    final_pass<false>(X, (MODE == 0) ? 128 : 256, a.Z, a.Y, a.g, a.factor, nullptr, nullptr);
    __syncthreads();
}
constexpr int V3_OFF = 0, K3_OFF = 3 * SHM_V, WSF3_OFF = 3 * SHM_V + 3 * SHM_K;
constexpr float THRL = 10.f;
__device__ __forceinline__ void qkt_c(f32x16& p0, f32x16& p1, const LAS char* Ks, const bf16x8* qr, const f32x16& negm, int r32, int hi, int dbase) {
#pragma unroll
    for (int d0 = 0; d0 < 4; ++d0) { const int cb = ((dbase + d0) * 16 + hi * 8) * 2;
        const bf16x8 b0 = *reinterpret_cast<const LAS bf16x8*>(Ks + KSWZ(r32, cb));
        const bf16x8 b1 = *reinterpret_cast<const LAS bf16x8*>(Ks + KSWZ(32 + r32, cb));
        if (d0 == 0) { p0 = __builtin_amdgcn_mfma_f32_32x32x16_bf16(b0, qr[0], negm, 0, 0, 0); p1 = __builtin_amdgcn_mfma_f32_32x32x16_bf16(b1, qr[0], negm, 0, 0, 0); }
        else { p0 = __builtin_amdgcn_mfma_f32_32x32x16_bf16(b0, qr[d0], p0, 0, 0, 0); p1 = __builtin_amdgcn_mfma_f32_32x32x16_bf16(b1, qr[d0], p1, 0, 0, 0); } }
}
__device__ __forceinline__ bf16x8 lds_rd128(int addr) { bf16x8 r; asm volatile("ds_read_b128 %0, %1" : "=&v"(r) : "v"(addr) : "memory"); return r; }
__device__ __forceinline__ bf16x8 lds_rd128_hi(int addr) { bf16x8 r; asm volatile("ds_read_b128 %0, %1 offset:8192" : "=&v"(r) : "v"(addr) : "memory"); return r; }
__device__ __forceinline__ void qkt_cb(f32x16& p0, f32x16& p1, const int (&ka)[4], const bf16x8* qr, const f32x16& negm) {
    const bf16x8 a0 = lds_rd128(ka[0]), b0 = lds_rd128_hi(ka[0]), a1 = lds_rd128(ka[1]), b1 = lds_rd128_hi(ka[1]);
    const bf16x8 a2 = lds_rd128(ka[2]), b2 = lds_rd128_hi(ka[2]), a3 = lds_rd128(ka[3]), b3 = lds_rd128_hi(ka[3]);
    asm volatile("s_waitcnt lgkmcnt(6)" ::: "memory"); SBAR();
    p0 = __builtin_amdgcn_mfma_f32_32x32x16_bf16(a0, qr[0], negm, 0, 0, 0); p1 = __builtin_amdgcn_mfma_f32_32x32x16_bf16(b0, qr[0], negm, 0, 0, 0);
    asm volatile("s_waitcnt lgkmcnt(4)" ::: "memory"); SBAR();
    p0 = __builtin_amdgcn_mfma_f32_32x32x16_bf16(a1, qr[1], p0, 0, 0, 0); p1 = __builtin_amdgcn_mfma_f32_32x32x16_bf16(b1, qr[1], p1, 0, 0, 0);
    asm volatile("s_waitcnt lgkmcnt(2)" ::: "memory"); SBAR();
    p0 = __builtin_amdgcn_mfma_f32_32x32x16_bf16(a2, qr[2], p0, 0, 0, 0); p1 = __builtin_amdgcn_mfma_f32_32x32x16_bf16(b2, qr[2], p1, 0, 0, 0);
    asm volatile("s_waitcnt lgkmcnt(0)" ::: "memory"); SBAR();
    p0 = __builtin_amdgcn_mfma_f32_32x32x16_bf16(a3, qr[3], p0, 0, 0, 0); p1 = __builtin_amdgcn_mfma_f32_32x32x16_bf16(b3, qr[3], p1, 0, 0, 0);
}
struct VSet { s16x4 l0, h0, l1, h1, l2, h2, l3, h3; };
template <int KS> __device__ __forceinline__ void tr_group(VSet& s, int vb) {
    s.l0 = tr_read<v_rd_off(0, KS, 0)>(vb); s.h0 = tr_read<v_rd_off(0, KS, 1)>(vb); s.l1 = tr_read<v_rd_off(1, KS, 0)>(vb); s.h1 = tr_read<v_rd_off(1, KS, 1)>(vb);
    s.l2 = tr_read<v_rd_off(2, KS, 0)>(vb); s.h2 = tr_read<v_rd_off(2, KS, 1)>(vb); s.l3 = tr_read<v_rd_off(3, KS, 0)>(vb); s.h3 = tr_read<v_rd_off(3, KS, 1)>(vb);
}
__device__ __forceinline__ void mm_group(f32x16* o, bf16x8 pa, const VSet& s) {
#define PKV(L, H) (bf16x8){L[0], L[1], L[2], L[3], H[0], H[1], H[2], H[3]}
    o[0] = __builtin_amdgcn_mfma_f32_32x32x16_bf16(pa, PKV(s.l0, s.h0), o[0], 0, 0, 0);
    o[1] = __builtin_amdgcn_mfma_f32_32x32x16_bf16(pa, PKV(s.l1, s.h1), o[1], 0, 0, 0);
    o[2] = __builtin_amdgcn_mfma_f32_32x32x16_bf16(pa, PKV(s.l2, s.h2), o[2], 0, 0, 0);
    o[3] = __builtin_amdgcn_mfma_f32_32x32x16_bf16(pa, PKV(s.l3, s.h3), o[3], 0, 0, 0);
#undef PKV
}
#define LWAIT(n) do { asm volatile("s_waitcnt lgkmcnt(" #n ")" ::: "memory"); SBAR(); } while (0)
__device__ __forceinline__ void segm_body(f32x16& p0, f32x16& p1, f32x16* o, const int (&ka)[4], int vb, const bf16x8* qr, const f32x16& negm, bf16x8 pa0, bf16x8 pa1, bf16x8 pa2, bf16x8 pa3) {
    const bf16x8 a0 = lds_rd128(ka[0]), b0 = lds_rd128_hi(ka[0]), a1 = lds_rd128(ka[1]), b1 = lds_rd128_hi(ka[1]);
    const bf16x8 a2 = lds_rd128(ka[2]), b2 = lds_rd128_hi(ka[2]), a3 = lds_rd128(ka[3]), b3 = lds_rd128_hi(ka[3]);
    VSet sa, sb;
    tr_group<0>(sa, vb);
    LWAIT(14);
    p0 = __builtin_amdgcn_mfma_f32_32x32x16_bf16(a0, qr[0], negm, 0, 0, 0); p1 = __builtin_amdgcn_mfma_f32_32x32x16_bf16(b0, qr[0], negm, 0, 0, 0);
    LWAIT(12);
    p0 = __builtin_amdgcn_mfma_f32_32x32x16_bf16(a1, qr[1], p0, 0, 0, 0); p1 = __builtin_amdgcn_mfma_f32_32x32x16_bf16(b1, qr[1], p1, 0, 0, 0);
    LWAIT(10);
    p0 = __builtin_amdgcn_mfma_f32_32x32x16_bf16(a2, qr[2], p0, 0, 0, 0); p1 = __builtin_amdgcn_mfma_f32_32x32x16_bf16(b2, qr[2], p1, 0, 0, 0);
    LWAIT(8);
    p0 = __builtin_amdgcn_mfma_f32_32x32x16_bf16(a3, qr[3], p0, 0, 0, 0); p1 = __builtin_amdgcn_mfma_f32_32x32x16_bf16(b3, qr[3], p1, 0, 0, 0);
    tr_group<1>(sb, vb);
    LWAIT(8);
    mm_group(o, pa0, sa);
    tr_group<2>(sa, vb);
    LWAIT(8);
    mm_group(o, pa1, sb);
    tr_group<3>(sb, vb);
    LWAIT(8);
    mm_group(o, pa2, sa);
    LWAIT(0);
    mm_group(o, pa3, sb);
}
__device__ __forceinline__ void diff_unit(LAS char* lds, const AttnArgs& a) {
    int tid_ = threadIdx.x; asm volatile("" : "+v"(tid_));
    const int tid = tid_, wid = __builtin_amdgcn_readfirstlane(tid >> 6), lane = tid & 63, r32 = lane & 31, hi = lane >> 5;
    const int half = wid >> 2, map = wid >> 2, qg = wid & 3;
    LAS char* V_lds = lds + V3_OFF; LAS char* K_lds = lds + K3_OFF;
    LAS float* wsf = (LAS float*)(lds + WSF3_OFF) + wid * 64; LAS float* li_l = wsf; LAS float* al_l = wsf + 32;
    float mref = 0.f, l_reg = 0; f32x16 o[4] = {}; bf16x8 qr[4]; f32x16 negm = {};
    const bf16_t* Qw = a.Q + (size_t)(qg * 32 + r32) * LDP + map * 64 + hi * 8;
#pragma unroll
    for (int d0 = 0; d0 < 4; ++d0) qr[d0] = ld8(Qw + d0 * 16);
    const int sr = tid >> 4, sc = (tid & 15) * 8, vst0 = v_st(sr, sc), vst1 = v_st(32 + sr, sc);
    const unsigned go0 = (unsigned)(sr * LDP + sc) * 2u, go1 = (unsigned)((32 + sr) * LDP + sc) * 2u;
    const int vb0 = (int)(uintptr_t)V_lds + v_rd_base(lane);
    int kb_[4];
#pragma unroll
    for (int d0 = 0; d0 < 4; ++d0) kb_[d0] = (int)(uintptr_t)K_lds + KSWZ(r32, ((map * 4 + d0) * 16 + hi * 8) * 2);
    const int n1 = a.n1, n2 = a.n2, NT = a.NT;
    bf16x8 vs0, vs1, ks0, ks1;
#define SLOAD(j) do { const int _j = (j); const int _j2 = min(_j - n1, n2 - 1); \
    const char* _Kt = (const char*)((_j < n1) ? a.K1 + (size_t)_j * 64 * LDP : a.K2 + (size_t)_j2 * 64 * LDP); \
    const char* _Vt = (const char*)((_j < n1) ? a.V1 + (size_t)_j * 64 * LDP : a.V2 + (size_t)_j2 * 64 * LDP); \
    vs0 = *(const bf16x8*)(_Vt + go0); vs1 = *(const bf16x8*)(_Vt + go1); ks0 = *(const bf16x8*)(_Kt + go0); ks1 = *(const bf16x8*)(_Kt + go1); } while (0)
#define SWRITE(so) do { *(LAS bf16x8*)(V_lds + (so) + vst0) = vs0; *(LAS bf16x8*)(V_lds + (so) + vst1) = vs1; const int kc = sc * 2; \
    *(LAS bf16x8*)(K_lds + (so) + KSWZ(sr, kc)) = ks0; *(LAS bf16x8*)(K_lds + (so) + KSWZ(32 + sr, kc)) = ks1; } while (0)
#define BAR() do { SBAR(); asm volatile("s_waitcnt lgkmcnt(0)" ::: "memory"); __builtin_amdgcn_s_barrier(); SBAR(); } while (0)
#define PIN(X) asm volatile("" : "+v"(X))
#define SEGV(X0, X1, t) do { \
    float rm = X0[0]; \
    _Pragma("unroll") for (int r = 1; r < 16; ++r) rm = fmaxf(rm, X0[r]); \
    _Pragma("unroll") for (int r = 0; r < 16; ++r) rm = fmaxf(rm, X1[r]); \
    { auto rr = __builtin_amdgcn_permlane32_swap(__float_as_uint(rm), __float_as_uint(rm), false, false); rm = fmaxf(__uint_as_float(rr[0]), __uint_as_float(rr[1])); } \
    if (__builtin_expect((t) == 0 || __any(rm > THRL), 0)) { const float dl = ((t) == 0) ? rm : fmaxf(rm, 0.f); mref += dl; \
        _Pragma("unroll") for (int r = 0; r < 16; ++r) { X0[r] -= dl; X1[r] -= dl; } \
        _Pragma("unroll") for (int r = 0; r < 16; ++r) negm[r] = -mref; \
        const float f = __builtin_amdgcn_exp2f(-dl); l_reg *= f; if (hi == 0) al_l[r32] = f; asm volatile("s_waitcnt lgkmcnt(0)" ::: "memory"); \
        _Pragma("unroll") for (int d = 0; d < 4; ++d) _Pragma("unroll") for (int r = 0; r < 16; ++r) o[d][r] *= al_l[crow(r, hi)]; } \
    sm_exp(X0); sm_exp(X1); \
    sm_finish(X0, X1, 1.0f, l_reg, pa0, pa1, pa2, pa3); \
    PIN(pa0); PIN(pa1); PIN(pa2); PIN(pa3); \
    if ((t) + 1 + half < NT) { SWRITE(s_w); } \
    if ((t) + 2 + half < NT) { SLOAD((t) + 2 + half); } \
    s_w = (s_w == 2 * SHM_V) ? 0 : s_w + SHM_V; } while (0)
#if defined(PROBE_DUPQK)
#define PROBE_DUPQK_STMT(X0, X1) { int ka_[4]; _Pragma("unroll") for (int d0 = 0; d0 < 4; ++d0) ka_[d0] = kb_[d0] + s_k; qkt_cb(X0, X1, ka_, qr, negm); } PIN(X0); PIN(X1);
#else
#define PROBE_DUPQK_STMT(X0, X1)
#endif
#define SEGM(X0, X1, t) do { \
    PROBE_DUPQK_STMT(X0, X1) \
    { int ka_[4]; _Pragma("unroll") for (int d0 = 0; d0 < 4; ++d0) ka_[d0] = kb_[d0] + s_k; segm_body(X0, X1, o, ka_, vb0 + s_v, qr, negm, pa0, pa1, pa2, pa3); }     \
    s_v = s_k; s_k = (s_k == 2 * SHM_V) ? 0 : s_k + SHM_V; } while (0)
    f32x16 pA0, pA1; bf16x8 pa0, pa1, pa2, pa3;
    SLOAD(0); SWRITE(0);
    if (half) { SLOAD(1); SWRITE(SHM_V); }
    SLOAD(1 + half);
    BAR();
    qkt_c(pA0, pA1, K_lds, qr, negm, r32, hi, map * 4);
    if (half) { __builtin_amdgcn_s_setprio(1); BAR(); }
    int s_w = (1 + half) * SHM_V;
    int s_v = 0, s_k = SHM_V;
    for (int t = 0; t < NT; ++t) {
        { TPROBE_BEGIN(3); SEGV(pA0, pA1, t); TPROBE_END(3); }  { TPROBE_BEGIN(5); BAR(); TPROBE_END(5); }
        { TPROBE_BEGIN(4); SEGM(pA0, pA1, t); TPROBE_END(4); }  { TPROBE_BEGIN(5); BAR(); TPROBE_END(5); }
    }
    if (!half) BAR();
    __builtin_amdgcn_s_setprio(0);
    asm volatile("s_waitcnt vmcnt(0)" ::: "memory");
    attn_epilogue<0>(lds, a, o, l_reg, li_l, map, qg, r32, hi);
#undef SLOAD
#undef SWRITE
#undef BAR
#undef PIN
#undef SEGV
#undef SEGM
}

template <int OFF> __device__ __forceinline__ float lds_rd32(int addr) { float r; asm volatile("ds_read_b32 %0, %1 offset:%2" : "=&v"(r) : "v"(addr), "i"(OFF) : "memory"); return r; }
__device__ __forceinline__ void na_unit(LAS char* lds, const AttnArgs& a) {
    constexpr float SC = ModeC<1>::SC;
    int tid_ = threadIdx.x; asm volatile("" : "+v"(tid_));
    const int tid = tid_, wid = __builtin_amdgcn_readfirstlane(tid >> 6), lane = tid & 63, r32 = lane & 31, hi = lane >> 5;
    LAS char* V_lds = lds; LAS char* K_lds = lds + 2 * SHM_V;
    LAS float* wsf = (LAS float*)(lds + WSF_OFF) + wid * 64; LAS float* li_l = wsf; LAS float* al_l = wsf + 32;
    LAS float* bias_l = (LAS float*)(lds + BIAS_OFF);
    float m_reg = -1e30f, l_reg = 0; f32x16 o[4] = {}; bf16x8 qr[8];
    const bf16_t* Qw = a.Q + (size_t)(wid * 32 + r32) * LDP + hi * 8;
#pragma unroll
    for (int d0 = 0; d0 < 8; ++d0) qr[d0] = ld8(Qw + d0 * 16);
    const int nr = a.R0 + (wid >> 1), nqc = 32 * (wid & 1) + r32;
    const int ncs = min(max(nqc - 8, 0), 48), nrs = min(max(nr - 4, 0), 56);
    if (tid < 465) bias_l[tid] = a.rpb[tid] * (1.0f / SC);
    const int sr = tid >> 4, sc = (tid & 15) * 8, vst0 = v_st(sr, sc), vst1 = v_st(32 + sr, sc);
    const int vb0 = (int)(uintptr_t)V_lds + v_rd_base(lane);
    const int n1 = a.n1, NT = a.n1 + a.n2;
    struct { bf16x8 vs0, vs1, ks0, ks1; } st_[2];
#define NA_SLOAD(i, j) do { const int _j = (j); const bf16_t* _Kt = (_j < n1) ? a.K1 + (size_t)_j * 64 * LDP : a.K2 + (size_t)(_j - n1) * 64 * LDP; \
    const bf16_t* _Vt = (_j < n1) ? a.V1 + (size_t)_j * 64 * LDP : a.V2 + (size_t)(_j - n1) * 64 * LDP; \
    st_[i].vs0 = ld8(_Vt + (size_t)sr * LDP + sc); st_[i].vs1 = ld8(_Vt + (size_t)(32 + sr) * LDP + sc); st_[i].ks0 = ld8(_Kt + (size_t)sr * LDP + sc); st_[i].ks1 = ld8(_Kt + (size_t)(32 + sr) * LDP + sc); } while (0)
#define NA_SWRITE(i, buf) do { const int kc = sc * 2; \
    *(LAS bf16x8*)(V_lds + (buf) * SHM_V + vst0) = st_[i].vs0; *(LAS bf16x8*)(V_lds + (buf) * SHM_V + vst1) = st_[i].vs1; \
    *(LAS bf16x8*)(K_lds + (buf) * SHM_K + KSWZ(sr, kc)) = st_[i].ks0; *(LAS bf16x8*)(K_lds + (buf) * SHM_K + KSWZ(32 + sr, kc)) = st_[i].ks1; } while (0)
    NA_SLOAD(0, 0); if (1 < NT) NA_SLOAD(1, 1);
    TPROBE_BEGIN(14);
    for (int j = 0; j < NT; ++j) {
        const int buf = j & 1;
        if (buf == 0) { NA_SWRITE(0, 0); if (j + 2 < NT) NA_SLOAD(0, j + 2); }
        else          { NA_SWRITE(1, 1); if (j + 2 < NT) NA_SLOAD(1, j + 2); }
        __syncthreads();
        const int kr = a.kfirst + j;
        const bool loc = j < n1;
        const bool act = loc ? (kr >= nrs && kr <= nrs + 7) : true;
        TPROBE_BEGIN(13);
        if (act) {
            f32x16 p0, p1; float mn, al; bf16x8 pa0, pa1, pa2, pa3;
            {
              const int kx = (int)(uintptr_t)(K_lds + buf * SHM_K) + r32 * 256, x0 = (hi * 16) ^ ((r32 & 15) << 4);
              const bf16x8 a0 = lds_rd128(kx + (x0 ^ 0)), b0 = lds_rd128_hi(kx + (x0 ^ 0)), a1 = lds_rd128(kx + (x0 ^ 32)), b1 = lds_rd128_hi(kx + (x0 ^ 32));
              const bf16x8 a2 = lds_rd128(kx + (x0 ^ 64)), b2 = lds_rd128_hi(kx + (x0 ^ 64)), a3 = lds_rd128(kx + (x0 ^ 96)), b3 = lds_rd128_hi(kx + (x0 ^ 96));
              const bf16x8 a4 = lds_rd128(kx + (x0 ^ 128)), b4 = lds_rd128_hi(kx + (x0 ^ 128)), a5 = lds_rd128(kx + (x0 ^ 160)), b5 = lds_rd128_hi(kx + (x0 ^ 160));
              const bf16x8 a6 = lds_rd128(kx + (x0 ^ 192)), b6 = lds_rd128_hi(kx + (x0 ^ 192)), a7 = lds_rd128(kx + (x0 ^ 224)), b7 = lds_rd128_hi(kx + (x0 ^ 224));
              const f32x16 z = {};
              LWAIT(14); p0 = __builtin_amdgcn_mfma_f32_32x32x16_bf16(a0, qr[0], z, 0, 0, 0); p1 = __builtin_amdgcn_mfma_f32_32x32x16_bf16(b0, qr[0], z, 0, 0, 0);
              LWAIT(12); p0 = __builtin_amdgcn_mfma_f32_32x32x16_bf16(a1, qr[1], p0, 0, 0, 0); p1 = __builtin_amdgcn_mfma_f32_32x32x16_bf16(b1, qr[1], p1, 0, 0, 0);
              LWAIT(10); p0 = __builtin_amdgcn_mfma_f32_32x32x16_bf16(a2, qr[2], p0, 0, 0, 0); p1 = __builtin_amdgcn_mfma_f32_32x32x16_bf16(b2, qr[2], p1, 0, 0, 0);
              LWAIT(8);  p0 = __builtin_amdgcn_mfma_f32_32x32x16_bf16(a3, qr[3], p0, 0, 0, 0); p1 = __builtin_amdgcn_mfma_f32_32x32x16_bf16(b3, qr[3], p1, 0, 0, 0);
              LWAIT(6);  p0 = __builtin_amdgcn_mfma_f32_32x32x16_bf16(a4, qr[4], p0, 0, 0, 0); p1 = __builtin_amdgcn_mfma_f32_32x32x16_bf16(b4, qr[4], p1, 0, 0, 0);
              LWAIT(4);  p0 = __builtin_amdgcn_mfma_f32_32x32x16_bf16(a5, qr[5], p0, 0, 0, 0); p1 = __builtin_amdgcn_mfma_f32_32x32x16_bf16(b5, qr[5], p1, 0, 0, 0);
              LWAIT(2);  p0 = __builtin_amdgcn_mfma_f32_32x32x16_bf16(a6, qr[6], p0, 0, 0, 0); p1 = __builtin_amdgcn_mfma_f32_32x32x16_bf16(b6, qr[6], p1, 0, 0, 0);
              LWAIT(0);  p0 = __builtin_amdgcn_mfma_f32_32x32x16_bf16(a7, qr[7], p0, 0, 0, 0); p1 = __builtin_amdgcn_mfma_f32_32x32x16_bf16(b7, qr[7], p1, 0, 0, 0); }
            if (loc) {
                const int rel = kr - nr + 7; const int bb = (int)(uintptr_t)bias_l + 4 * (rel * 31 + 15 - nqc + 4 * hi);
                float bv0[16], bv1[16];
#define BRD(r) bv0[r] = lds_rd32<4 * (((r) & 3) + 8 * ((r) >> 2))>(bb); bv1[r] = lds_rd32<4 * (((r) & 3) + 8 * ((r) >> 2)) + 128>(bb);
                BRD(0) BRD(1) BRD(2) BRD(3) BRD(4) BRD(5) BRD(6) BRD(7) BRD(8) BRD(9) BRD(10) BRD(11) BRD(12) BRD(13) BRD(14) BRD(15)
#undef BRD
                asm volatile("s_waitcnt lgkmcnt(0)" ::: "memory"); SBAR();
#pragma unroll
                for (int r = 0; r < 16; ++r) { const int kc0 = crow(r, hi), kc1 = 32 + kc0;
                    const bool v0 = (unsigned)(kc0 - ncs) < 16u, v1 = (unsigned)(kc1 - ncs) < 16u;
                    p0[r] = v0 ? p0[r] + bv0[r] : -1e30f; p1[r] = v1 ? p1[r] + bv1[r] : -1e30f; }
            }
            partialSM<1>(p0, p1, m_reg, mn, al);
            if (__any(al < 1.f)) { if (hi == 0) al_l[r32] = al; asm volatile("s_waitcnt lgkmcnt(0)" ::: "memory");
#pragma unroll
                for (int d = 0; d < 4; ++d)
#pragma unroll
                    for (int r = 0; r < 16; ++r) o[d][r] *= al_l[crow(r, hi)]; }
            finishSM(p0, p1, al, l_reg, pa0, pa1, pa2, pa3);
            pv_d0(o, vb0 + buf * SHM_V, pa0, pa1, pa2, pa3);
        }
        TPROBE_END(13);
    }
    TPROBE_END(14);
#undef NA_SLOAD
#undef NA_SWRITE
    attn_epilogue<1>(lds, a, o, l_reg, li_l, 0, wid, r32, hi);
}

struct MlpArgs { const bf16_t* Prow; bf16_t* Yrow; const bf16_t* Wsb; const float *lng, *lnb, *bs, *mg; int g; };
__device__ __forceinline__ void mlp_unit(LAS char* lds, const MlpArgs& a) {
    int tid_ = threadIdx.x; asm volatile("" : "+v"(tid_));
    const int tid = tid_, wid = __builtin_amdgcn_readfirstlane(tid >> 6), lane = tid & 63, r32 = lane & 31, hi = lane >> 5;
    const int sr = tid >> 4, sc = (tid & 15) * 8, g = a.g;
    const f32x4 lg0 = *(const f32x4*)(a.lng + g * 128 + sc), lg1 = *(const f32x4*)(a.lng + g * 128 + sc + 4);
    const f32x4 lb0 = *(const f32x4*)(a.lnb + g * 128 + sc), lb1 = *(const f32x4*)(a.lnb + g * 128 + sc + 4);
#pragma unroll
    for (int t = 0; t < 4; ++t) {
        const int q = t * 32 + sr;
        const u32x4 w = *(const u32x4*)(a.Prow + (size_t)q * LDP + C_MV + g * 128 + sc);
        float v[8] = {bf_lo(w.x), bf_hi(w.x), bf_lo(w.y), bf_hi(w.y), bf_lo(w.z), bf_hi(w.z), bf_lo(w.w), bf_hi(w.w)};
        float s = 0.f;
#pragma unroll
        for (int e = 0; e < 8; ++e) s += v[e];
        s += __shfl_xor(s, 1); s += __shfl_xor(s, 2); s += __shfl_xor(s, 4); s += __shfl_xor(s, 8);
        const float mu = s * (1.0f / 128.0f); float qq = 0.f;
#pragma unroll
        for (int e = 0; e < 8; ++e) { v[e] -= mu; qq += v[e] * v[e]; }
        qq += __shfl_xor(qq, 1); qq += __shfl_xor(qq, 2); qq += __shfl_xor(qq, 4); qq += __shfl_xor(qq, 8);
        const float rstd = __builtin_amdgcn_rsqf(qq * (1.0f / 128.0f) + EPS);
        u32x4 ow;
        ow.x = cvt_pk_bf16(v[0] * rstd * lg0[0] + lb0[0], v[1] * rstd * lg0[1] + lb0[1]); ow.y = cvt_pk_bf16(v[2] * rstd * lg0[2] + lb0[2], v[3] * rstd * lg0[3] + lb0[3]);
        ow.z = cvt_pk_bf16(v[4] * rstd * lg1[0] + lb1[0], v[5] * rstd * lg1[1] + lb1[1]); ow.w = cvt_pk_bf16(v[6] * rstd * lg1[2] + lb1[2], v[7] * rstd * lg1[3] + lb1[3]);
        *(LAS u32x4*)(lds + (q >> 6) * SHM_V + v_st(q & 63, sc)) = ow;
    }
    const int prow0 = 32 * (wid & 3), dsel = wid >> 2;
    bf16x8 pa[8];
    const bf16_t* wp = a.Wsb + ((size_t)(g * 128 + prow0 + r32)) * 128 + 8 * hi;
#pragma unroll
    for (int s = 0; s < 8; ++s) pa[s] = ld8(wp + 16 * s);
    __syncthreads();
    f32x16 o0 = {}, o1 = {};
    const int vb0 = (int)(uintptr_t)lds + v_rd_base(lane);
    if (dsel == 0) { pv_one<0>(o0, vb0, pa[0], pa[1], pa[2], pa[3]); pv_one<1>(o1, vb0, pa[0], pa[1], pa[2], pa[3]);
                     pv_one<0>(o0, vb0 + SHM_V, pa[4], pa[5], pa[6], pa[7]); pv_one<1>(o1, vb0 + SHM_V, pa[4], pa[5], pa[6], pa[7]); }
    else           { pv_one<2>(o0, vb0, pa[0], pa[1], pa[2], pa[3]); pv_one<3>(o1, vb0, pa[0], pa[1], pa[2], pa[3]);
                     pv_one<2>(o0, vb0 + SHM_V, pa[4], pa[5], pa[6], pa[7]); pv_one<3>(o1, vb0 + SHM_V, pa[4], pa[5], pa[6], pa[7]); }
    __syncthreads();
    LAS float* X = (LAS float*)lds;
#pragma unroll
    for (int r = 0; r < 16; ++r) { X[(prow0 + crow(r, hi)) * XS + (2 * dsel) * 32 + r32] = o0[r]; X[(prow0 + crow(r, hi)) * XS + (2 * dsel + 1) * 32 + r32] = o1[r]; }
    __syncthreads();
    final_pass<true>(X, 128, a.Prow + C_MZ + g * 128, a.Yrow + 1536 + g * 128, a.mg + g * 128, 1.0f, a.Prow + C_MU + g * 128, a.bs + g * 128);
    __syncthreads();
}
}

__device__ __forceinline__ void p0_transpose_item(const float* W, int K, int N, bf16_t* WT, LAS float* scr, int item, int lane) {
    const int nblk = N / 32, kb = item / nblk, nb = item % nblk, k0 = 64 * kb, n0 = 32 * nb;
#pragma unroll 8
    for (int i = 0; i < 32; ++i) { const int kk = 2 * i + (lane >> 5); scr[kk * 33 + (lane & 31)] = W[(size_t)(k0 + kk) * N + n0 + (lane & 31)]; }
    asm volatile("s_waitcnt lgkmcnt(0)" ::: "memory");
    const int c = lane & 7;
#pragma unroll
    for (int j = 0; j < 4; ++j) { const int n = (lane >> 3) + 8 * j; const LAS float* s = scr + (8 * c) * 33 + n;
        u32x4 o; o.x = cvt_pk_bf16(s[0 * 33], s[1 * 33]); o.y = cvt_pk_bf16(s[2 * 33], s[3 * 33]); o.z = cvt_pk_bf16(s[4 * 33], s[5 * 33]); o.w = cvt_pk_bf16(s[6 * 33], s[7 * 33]);
        *(u32x4*)(WT + (size_t)(n0 + n) * K + k0 + 8 * c) = o; }
    asm volatile("s_waitcnt lgkmcnt(0)" ::: "memory");
}

__device__ __forceinline__ void phase0a(const Params& p, LAS unsigned char* lds, int tid, int lane, int wave) {
    const int gw = blockIdx.x * 8 + wave, ngw = gridDim.x * 8;
    unsigned char* ws = p.ws;
    LAS float* scr = (LAS float*)(lds + wave * 16384);
    float* mod = (float*)(ws + WS_CTL + CTL_MOD);
    for (int it = (int)blockIdx.x + (int)gridDim.x * wave; it < 768; it += (int)gridDim.x * 8) {
        const int l = it / 384, r = it % 384, kc = r / 24, nc = r % 24;
        const float* W = p.ada_w + (size_t)l * DM * 6144 + nc * 256 + lane * 4;
        f32x4 acc[5];
#pragma unroll
        for (int b = 0; b < 5; ++b) acc[b] = (f32x4){0.f, 0.f, 0.f, 0.f};
        for (int half = 0; half < 2; ++half) {
            const int k0 = kc * 128 + half * 64;
            float sv[5];
#pragma unroll
            for (int b = 0; b < 4; ++b) sv[b] = silu_f(p.c[b * DM + k0 + lane]);
            sv[4] = silu_f(p.c_ctx[k0 + lane]);
#pragma unroll 8
            for (int kk = 0; kk < 64; ++kk) {
                const f32x4 w4 = *(const f32x4*)(W + (size_t)(k0 + kk) * 6144);
#pragma unroll
                for (int b = 0; b < 5; ++b) { const float s = __uint_as_float(__builtin_amdgcn_readlane(__float_as_uint(sv[b]), kk)); acc[b] += w4 * s; }
            }
        }
        if (kc == 0) { const f32x4 bv = *(const f32x4*)(p.ada_b + l * 6144 + nc * 256 + lane * 4);
#pragma unroll
            for (int b = 0; b < 5; ++b) acc[b] += bv; }
#pragma unroll
        for (int b = 0; b < 5; ++b) { float* dst = mod + ((size_t)(l * 5 + b)) * 6144 + nc * 256 + lane * 4;
#pragma unroll
            for (int e = 0; e < 4; ++e) atomicAdd(dst + e, acc[b][e]); }
    }
    float* tab = (float*)(ws + WS_TAB);
    if (gw == ngw - 1) {
        for (int idx = lane; idx < 1024; idx += 64) { const int pos = idx >> 4, i = idx & 15;
            const float freq = powf(10000.0f, -(float)i / 16.0f); const float ang = (float)pos * freq;
            tab[idx] = cosf(ang); tab[1024 + idx] = sinf(ang); }
    }
    if (gw == ngw - 2) {
        for (int l = 0; l < 2; ++l) {
            const float s1 = wave_sum(p.lq1[l * 64 + lane] * p.lk1[l * 64 + lane]), s2 = wave_sum(p.lq2[l * 64 + lane] * p.lk2[l * 64 + lane]);
            const float lam_init = 0.8f - 0.6f * expf(-0.3f * (float)l);
            if (lane == 0) tab[2048 + l] = expf(s1) - expf(s2) + lam_init;
        }
    }
    { bf16_t* wsb = (bf16_t*)(ws + WS_WSB); const int gt = blockIdx.x * 512 + tid;
      if (gt < 16384) { const f32x4 a = *(const f32x4*)(p.mws + gt * 8), b = *(const f32x4*)(p.mws + gt * 8 + 4);
          u32x4 o; o.x = cvt_pk_bf16(a[0], a[1]); o.y = cvt_pk_bf16(a[2], a[3]); o.z = cvt_pk_bf16(b[0], b[1]); o.w = cvt_pk_bf16(b[2], b[3]); *(u32x4*)(wsb + gt * 8) = o; } }
}

__device__ __forceinline__ void phase0b(const Params& p, LAS unsigned char* lds, int tid, int lane, int wave) {
    const int gw = blockIdx.x * 8 + wave, ngw = gridDim.x * 8;
    unsigned char* ws = p.ws;
    LAS float* scr = (LAS float*)(lds + wave * 16384);
    bf16_t* WinT = (bf16_t*)(ws + WS_WIN); bf16_t* WoutT = (bf16_t*)(ws + WS_WOUT);
    constexpr int I_IN = (DM / 64) * (INW / 32), I_OUT = (DM / 64) * (DM / 32), I_L = I_IN + I_OUT;
    for (int it = gw; it < 2 * I_L; it += ngw) {
        const int l = it / I_L, r = it % I_L;
        if (r < I_IN) p0_transpose_item(p.w_in + (size_t)l * DM * INW, DM, INW, WinT + (size_t)l * INW * DM, scr, r, lane);
        else p0_transpose_item(p.w_out + (size_t)l * DM * DM, DM, DM, WoutT + (size_t)l * DM * DM, scr, r - I_IN, lane);
    }
}

template <int L>
__device__ __forceinline__ void norm_phase(const Params& p, int lane, int wave) {
    const int gw = blockIdx.x * 8 + wave, ngw = gridDim.x * 8;
    unsigned char* ws = p.ws;
    const float* mod = (const float*)(ws + WS_CTL + CTL_MOD);
    const float* rowss = (const float*)(ws + WS_CTL + CTL_ROWSS);
    const bf16_t* Y0 = (const bf16_t*)(ws + WS_Y0); const bf16_t* Y1 = (const bf16_t*)(ws + WS_P);
    bf16_t* H = (bf16_t*)(ws + WS_H);
    const int nrows = (L == 2) ? NLAT : MROWS;
    int bcur = -1; f32x4 gq[2][4][2];
    for (int row = gw; row < nrows; row += ngw) {
        const bool isctx = row >= NLAT; const int b = isctx ? 4 : (row >> 12);
        const float* xin = isctx ? p.ctx + (size_t)(row - NLAT) * DM : p.x + (size_t)row * DM;
        f32x4 v[4][2];
#pragma unroll
        for (int j = 0; j < 4; ++j) { v[j][0] = *(const f32x4*)(xin + 8 * lane + 512 * j); v[j][1] = *(const f32x4*)(xin + 8 * lane + 512 * j + 4); }
        if (L >= 1 && b != bcur) { bcur = b;
#pragma unroll
            for (int lp = 0; lp < 2; ++lp) if (lp < L) {
                const float* gate = mod + ((size_t)(lp * 5 + b)) * 6144 + 4096; const float* pg = p.post_g + lp * DM;
#pragma unroll
                for (int j = 0; j < 4; ++j)
#pragma unroll
                    for (int e = 0; e < 2; ++e) { const int cidx = 8 * lane + 512 * j + 4 * e; gq[lp][j][e] = *(const f32x4*)(gate + cidx) * *(const f32x4*)(pg + cidx); } } }
#pragma unroll
        for (int lp = 0; lp < 2; ++lp) {
            if (lp < L) {
                const float rs = __builtin_amdgcn_rsqf(rowss[lp * MROWS + row] * (1.0f / DM) + EPS);
                const bf16_t* Yb = (lp == 0) ? Y0 : Y1;
#pragma unroll
                for (int j = 0; j < 4; ++j) { const int cidx = 8 * lane + 512 * j;
                    const u32x4 w = *(const u32x4*)(Yb + (size_t)row * DM + cidx);
                    const f32x4 y0 = {bf_lo(w.x), bf_hi(w.x), bf_lo(w.y), bf_hi(w.y)}, y1 = {bf_lo(w.z), bf_hi(w.z), bf_lo(w.w), bf_hi(w.w)};
                    v[j][0] = v[j][0] + gq[lp][j][0] * (y0 * rs); v[j][1] = v[j][1] + gq[lp][j][1] * (y1 * rs); }
            }
        }
        if (L == 2) {
            float* xo = p.out + (size_t)row * DM;
#pragma unroll
            for (int j = 0; j < 4; ++j) { *(f32x4*)(xo + 8 * lane + 512 * j) = v[j][0]; *(f32x4*)(xo + 8 * lane + 512 * j + 4) = v[j][1]; }
        } else {
            float ss = 0.f;
#pragma unroll
            for (int j = 0; j < 4; ++j)
#pragma unroll
                for (int e = 0; e < 2; ++e) ss += (v[j][e][0] * v[j][e][0] + v[j][e][1] * v[j][e][1]) + (v[j][e][2] * v[j][e][2] + v[j][e][3] * v[j][e][3]);
            ss = wave_sum(ss);
            const float rstd = __builtin_amdgcn_rsqf(ss * (1.0f / DM) + EPS);
            const float* shift = mod + ((size_t)(L * 5 + b)) * 6144; const float* scale = shift + 2048; const float* pg = p.pre_g + L * DM;
#pragma unroll
            for (int j = 0; j < 4; ++j) { const int cidx = 8 * lane + 512 * j;
                f32x4 hv[2];
#pragma unroll
                for (int e = 0; e < 2; ++e) { const f32x4 sh = *(const f32x4*)(shift + cidx + 4 * e), scv = *(const f32x4*)(scale + cidx + 4 * e), g4 = *(const f32x4*)(pg + cidx + 4 * e);
                    hv[e] = (v[j][e] * rstd) * g4 * (scv + 1.0f) + sh; }
                u32x4 w; w.x = cvt_pk_bf16(hv[0][0], hv[0][1]); w.y = cvt_pk_bf16(hv[0][2], hv[0][3]); w.z = cvt_pk_bf16(hv[1][0], hv[1][1]); w.w = cvt_pk_bf16(hv[1][2], hv[1][3]);
                *(u32x4*)(H + (size_t)row * DM + cidx) = w; }
        }
    }
}

template <int L>
__device__ __forceinline__ void mixer_phase(const Params& p, LAS unsigned char* lds8, int tid, int qslot, int umask) {
    LAS char* lds = (LAS char*)lds8;
    unsigned char* ws = p.ws;
    const bf16_t* P = (const bf16_t*)(ws + WS_P);
    bf16_t* Y = (bf16_t*)(ws + WS_H);
    const float* tab = (const float*)(ws + WS_TAB);
    const float lam = tab[2048 + L];
    const float lam_init = (L == 0) ? 0.2f : 0.35550906759096926f;
    unsigned* qctr = (unsigned*)(ws + WS_CTL + CTL_QCTR) + 64 * qslot;
    volatile LAS unsigned* misc = (volatile LAS unsigned*)(lds8 + MISC_OFF);
    constexpr int N_DIFF = NB * 6 * 32, N_NA = NB * 6 * 16, N_DIFFC = (L == 0) ? NB * 6 * 2 : 0, N_SMC = (L == 0) ? NB * 6 : 0, N_MLP = NB * 32 * 4, N_MLPC = (L == 0) ? NB * 2 * 4 : 0;
    constexpr int NU = N_DIFF + N_NA + N_DIFFC + N_SMC + N_MLP + N_MLPC;
#define PULL() do { if (tid == 0) misc[0] = atomicAdd(qctr, 1u); __syncthreads(); u = (int)misc[0]; __syncthreads(); } while (0)
    int u; PULL();
    constexpr int E_DIFF = N_DIFF, E_NA = E_DIFF + N_NA, E_DIFFC = E_NA + N_DIFFC, E_SMC = E_DIFFC + N_SMC;
    TPROBE_BEGIN(6); unsigned long long _tl = 0; if (PROBE_T == 30 + L && blockIdx.x == 0 && threadIdx.x == 0) _tl = wall_clock64();
    while (u < E_DIFF) { if (!(umask & 1)) { PULL(); continue; }
        if ((PROBE_T == 7 || PROBE_T == 34 + L) && blockIdx.x == 0 && threadIdx.x == 0) { misc[20] = misc[20] + 5000u; }
        const int qb = u & 31, h = (u >> 5) % 6, b = u / 192;
        att::AttnArgs a{};
        const size_t t0 = (size_t)b * SEQ, tq = t0 + qb * 128, tc = (size_t)NLAT + b * CTXL;
        a.Q = P + tq * LDP + C_AQ + h * HD;
        a.K1 = P + t0 * LDP + C_AK + h * HD; a.K2 = P + tc * LDP + C_AK + h * HD;
        a.V1 = P + t0 * LDP + C_AV + h * HD; a.V2 = P + tc * LDP + C_AV + h * HD;
        a.n1 = 64; a.n2 = 4; a.NT = 68;
        a.Z = P + tq * LDP + C_AZ + h * HD; a.Y = Y + tq * DM + h * HD; a.g = p.da_g + L * HD; a.factor = 1.0f - lam_init; a.lam = lam;
        { TPROBE_BEGIN(1); att::diff_unit(lds, a); TPROBE_END(1); }
        PULL();
    }
    TPROBE_END(6); if (PROBE_T == 30 + L && blockIdx.x == 0 && threadIdx.x == 0) { misc[20] = misc[20] + (unsigned)(wall_clock64() - _tl); }
    if (PROBE_T == 32 + L && blockIdx.x == 0 && threadIdx.x == 0) { misc[20] = misc[20] + 5000u * 0u; }
    TPROBE_BEGIN(8);
    while (u >= E_DIFF && u < E_NA) { if (!(umask & 2)) { PULL(); continue; }
        if (PROBE_T == 9 && blockIdx.x == 0 && threadIdx.x == 0) { misc[20] = misc[20] + 5000u; }
        const int v = u - E_DIFF; const int g4 = v & 15, h = (v >> 4) % 6, b = v / 96;
        att::AttnArgs a{};
        const int R0 = 4 * g4, kfirst = min(max(R0 - 4, 0), 56), klast = min(max(R0 - 1, 0), 56) + 7, nloc = klast - kfirst + 1;
        const size_t t0 = (size_t)b * SEQ, tq = t0 + R0 * 64, tk = t0 + kfirst * 64, tc = (size_t)NLAT + b * CTXL;
        a.Q = P + tq * LDP + C_NQ + h * HD;
        a.K1 = P + tk * LDP + C_NK + h * HD; a.K2 = P + tc * LDP + C_NK + h * HD;
        a.V1 = P + tk * LDP + C_NV + h * HD; a.V2 = P + tc * LDP + C_NV + h * HD;
        a.n1 = nloc; a.n2 = 4; a.NT = nloc + 4;
        a.R0 = R0; a.kfirst = kfirst; a.rpb = p.rpb + ((size_t)(L * 6 + h)) * 465;
        a.Z = P + tq * LDP + C_NZ + h * HD; a.Y = Y + tq * DM + 768 + h * HD; a.g = p.na_g + (L * 6 + h) * HD; a.factor = 1.0f; a.lam = 0.f;
        att::na_unit(lds, a);
        PULL();
    }
    TPROBE_END(8);
    while (L == 0 && u >= E_NA && u < E_DIFFC) { if (!(umask & 4)) { PULL(); continue; }
        const int v = u - E_NA; const int qb = v & 1, h = (v >> 1) % 6, b = v / 12;
        att::AttnArgs a{};
        const size_t tc = (size_t)NLAT + b * CTXL, tq = tc + qb * 128;
        a.Q = P + tq * LDP + C_AQ + h * HD;
        a.K1 = P + tc * LDP + C_AK + h * HD; a.K2 = a.K1; a.V1 = P + tc * LDP + C_AV + h * HD; a.V2 = a.V1;
        a.n1 = 4; a.n2 = 1; a.NT = 4;
        a.Z = P + tq * LDP + C_AZ + h * HD; a.Y = Y + tq * DM + h * HD; a.g = p.da_g + L * HD; a.factor = 1.0f - lam_init; a.lam = lam;
        att::diff_unit(lds, a);
        PULL();
    }
    while (L == 0 && u >= E_DIFFC && u < E_SMC) { if (!(umask & 8)) { PULL(); continue; }
        const int v = u - E_DIFFC; const int h = v % 6, b = v / 6;
        att::AttnArgs a{};
        const size_t tc = (size_t)NLAT + b * CTXL;
        a.Q = P + tc * LDP + C_NQ + h * HD;
        a.K1 = P + tc * LDP + C_NK + h * HD; a.K2 = a.K1; a.V1 = P + tc * LDP + C_NV + h * HD; a.V2 = a.V1;
        a.n1 = 0; a.n2 = 4; a.NT = 4; a.rpb = p.rpb;
        a.Z = P + tc * LDP + C_NZ + h * HD; a.Y = Y + tc * DM + 768 + h * HD; a.g = p.na_g + (L * 6 + h) * HD; a.factor = 1.0f; a.lam = 0.f;
        att::na_unit(lds, a);
        PULL();
    }
    TPROBE_BEGIN(12);
    while (u >= E_SMC && u < NU) { if (!(umask & 16)) { PULL(); continue; }
        const int v = u - E_SMC;
        att::MlpArgs m{};
        size_t t0;
        if (v < N_MLP) { const int g = v & 3, ch = (v >> 2) & 31, b = v >> 7; t0 = (size_t)b * SEQ + ch * 128; m.g = g; }
        else { const int w = v - N_MLP; const int g = w & 3, ch = (w >> 2) & 1, b = w >> 3; t0 = (size_t)NLAT + b * CTXL + ch * 128; m.g = g; }
        m.Prow = P + t0 * LDP; m.Yrow = Y + t0 * DM; m.Wsb = (const bf16_t*)(ws + WS_WSB) + (size_t)L * 4 * 128 * 128;
        m.lng = p.ln_g + L * 512; m.lnb = p.ln_b + L * 512; m.bs = p.mbs + L * 512; m.mg = p.mlp_g + L * 512;
        att::mlp_unit(lds, m);
        PULL();
    }
    TPROBE_END(12);
#undef PULL
}

#define XB_TMO      128
#define XB_XCNT(j)  (256  + 64 * (j))
#define XB_XSUB(j)  (1280 + 64 * (j))
#define XB_XGEN(j)  (2304 + 64 * (j))
#define XB_TOP      3328
#define XB_TOPGEN   3392
#define XCD_BAR_WORDS 3456
#define XB_SPIN_CAP (1u << 22)
__device__ __forceinline__ unsigned xb_ld(unsigned* p)              { return __hip_atomic_load(p, __ATOMIC_RELAXED, __HIP_MEMORY_SCOPE_AGENT); }
__device__ __forceinline__ unsigned xb_add(unsigned* p, unsigned v) { return __hip_atomic_fetch_add(p, v, __ATOMIC_RELAXED, __HIP_MEMORY_SCOPE_AGENT); }
__device__ __forceinline__ unsigned xb_xcc_id() { return (unsigned)__builtin_amdgcn_s_getreg((3 << 11) | 20) & 0xFu; }
#define XB_SPIN(cond, bar) do { unsigned _sp = 0; while (cond) { __builtin_amdgcn_s_sleep(1); \
    if ((++_sp & 255u) == 0u) { if (xb_ld(&(bar)[XB_TMO])) break; if (_sp > XB_SPIN_CAP) { atomicAdd(&(bar)[XB_TMO], 1u); break; } } } } while (0)
struct XcdBarrier { unsigned* bar; unsigned x; volatile LAS unsigned* st; };
__device__ __forceinline__ XcdBarrier xcd_barrier_post(unsigned* bar, volatile LAS unsigned* st) {
    XcdBarrier b; b.bar = bar; b.x = xb_xcc_id(); b.st = st;
    if (threadIdx.x == 0) (void)xb_add(&bar[XB_XCNT(b.x)], 1u);
    return b;
}
__device__ __forceinline__ void xcd_barrier_complete(unsigned* bar, unsigned x, unsigned& nloc, unsigned& nx) {
    const unsigned G = gridDim.x * gridDim.y * gridDim.z;
    unsigned sum, cnt, mine, sp = 0u;
    for (;;) {
        sum = 0u; cnt = 0u; mine = 0u;
#pragma unroll
        for (unsigned j = 0; j < 16; ++j) { const unsigned c = xb_ld(&bar[XB_XCNT(j)]); sum += c; cnt += (c > 0u) ? 1u : 0u; mine = (j == x) ? c : mine; }
        if (sum == G) break;
        __builtin_amdgcn_s_sleep(1);
        if ((++sp & 255u) == 0u) { if (xb_ld(&bar[XB_TMO])) break; if (sp > XB_SPIN_CAP) { atomicAdd(&bar[XB_TMO], 1u); break; } }
    }
    nloc = mine > 0u ? mine : 1u; nx = cnt > 0u ? cnt : 1u;
}
__device__ __forceinline__ void xcd_barrier(const XcdBarrier& b) {
    asm volatile("s_waitcnt vmcnt(0)" ::: "memory");
    __syncthreads();
    if (threadIdx.x == 0) {
        unsigned* bar = b.bar;
        __builtin_amdgcn_s_waitcnt(0);
        unsigned nloc = b.st[0], nx = b.st[1];
        if (nloc == 0u) { xcd_barrier_complete(bar, b.x, nloc, nx); b.st[0] = nloc; b.st[1] = nx; }
        const unsigned old = xb_add(&bar[XB_XSUB(b.x)], 1u);
        const unsigned gen = old / nloc;
        if (old + 1u == (gen + 1u) * nloc) {
            __builtin_amdgcn_fence(__ATOMIC_RELEASE, "agent");
            asm volatile("s_waitcnt vmcnt(0)" ::: "memory");
            const unsigned og = xb_add(&bar[XB_TOP], 1u);
            const unsigned tg = og / nx;
            if (og + 1u == (tg + 1u) * nx) xb_add(&bar[XB_TOPGEN], 1u);
            else XB_SPIN(xb_ld(&bar[XB_TOPGEN]) == tg, bar);
            __builtin_amdgcn_fence(__ATOMIC_ACQUIRE, "agent");
            xb_add(&bar[XB_XGEN(b.x)], 1u);
            asm volatile("s_waitcnt vmcnt(0)" ::: "memory");
        } else {
            XB_SPIN(xb_ld(&bar[XB_XGEN(b.x)]) == gen, bar);
            __builtin_amdgcn_fence(__ATOMIC_ACQUIRE, "agent");
            asm volatile("s_waitcnt vmcnt(0)" ::: "memory");
        }
    }
    __syncthreads();
}

__global__ void __launch_bounds__(512, 2) mega_fwd(Params p) {
    extern __shared__ __attribute__((aligned(16))) unsigned char lds_raw[];
    LAS unsigned char* lds = (LAS unsigned char*)lds_raw;
    const int tid = threadIdx.x, lane = tid & 63, wave = __builtin_amdgcn_readfirstlane(tid >> 6);
    unsigned char* ws = p.ws;
    const int lo = p.ph_lo, hi = p.ph_hi;
    volatile LAS unsigned* MISC = (volatile LAS unsigned*)(lds + MISC_OFF);
    if (tid < 64) MISC[tid] = 0u;
    __syncthreads();
    XcdBarrier bar = xcd_barrier_post((unsigned*)(ws + WS_CTL + CTL_BAR), MISC + 8);
#ifndef PH_MASK
#define PH_MASK 0x3ff
#endif
#define IN(k) (((PH_MASK >> (k)) & 1) && lo <= (k) && (k) < hi)
#define SEAM(k) do { if (IN(k) && IN((k) + 1)) { xcd_barrier(bar); } } while (0)
    TPROBE_BEGIN(20);
    if (IN(0)) phase0a(p, lds, tid, lane, wave);
    SEAM(0);
    TPROBE_END(20);
    TPROBE_BEGIN(21);
    if (IN(1)) { norm_phase<0>(p, lane, wave); phase0b(p, lds, tid, lane, wave); }
    SEAM(1);
    TPROBE_END(21);
    TPROBE_BEGIN(22);
    if (IN(2)) for (int rep = 0; rep < ((DUP_PHASE == 2) ? 2 : 1); ++rep) { if (rep) xcd_barrier(bar); pg8::Gemm g{(const bf16_t*)(ws + WS_H), (const bf16_t*)(ws + WS_WIN), DM}; pg8::Sched S; S.init(68, 30, gridDim.x, blockIdx.x, 0);
        pg8::Epi1 E{(bf16_t*)(ws + WS_P), (const float*)(ws + WS_TAB), (const float*)(ws + WS_TAB) + 1024}; pg8::gemm_phase<pg8::Epi1>(lds, g, S, E); }
    SEAM(2);
    TPROBE_END(22);
    TPROBE_BEGIN(23);
    if (IN(3)) mixer_phase<0>(p, lds, tid, 0, UNIT_MASK);
    if (DUP_PHASE == 3) { xcd_barrier(bar); mixer_phase<0>(p, lds, tid, 3, DUP_UMASK); }
    SEAM(3);
    TPROBE_END(23);
    TPROBE_BEGIN(24);
    if (IN(4)) { pg8::Gemm g{(const bf16_t*)(ws + WS_H), (const bf16_t*)(ws + WS_WOUT), DM}; pg8::Sched S; S.init(68, 8, gridDim.x, blockIdx.x, 0);
        pg8::Epi2 E{(bf16_t*)(ws + WS_Y0), (float*)(ws + WS_CTL + CTL_ROWSS)}; pg8::gemm_phase<pg8::Epi2>(lds, g, S, E); }
    SEAM(4);
    TPROBE_END(24);
    TPROBE_BEGIN(25);
    if (IN(5)) norm_phase<1>(p, lane, wave);
    if (DUP_PHASE == 5) { xcd_barrier(bar); norm_phase<1>(p, lane, wave); }
    SEAM(5);
    TPROBE_END(25);
    TPROBE_BEGIN(26);
    if (IN(6)) { pg8::Gemm g{(const bf16_t*)(ws + WS_H), (const bf16_t*)(ws + WS_WIN) + (size_t)INW * DM, DM}; pg8::Sched S; S.init(64, 30, gridDim.x, blockIdx.x, 48);
        pg8::Epi1 E{(bf16_t*)(ws + WS_P), (const float*)(ws + WS_TAB), (const float*)(ws + WS_TAB) + 1024}; pg8::gemm_phase<pg8::Epi1>(lds, g, S, E); }
    SEAM(6);
    TPROBE_END(26);
    { TPROBE_BEGIN(10); if (IN(7)) mixer_phase<1>(p, lds, tid, 1, UNIT_MASK); TPROBE_END(10);
      TPROBE_BEGIN(11); if (PROBE_T == 11) xcd_barrier(bar); TPROBE_END(11); }
    if (DUP_PHASE == 7) { xcd_barrier(bar); mixer_phase<1>(p, lds, tid, 2, DUP_UMASK); }
    SEAM(7);
    TPROBE_BEGIN(28);
    if (IN(8)) { pg8::Gemm g{(const bf16_t*)(ws + WS_H), (const bf16_t*)(ws + WS_WOUT) + (size_t)DM * DM, DM}; pg8::Sched S; S.init(64, 8, gridDim.x, blockIdx.x, 0);
        pg8::Epi2 E{(bf16_t*)(ws + WS_P), (float*)(ws + WS_CTL + CTL_ROWSS) + MROWS}; pg8::gemm_phase<pg8::Epi2>(lds, g, S, E); }
    if (DUP_PHASE == 8) { xcd_barrier(bar); pg8::Gemm g{(const bf16_t*)(ws + WS_H), (const bf16_t*)(ws + WS_WOUT) + (size_t)DM * DM, DM}; pg8::Sched S; S.init(64, 8, gridDim.x, blockIdx.x, 0);
        pg8::Epi2 E{(bf16_t*)(ws + WS_P), (float*)(ws + WS_CTL + 786432)}; pg8::gemm_phase<pg8::Epi2>(lds, g, S, E); }
    SEAM(8);
    TPROBE_END(28);
    TPROBE_BEGIN(29);
    if (IN(9)) norm_phase<2>(p, lane, wave);
    TPROBE_END(29);
    if (PROBE_T != 0 && blockIdx.x == 0 && tid == PROBE_TID) { const unsigned want = MISC[20]; const unsigned long long t0 = wall_clock64(); while ((unsigned)(wall_clock64() - t0) < want) __builtin_amdgcn_s_sleep(8); }
#undef IN
#undef SEAM
}

extern "C" void kernel_launch(void* const* d_in, const int* in_sizes, int n_in, void* d_out, int out_size, void* d_ws, size_t ws_size, hipStream_t stream) {
    static int grid = 0;
    if (grid == 0) {
        if (n_in != 22 || out_size != NLAT * DM || ws_size < WS_END) { fprintf(stderr, "kernel_launch: unexpected shapes (n_in %d out %d ws %zu)\n", n_in, out_size, ws_size); grid = -1; return; }
        int dev = 0, cus = 0, per_cu = 0;
        if (hipGetDevice(&dev) != hipSuccess || hipDeviceGetAttribute(&cus, hipDeviceAttributeMultiprocessorCount, dev) != hipSuccess) { grid = -1; return; }
        if (hipFuncSetAttribute((const void*)mega_fwd, hipFuncAttributeMaxDynamicSharedMemorySize, LDS_BYTES) != hipSuccess) { fprintf(stderr, "kernel_launch: hipFuncSetAttribute failed\n"); grid = -1; return; }
        if (hipOccupancyMaxActiveBlocksPerMultiprocessor(&per_cu, (const void*)mega_fwd, 512, LDS_BYTES) != hipSuccess || per_cu < 1) { fprintf(stderr, "kernel_launch: occupancy query says %d\n", per_cu); per_cu = 1; }
        (void)hipGetLastError();
        grid = cus * 1;
    }
    if (grid < 0) return;
    (void)hipMemsetAsync((char*)d_ws + WS_CTL, 0, CTL_BYTES, stream);
    Params p{};
    p.x = (const float*)d_in[0]; p.c = (const float*)d_in[1]; p.ctx = (const float*)d_in[2]; p.c_ctx = (const float*)d_in[3]; p.ada_w = (const float*)d_in[4]; p.ada_b = (const float*)d_in[5];
    p.pre_g = (const float*)d_in[6]; p.post_g = (const float*)d_in[7]; p.w_in = (const float*)d_in[8]; p.w_out = (const float*)d_in[9];
    p.lq1 = (const float*)d_in[10]; p.lk1 = (const float*)d_in[11]; p.lq2 = (const float*)d_in[12]; p.lk2 = (const float*)d_in[13];
    p.da_g = (const float*)d_in[14]; p.rpb = (const float*)d_in[15]; p.na_g = (const float*)d_in[16]; p.ln_g = (const float*)d_in[17]; p.ln_b = (const float*)d_in[18];
    p.mws = (const float*)d_in[19]; p.mbs = (const float*)d_in[20]; p.mlp_g = (const float*)d_in[21];
    p.out = (float*)d_out; p.ws = (unsigned char*)d_ws;
#if MK_SINGLE
    p.ph_lo = 0; p.ph_hi = 10;
    { void* args[] = {&p}; hipError_t e = hipLaunchCooperativeKernel((const void*)mega_fwd, dim3(grid), dim3(512), args, LDS_BYTES, stream);
      if (e != hipSuccess) fprintf(stderr, "kernel_launch: cooperative launch failed: %s (grid %d)\n", hipGetErrorString(e), grid); }
#else
    for (int ph = 0; ph < 10; ++ph) { p.ph_lo = ph; p.ph_hi = ph + 1; void* args[] = {&p};
        hipError_t e = hipLaunchCooperativeKernel((const void*)mega_fwd, dim3(grid), dim3(512), args, LDS_BYTES, stream);
        if (e != hipSuccess) { fprintf(stderr, "kernel_launch: launch %d failed: %s (grid %d)\n", ph, hipGetErrorString(e), grid); break; } }
#endif
}
```

```cpp
#include <hip/hip_runtime.h>
#include <hip/hip_cooperative_groups.h>
#include <cstdio>
#include <cstdint>
namespace cg = cooperative_groups;
#ifndef UNIT_MASK
#define UNIT_MASK 31
#endif
#ifndef DUP_PHASE
#define DUP_PHASE -1
#endif
#ifndef DUP_UMASK
#define DUP_UMASK 31
#endif

#ifndef MK_SINGLE
#define MK_SINGLE 1
#endif

#define LAS __attribute__((address_space(3)))
typedef unsigned short bf16_t;
typedef short bf16x8 __attribute__((ext_vector_type(8)));
typedef short s16x4 __attribute__((ext_vector_type(4)));
typedef float f32x2 __attribute__((ext_vector_type(2)));
typedef float f32x4 __attribute__((ext_vector_type(4)));
typedef float f32x8 __attribute__((ext_vector_type(8)));
typedef float f32x16 __attribute__((ext_vector_type(16)));
typedef unsigned u32x2 __attribute__((ext_vector_type(2)));
typedef unsigned u32x4 __attribute__((ext_vector_type(4)));

constexpr int DM = 2048, NB = 4, SEQ = 4096, CTXL = 256, NLAT = NB * SEQ, NCTX = NB * CTXL, MROWS = NLAT + NCTX;
constexpr int INW = 7680, LDP = INW, HD = 128;
constexpr int C_AQ = 0, C_AK = 768, C_AV = 1536, C_AZ = 2304, C_NQ = 3072, C_NK = 3840, C_NV = 4608, C_NZ = 5376, C_MU = 6144, C_MV = 6656, C_MZ = 7168;
constexpr float EPS = 1e-6f;
constexpr float LOG2E = 1.4426950408889634f;

constexpr size_t MiB = 1u << 20;
constexpr size_t WS_CTL = 0, CTL_BYTES = 1 * MiB;
constexpr size_t CTL_QCTR = 256;
constexpr size_t CTL_MOD = 4096;
constexpr size_t CTL_ROWSS = 262144;
constexpr size_t CTL_BAR = 524288;
constexpr size_t WS_TAB = 1 * MiB;
constexpr size_t WS_WSB = 1 * MiB + 65536;
constexpr size_t WS_WIN = 2 * MiB;
constexpr size_t WS_WOUT = 62 * MiB;
constexpr size_t WS_H = 78 * MiB;
constexpr size_t WS_XC1 = 146 * MiB;
constexpr size_t WS_P = 154 * MiB;
constexpr size_t WS_Y0 = 409 * MiB;
constexpr size_t WS_END = 477 * MiB;

constexpr int LDS_BYTES = 147456;
constexpr int MISC_OFF = 139264;


#ifndef PROBE_T
#define PROBE_T 0
#endif
#ifndef PROBE_TID
#define PROBE_TID 0
#endif
#define TPROBE_BEGIN(k) unsigned long long _tp##k = 0; if (PROBE_T == (k) && blockIdx.x == 0 && threadIdx.x == PROBE_TID) { _tp##k = wall_clock64(); }
#define TPROBE_END(k) if (PROBE_T == (k) && blockIdx.x == 0 && threadIdx.x == PROBE_TID) { const unsigned _d = (unsigned)(wall_clock64() - _tp##k); volatile LAS unsigned* _m = (volatile LAS unsigned*)((LAS unsigned char*)0 + MISC_OFF); _m[20] = _m[20] + _d; }

struct Params {
    const float *x, *c, *ctx, *c_ctx, *ada_w, *ada_b, *pre_g, *post_g, *w_in, *w_out, *lq1, *lk1, *lq2, *lk2, *da_g, *rpb, *na_g, *ln_g, *ln_b, *mws, *mbs, *mlp_g;
    float* out; unsigned char* ws; int ph_lo, ph_hi;
};

__device__ __forceinline__ unsigned cvt_pk_bf16(float lo, float hi) { unsigned r; asm volatile("v_cvt_pk_bf16_f32 %0, %1, %2" : "=v"(r) : "v"(lo), "v"(hi)); return r; }
__device__ __forceinline__ float bf_lo(unsigned w) { return __uint_as_float(w << 16); }
__device__ __forceinline__ float bf_hi(unsigned w) { return __uint_as_float(w & 0xffff0000u); }
__device__ __forceinline__ float wave_sum(float v) {
#pragma unroll
    for (int o = 1; o < 64; o <<= 1) v += __shfl_xor(v, o);
    return v;
}
__device__ __forceinline__ float silu_f(float z) { return z * __builtin_amdgcn_rcpf(1.0f + __builtin_amdgcn_exp2f(-z * LOG2E)); }
__device__ __forceinline__ float gelu_tanh(float x) {
    const float u = 0.7978845608028654f * (x + 0.044715f * x * x * x);
    return x * __builtin_amdgcn_rcpf(1.0f + __builtin_amdgcn_exp2f(-2.0f * LOG2E * u));
}

namespace pg8 {
constexpr int BM = 256, BK = 64, HALF = 128, HTB = HALF * BK * 2, STAGE_BYTES = 8 * HTB, NXCD = 8, WGM = 8;
__host__ __device__ __forceinline__ int lds_byte(int r, int c) { const int st = (r >> 4) * 2 + (c >> 5), rr = r & 15, cc = c & 31, ob = rr * 64 + cc * 2; return st * 1024 + (ob ^ (((ob >> 9) & 1) << 5)); }
__host__ __device__ __forceinline__ void stage_rc(int b, int& R, int& C) { const int st = b / 1024, sb = b % 1024, swz = sb ^ (((sb >> 9) & 1) << 5); R = (st >> 1) * 16 + swz / 64; C = (st & 1) * 32 + (swz % 64) / 2; }
__host__ __device__ __forceinline__ int perm32(int rho) { const int n = rho >> 4, i = rho & 15; return 8 * (i >> 2) + 4 * n + (i & 3); }

struct Unit { int pm, pn; };
struct Gemm { const bf16_t* A; const bf16_t* Bt; int K; };

struct Sched {
    int nM, nN, nwg, G, c, extra;
    __device__ void init(int nM_, int nN_, int G_, int c_, int extra_) { nM = nM_; nN = nN_; nwg = nM * nN; G = G_; c = c_; extra = extra_; }
    __device__ bool next(int i, Unit& u) const {
        const long L = (long)i * G + c;
        if (L < nwg) {
            int wgid = (int)L; { const int q = nwg / NXCD, r = nwg % NXCD, xcd = wgid % NXCD, off = wgid / NXCD; wgid = (xcd < r ? xcd * (q + 1) : r * (q + 1) + (xcd - r) * q) + off; }
            const int nig = WGM * nN, gid = wgid / nig, fm = gid * WGM, gsz = (nM - fm) < WGM ? (nM - fm) : WGM;
            u.pm = fm + ((wgid % nig) % gsz); u.pn = (wgid % nig) / gsz; return true;
        }
        const int e = (int)(L - nwg); if (e >= extra) return false;
        const int t = e >> 2; u.pm = 64 + (e & 3); u.pn = t < 6 ? 3 + t : 9 + t; return true;
    }
};

template <class Epi>
__device__ __forceinline__ void gemm_phase(LAS unsigned char* lds, const Gemm g, const Sched& S, const Epi& E) {
    const int tid = threadIdx.x, wid = __builtin_amdgcn_readfirstlane(tid >> 6), lane = tid & 63, wr = wid >> 2, wc = wid & 3, fr = lane & 15, fq = lane >> 4;
    const int K = g.K, nt = K / BK;
    unsigned voffA[2], voffB[2];
#pragma unroll
    for (int i = 0; i < 2; ++i) { int R, C; stage_rc(tid * 16 + i * 8192, R, C); const int Rb = Epi::PERM ? ((R & ~31) + perm32(R & 31)) : R;
        voffA[i] = (unsigned)(R * K + C) * 2u; voffB[i] = (unsigned)(Rb * K + C) * 2u; }
    const size_t kstep = (size_t)(BK * 2);
    const size_t hstep = (size_t)HALF * K * 2;
    const size_t tstep = 2 * hstep;
    const unsigned ldsw = (unsigned)wid * 1024u;
    const int aoff = lds_byte(wr * 64 + fr, fq * 8), boff = lds_byte(wc * 32 + fr, fq * 8);
#define PG8_SA(b, h) (((b) * 2 + (h)) * HTB)
#define PG8_SB(b, h) ((4 + (b) * 2 + (h)) * HTB)
#define PG8_STAGE(bufoff, gbase, voff) do { _Pragma("unroll") for (int _i = 0; _i < 2; ++_i) \
        __builtin_amdgcn_global_load_lds((const unsigned*)((const char*)(gbase) + (voff)[_i]), (LAS unsigned*)(lds + (bufoff) + ldsw + _i * 8192), 16, 0, 0); } while (0)
#define PG8_LDA(dst, b, h) do { _Pragma("unroll") for (int m = 0; m < 4; ++m) _Pragma("unroll") for (int k = 0; k < 2; ++k) dst[m][k] = *(const LAS bf16x8*)(lds + PG8_SA(b, h) + aoff + m * 2048 + k * 1024); } while (0)
#define PG8_LDB(dst, b, h) do { _Pragma("unroll") for (int n = 0; n < 2; ++n) _Pragma("unroll") for (int k = 0; k < 2; ++k) dst[n][k] = *(const LAS bf16x8*)(lds + PG8_SB(b, h) + boff + n * 2048 + k * 1024); } while (0)
#define PG8_MMA(ai, bj, At, Bt) do { __builtin_amdgcn_s_setprio(1); _Pragma("unroll") for (int m = 0; m < 4; ++m) _Pragma("unroll") for (int n = 0; n < 2; ++n) _Pragma("unroll") for (int k = 0; k < 2; ++k) \
        acc[ai][bj][m][n] = __builtin_amdgcn_mfma_f32_16x16x32_bf16(Bt[n][k], At[m][k], acc[ai][bj][m][n], 0, 0, 0); __builtin_amdgcn_s_setprio(0); } while (0)
#define PG8_WAIT_V(n) asm volatile("s_waitcnt vmcnt(" #n ")" ::: "memory")
#define PG8_WAIT_L(n) asm volatile("s_waitcnt lgkmcnt(" #n ")" ::: "memory")
#define PG8_BAR __builtin_amdgcn_s_barrier()
#define PG8_SCHED __builtin_amdgcn_sched_barrier(0)
    Unit cur, nxt; int ui = 0;
    if (!S.next(0, cur)) return;
    f32x4 acc[2][2][4][2];
#pragma unroll
    for (int a = 0; a < 2; ++a)
#pragma unroll
        for (int b = 0; b < 2; ++b)
#pragma unroll
            for (int m = 0; m < 4; ++m)
#pragma unroll
                for (int n = 0; n < 2; ++n) acc[a][b][m][n] = (f32x4){0.f, 0.f, 0.f, 0.f};
    bf16x8 At[4][2], B0[2][2], B1[2][2];
    const char* cA = (const char*)g.A + (size_t)cur.pm * tstep; const char* cB = (const char*)g.Bt + (size_t)cur.pn * tstep;
    PG8_STAGE(PG8_SB(0, 0), cB, voffB); PG8_STAGE(PG8_SB(0, 1), cB + hstep, voffB); PG8_STAGE(PG8_SA(0, 0), cA, voffA); PG8_STAGE(PG8_SA(0, 1), cA + hstep, voffA);
    if (wr == 1) PG8_BAR;
    PG8_WAIT_V(2); PG8_BAR;
    PG8_STAGE(PG8_SB(1, 0), cB + kstep, voffB); PG8_STAGE(PG8_SA(1, 0), cA + kstep, voffA); PG8_STAGE(PG8_SB(1, 1), cB + hstep + kstep, voffB);
    PG8_WAIT_V(6); PG8_BAR;
    for (;;) {
        const bool has_next = S.next(ui + 1, nxt);
        const char* nA = has_next ? (const char*)g.A + (size_t)nxt.pm * tstep : cA; const char* nB = has_next ? (const char*)g.Bt + (size_t)nxt.pn * tstep : cB;
        for (int t = 0; t < nt; t += 2) {
            const bool last = (t == nt - 2);
            const char* a1 = cA + (size_t)(t + 1) * kstep;
            const char* a2 = last ? nA : cA + (size_t)(t + 2) * kstep; const char* b2 = last ? nB : cB + (size_t)(t + 2) * kstep;
            const char* a3 = a2 + kstep; const char* b3 = b2 + kstep;
            PG8_LDB(B0, 0, 0); PG8_LDB(B1, 0, 1); PG8_SCHED; PG8_LDA(At, 0, 0); PG8_STAGE(PG8_SA(1, 1), a1 + hstep, voffA);
            PG8_WAIT_V(8); PG8_WAIT_L(0); PG8_BAR; PG8_MMA(0, 0, At, B0); PG8_MMA(0, 1, At, B1); PG8_BAR; PG8_SCHED;
            PG8_LDA(At, 0, 1); PG8_STAGE(PG8_SB(0, 0), b2, voffB); PG8_STAGE(PG8_SB(0, 1), b2 + hstep, voffB); PG8_STAGE(PG8_SA(0, 0), a2, voffA);
            PG8_WAIT_V(8); PG8_WAIT_L(0); PG8_BAR; PG8_MMA(1, 0, At, B0); PG8_MMA(1, 1, At, B1); PG8_BAR; PG8_SCHED;
            PG8_LDB(B0, 1, 0); PG8_LDB(B1, 1, 1); PG8_SCHED; PG8_LDA(At, 1, 0); PG8_STAGE(PG8_SA(0, 1), a2 + hstep, voffA);
            PG8_WAIT_V(8); PG8_WAIT_L(0); PG8_BAR; PG8_MMA(0, 0, At, B0); PG8_MMA(0, 1, At, B1); PG8_BAR; PG8_SCHED;
            PG8_LDA(At, 1, 1); PG8_STAGE(PG8_SB(1, 0), b3, voffB); PG8_STAGE(PG8_SB(1, 1), b3 + hstep, voffB); PG8_STAGE(PG8_SA(1, 0), a3, voffA);
            PG8_WAIT_V(8); PG8_WAIT_L(0); PG8_BAR; PG8_MMA(1, 0, At, B0); PG8_MMA(1, 1, At, B1); PG8_BAR; PG8_SCHED;
        }
        if (wr == 0) PG8_BAR;
        E(acc, cur, wr, wc, fr, fq);
        if (!has_next) break;
#pragma unroll
        for (int a = 0; a < 2; ++a)
#pragma unroll
            for (int b = 0; b < 2; ++b)
#pragma unroll
                for (int m = 0; m < 4; ++m)
#pragma unroll
                    for (int n = 0; n < 2; ++n) acc[a][b][m][n] = (f32x4){0.f, 0.f, 0.f, 0.f};
        cur = nxt; cA = nA; cB = nB; ++ui;
        if (wr == 1) PG8_BAR;
    }
    PG8_WAIT_V(0);
    PG8_BAR;
#undef PG8_SA
#undef PG8_SB
#undef PG8_STAGE
#undef PG8_LDA
#undef PG8_LDB
#undef PG8_MMA
#undef PG8_WAIT_V
#undef PG8_WAIT_L
#undef PG8_BAR
#undef PG8_SCHED
}

struct Epi1 {
    static constexpr bool PERM = true;
    bf16_t* O; const float* cs; const float* sn;
    __device__ __forceinline__ void operator()(const f32x4 (&acc)[2][2][4][2], const Unit& u, int wr, int wc, int fr, int fq) const {
        const int row0 = u.pm * BM + wr * 64 + fr, col0 = u.pn * BM + wc * 32 + 8 * fq;
        const bool rope = (u.pn < 6) && (u.pm < 64), gelu = (u.pn >= 24) && (u.pn < 28);
        const float qs = (u.pn < 3) ? 0.125f * LOG2E : 1.0f;
        const float sgn = (fq < 2) ? -1.f : 1.f;
#pragma unroll
        for (int ai = 0; ai < 2; ++ai)
#pragma unroll
            for (int m = 0; m < 4; ++m) {
                const int row = row0 + ai * HALF + m * 16;
                bf16_t* rowp = O + (size_t)row * LDP + col0;
                f32x4 c0 = {1.f, 1.f, 1.f, 1.f}, c1 = c0, s0 = {0.f, 0.f, 0.f, 0.f}, s1 = s0;
                if (rope) { const int s = row & (SEQ - 1); const int pos = (wc & 1) ? (s & 63) : (s >> 6); const int ti = pos * 16 + 8 * (fq & 1);
                    c0 = *(const f32x4*)(cs + ti); c1 = *(const f32x4*)(cs + ti + 4); s0 = *(const f32x4*)(sn + ti); s1 = *(const f32x4*)(sn + ti + 4);
                    s0 = s0 * sgn; s1 = s1 * sgn; }
#pragma unroll
                for (int bj = 0; bj < 2; ++bj) { f32x4 v0 = acc[ai][bj][m][0], v1 = acc[ai][bj][m][1];
                    if (rope) { f32x4 q0, q1;
#pragma unroll
                        for (int e = 0; e < 4; ++e) { q0[e] = __shfl_xor(v0[e], 32); q1[e] = __shfl_xor(v1[e], 32); }
                        v0 = v0 * c0 + q0 * s0; v1 = v1 * c1 + q1 * s1; }
                    if (gelu) {
#pragma unroll
                        for (int e = 0; e < 4; ++e) { v0[e] = gelu_tanh(v0[e]); v1[e] = gelu_tanh(v1[e]); } }
                    v0 = v0 * qs; v1 = v1 * qs;
                    u32x4 w; w.x = cvt_pk_bf16(v0[0], v0[1]); w.y = cvt_pk_bf16(v0[2], v0[3]); w.z = cvt_pk_bf16(v1[0], v1[1]); w.w = cvt_pk_bf16(v1[2], v1[3]);
                    *(u32x4*)(rowp + bj * HALF) = w; } }
    }
};
struct Epi2 {
    static constexpr bool PERM = true;
    bf16_t* Yb; float* rowss;
    __device__ __forceinline__ void operator()(const f32x4 (&acc)[2][2][4][2], const Unit& u, int wr, int wc, int fr, int fq) const {
        const int row0 = u.pm * BM + wr * 64 + fr, col0 = u.pn * BM + wc * 32 + 8 * fq;
#pragma unroll
        for (int ai = 0; ai < 2; ++ai)
#pragma unroll
            for (int m = 0; m < 4; ++m) { const int row = row0 + ai * HALF + m * 16; bf16_t* rowp = Yb + (size_t)row * DM + col0; float ss = 0.f;
#pragma unroll
                for (int bj = 0; bj < 2; ++bj) { const f32x4 v0 = acc[ai][bj][m][0], v1 = acc[ai][bj][m][1];
                    ss += (v0[0] * v0[0] + v0[1] * v0[1]) + (v0[2] * v0[2] + v0[3] * v0[3]) + (v1[0] * v1[0] + v1[1] * v1[1]) + (v1[2] * v1[2] + v1[3] * v1[3]);
                    u32x4 w; w.x = cvt_pk_bf16(v0[0], v0[1]); w.y = cvt_pk_bf16(v0[2], v0[3]); w.z = cvt_pk_bf16(v1[0], v1[1]); w.w = cvt_pk_bf16(v1[2], v1[3]);
                    *(u32x4*)(rowp + bj * HALF) = w; }
                ss += __shfl_xor(ss, 16); ss += __shfl_xor(ss, 32);
                if (fq == 0) atomicAdd(rowss + row, ss); }
    }
};
}

namespace att {
constexpr int SHM_V = 64 * 128 * 2, SHM_K = 64 * 128 * 2;
constexpr int WSF_OFF = 2 * SHM_V + 2 * SHM_K;
constexpr int BIAS_OFF = WSF_OFF + 2048;
constexpr int XS = 132;
constexpr float THR = 8.f;
#define KSWZ(row, colB) ((row) * 256 + ((colB) ^ (((row) & 15) << 4)))
#define SBAR() __builtin_amdgcn_sched_barrier(0)
__device__ __forceinline__ int crow(int r, int hi) { return (r & 3) + 8 * (r >> 2) + 4 * hi; }
__device__ __forceinline__ bf16x8 ld8(const bf16_t* p) { return *reinterpret_cast<const bf16x8*>(p); }

template <int MODE> struct ModeC { static constexpr float SC = (MODE == 0) ? 0.125f : 0.08838834764831845f; };

template <int MODE>
__device__ __forceinline__ void partialSM(f32x16& p0, f32x16& p1, float& m_reg, float& mn, float& alpha) {
    constexpr float C = ModeC<MODE>::SC * LOG2E;
    float pmax = p0[0];
#pragma unroll
    for (int r = 1; r < 16; ++r) pmax = fmaxf(pmax, p0[r]);
#pragma unroll
    for (int r = 0; r < 16; ++r) pmax = fmaxf(pmax, p1[r]);
    { auto rr = __builtin_amdgcn_permlane32_swap(__float_as_uint(pmax), __float_as_uint(pmax), false, false);
      pmax = fmaxf(__uint_as_float(rr[0]), __uint_as_float(rr[1])); }
    if (__builtin_expect(__all(pmax - m_reg <= THR / ModeC<MODE>::SC), 1)) { mn = m_reg; alpha = 1.f; }
    else { mn = fmaxf(m_reg, pmax); alpha = __builtin_amdgcn_exp2f((m_reg - mn) * C); m_reg = mn; }
    const float mnC = -mn * C;
#pragma unroll
    for (int r = 0; r < 16; ++r) p0[r] = fmaf(p0[r], C, mnC);
#pragma unroll
    for (int r = 0; r < 16; ++r) p1[r] = fmaf(p1[r], C, mnC);
#pragma unroll
    for (int r = 0; r < 16; ++r) p0[r] = __builtin_amdgcn_exp2f(p0[r]);
}
__device__ __forceinline__ void finishSM(f32x16& p0, f32x16& p1, float alpha, float& l_reg, bf16x8& pa0, bf16x8& pa1, bf16x8& pa2, bf16x8& pa3) {
#pragma unroll
    for (int r = 0; r < 16; ++r) p1[r] = __builtin_amdgcn_exp2f(p1[r]);
    float ps = 0;
#pragma unroll
    for (int r = 0; r < 16; ++r) ps += p0[r];
#pragma unroll
    for (int r = 0; r < 16; ++r) ps += p1[r];
    { auto rr = __builtin_amdgcn_permlane32_swap(__float_as_uint(ps), __float_as_uint(ps), false, false);
      ps = __uint_as_float(rr[0]) + __uint_as_float(rr[1]); }
    l_reg = l_reg * alpha + ps;
#define PK4(P, BASE, OUT) do { unsigned a0 = cvt_pk_bf16(P[BASE + 0], P[BASE + 1]), a1 = cvt_pk_bf16(P[BASE + 2], P[BASE + 3]);   \
    unsigned b0 = cvt_pk_bf16(P[BASE + 4], P[BASE + 5]), b1 = cvt_pk_bf16(P[BASE + 6], P[BASE + 7]);                              \
    auto r0 = __builtin_amdgcn_permlane32_swap(a0, b0, false, false); auto r1 = __builtin_amdgcn_permlane32_swap(a1, b1, false, false); \
    u32x4 w = {r0[0], r1[0], r0[1], r1[1]}; OUT = *reinterpret_cast<bf16x8*>(&w); } while (0)
    PK4(p0, 0, pa0); PK4(p0, 8, pa1); PK4(p1, 0, pa2); PK4(p1, 8, pa3);
#undef PK4
}
template <int MODE>
__device__ __forceinline__ void sm_max(const f32x16& p0, const f32x16& p1, float& m_reg, float& mnC, float& alpha) {
    constexpr float C = ModeC<MODE>::SC * LOG2E;
    float pmax = p0[0];
#pragma unroll
    for (int r = 1; r < 16; ++r) pmax = fmaxf(pmax, p0[r]);
#pragma unroll
    for (int r = 0; r < 16; ++r) pmax = fmaxf(pmax, p1[r]);
    { auto rr = __builtin_amdgcn_permlane32_swap(__float_as_uint(pmax), __float_as_uint(pmax), false, false);
      pmax = fmaxf(__uint_as_float(rr[0]), __uint_as_float(rr[1])); }
    const bool keep = __all(pmax - m_reg <= THR / ModeC<MODE>::SC);
    const float mn = keep ? m_reg : fmaxf(m_reg, pmax);
    alpha = __builtin_amdgcn_exp2f((m_reg - mn) * C);
    m_reg = mn; mnC = -mn * C;
}
template <int MODE>
__device__ __forceinline__ void sm_scale(f32x16& p, float mnC) {
    constexpr float C = ModeC<MODE>::SC * LOG2E;
#pragma unroll
    for (int r = 0; r < 16; ++r) p[r] = fmaf(p[r], C, mnC);
}
__device__ __forceinline__ void sm_exp(f32x16& p) {
#pragma unroll
    for (int r = 0; r < 16; ++r) p[r] = __builtin_amdgcn_exp2f(p[r]);
}
__device__ __forceinline__ void sm_finish(f32x16& p0, f32x16& p1, float alpha, float& l_reg, bf16x8& pa0, bf16x8& pa1, bf16x8& pa2, bf16x8& pa3) {
    float ps = 0;
#pragma unroll
    for (int r = 0; r < 16; ++r) ps += p0[r];
#pragma unroll
    for (int r = 0; r < 16; ++r) ps += p1[r];
    { auto rr = __builtin_amdgcn_permlane32_swap(__float_as_uint(ps), __float_as_uint(ps), false, false);
      ps = __uint_as_float(rr[0]) + __uint_as_float(rr[1]); }
    l_reg = l_reg * alpha + ps;
#define PK4(P, BASE, OUT) do { unsigned a0 = cvt_pk_bf16(P[BASE + 0], P[BASE + 1]), a1 = cvt_pk_bf16(P[BASE + 2], P[BASE + 3]);   \
    unsigned b0 = cvt_pk_bf16(P[BASE + 4], P[BASE + 5]), b1 = cvt_pk_bf16(P[BASE + 6], P[BASE + 7]);                              \
    auto r0 = __builtin_amdgcn_permlane32_swap(a0, b0, false, false); auto r1 = __builtin_amdgcn_permlane32_swap(a1, b1, false, false); \
    u32x4 w = {r0[0], r1[0], r0[1], r1[1]}; OUT = *reinterpret_cast<bf16x8*>(&w); } while (0)
    PK4(p0, 0, pa0); PK4(p0, 8, pa1); PK4(p1, 0, pa2); PK4(p1, 8, pa3);
#undef PK4
}
template <int ND0>
__device__ __forceinline__ void qkt(f32x16& p0, f32x16& p1, const LAS char* Ks, const bf16x8* qr, int r32, int hi, int dbase) {
    p0 = f32x16{}; p1 = f32x16{};
#pragma unroll
    for (int d0 = 0; d0 < ND0; ++d0) { const int cb = ((dbase + d0) * 16 + hi * 8) * 2;
        const bf16x8 b0 = *reinterpret_cast<const LAS bf16x8*>(Ks + KSWZ(r32, cb));
        const bf16x8 b1 = *reinterpret_cast<const LAS bf16x8*>(Ks + KSWZ(32 + r32, cb));
        p0 = __builtin_amdgcn_mfma_f32_32x32x16_bf16(b0, qr[d0], p0, 0, 0, 0);
        p1 = __builtin_amdgcn_mfma_f32_32x32x16_bf16(b1, qr[d0], p1, 0, 0, 0); }
}
__device__ __forceinline__ int v_st(int k, int c) { const int kk = (k & ~0xC) | ((k & 4) << 1) | ((k & 8) >> 1); return ((kk >> 3) * 4 + (c >> 5)) * 512 + ((kk & 7) * 32 + (c & 31)) * 2; }
__device__ __forceinline__ int v_rd_base(int lane) { return ((lane & 3) << 3) | (((lane >> 2) & 3) << 6) | (((lane >> 4) & 1) << 5) | (((lane >> 5) & 1) << 8); }
constexpr int v_rd_off(int d0, int ks, int half) { return d0 * 512 + ks * 4096 + half * 2048; }
template <int OFF> __device__ __forceinline__ s16x4 tr_read(int vb) {
    s16x4 r; asm volatile("ds_read_b64_tr_b16 %0, %1 offset:%2" : "=&v"(r) : "v"(vb), "i"(OFF) : "memory"); return r;
}
template <int D0> __device__ __forceinline__ void pv_one(f32x16& od, int vb, bf16x8 pa0, bf16x8 pa1, bf16x8 pa2, bf16x8 pa3) {
    const s16x4 l0 = tr_read<v_rd_off(D0, 0, 0)>(vb), h0 = tr_read<v_rd_off(D0, 0, 1)>(vb), l1 = tr_read<v_rd_off(D0, 1, 0)>(vb), h1 = tr_read<v_rd_off(D0, 1, 1)>(vb);
    const s16x4 l2 = tr_read<v_rd_off(D0, 2, 0)>(vb), h2 = tr_read<v_rd_off(D0, 2, 1)>(vb), l3 = tr_read<v_rd_off(D0, 3, 0)>(vb), h3 = tr_read<v_rd_off(D0, 3, 1)>(vb);
    asm volatile("s_waitcnt lgkmcnt(0)" ::: "memory"); SBAR();
#define PKV(L, H) (bf16x8){L[0], L[1], L[2], L[3], H[0], H[1], H[2], H[3]}
    od = __builtin_amdgcn_mfma_f32_32x32x16_bf16(pa0, PKV(l0, h0), od, 0, 0, 0);
    od = __builtin_amdgcn_mfma_f32_32x32x16_bf16(pa1, PKV(l1, h1), od, 0, 0, 0);
    od = __builtin_amdgcn_mfma_f32_32x32x16_bf16(pa2, PKV(l2, h2), od, 0, 0, 0);
    od = __builtin_amdgcn_mfma_f32_32x32x16_bf16(pa3, PKV(l3, h3), od, 0, 0, 0);
#undef PKV
}
__device__ __forceinline__ void pv_d0(f32x16* o, int vb, bf16x8 pa0, bf16x8 pa1, bf16x8 pa2, bf16x8 pa3) {
    pv_one<0>(o[0], vb, pa0, pa1, pa2, pa3); pv_one<1>(o[1], vb, pa0, pa1, pa2, pa3); pv_one<2>(o[2], vb, pa0, pa1, pa2, pa3); pv_one<3>(o[3], vb, pa0, pa1, pa2, pa3);
}

template <int KS> __device__ __forceinline__ void pv_ks(f32x16* o, int vb, bf16x8 pa) {
    const s16x4 l0 = tr_read<v_rd_off(0, KS, 0)>(vb), h0 = tr_read<v_rd_off(0, KS, 1)>(vb), l1 = tr_read<v_rd_off(1, KS, 0)>(vb), h1 = tr_read<v_rd_off(1, KS, 1)>(vb);
    const s16x4 l2 = tr_read<v_rd_off(2, KS, 0)>(vb), h2 = tr_read<v_rd_off(2, KS, 1)>(vb), l3 = tr_read<v_rd_off(3, KS, 0)>(vb), h3 = tr_read<v_rd_off(3, KS, 1)>(vb);
#if defined(PROBE_DUPTR)
    { s16x4 d0_ = tr_read<v_rd_off(0, KS, 0)>(vb), d1_ = tr_read<v_rd_off(0, KS, 1)>(vb), d2_ = tr_read<v_rd_off(1, KS, 0)>(vb), d3_ = tr_read<v_rd_off(1, KS, 1)>(vb);
      s16x4 d4_ = tr_read<v_rd_off(2, KS, 0)>(vb), d5_ = tr_read<v_rd_off(2, KS, 1)>(vb), d6_ = tr_read<v_rd_off(3, KS, 0)>(vb), d7_ = tr_read<v_rd_off(3, KS, 1)>(vb);
      asm volatile("" :: "v"(d0_), "v"(d1_), "v"(d2_), "v"(d3_), "v"(d4_), "v"(d5_), "v"(d6_), "v"(d7_)); }
#endif
    asm volatile("s_waitcnt lgkmcnt(0)" ::: "memory"); SBAR();
#define PKV(L, H) (bf16x8){L[0], L[1], L[2], L[3], H[0], H[1], H[2], H[3]}
    o[0] = __builtin_amdgcn_mfma_f32_32x32x16_bf16(pa, PKV(l0, h0), o[0], 0, 0, 0);
    o[1] = __builtin_amdgcn_mfma_f32_32x32x16_bf16(pa, PKV(l1, h1), o[1], 0, 0, 0);
    o[2] = __builtin_amdgcn_mfma_f32_32x32x16_bf16(pa, PKV(l2, h2), o[2], 0, 0, 0);
    o[3] = __builtin_amdgcn_mfma_f32_32x32x16_bf16(pa, PKV(l3, h3), o[3], 0, 0, 0);
#undef PKV
}
__device__ __forceinline__ void pv_k4(f32x16* o, int vb, bf16x8 pa0, bf16x8 pa1, bf16x8 pa2, bf16x8 pa3) {
    pv_ks<0>(o, vb, pa0); pv_ks<1>(o, vb, pa1); pv_ks<2>(o, vb, pa2); pv_ks<3>(o, vb, pa3);
}

template <bool MLP>
__device__ __forceinline__ void final_pass(const LAS float* X, int nrows, const bf16_t* Z, bf16_t* Y, const float* g, float factor, const bf16_t* U, const float* rowb) {
    int t_ = threadIdx.x; asm volatile("" : "+v"(t_));
    for (int idx = t_; idx < nrows * 4; idx += 512) {
        const int row = idx >> 2, seg = idx & 3;
        f32x4 x[8];
#pragma unroll
        for (int i = 0; i < 8; ++i) x[i] = *reinterpret_cast<const LAS f32x4*>(X + row * XS + seg * 32 + 4 * i);
        if (MLP) { const float rb = rowb[row]; const u32x4* up = reinterpret_cast<const u32x4*>(U + (size_t)row * LDP + seg * 32);
#pragma unroll
            for (int i = 0; i < 4; ++i) { const u32x4 w = up[i];
                x[2 * i][0] = (x[2 * i][0] + rb) * bf_lo(w.x); x[2 * i][1] = (x[2 * i][1] + rb) * bf_hi(w.x); x[2 * i][2] = (x[2 * i][2] + rb) * bf_lo(w.y); x[2 * i][3] = (x[2 * i][3] + rb) * bf_hi(w.y);
                x[2 * i + 1][0] = (x[2 * i + 1][0] + rb) * bf_lo(w.z); x[2 * i + 1][1] = (x[2 * i + 1][1] + rb) * bf_hi(w.z); x[2 * i + 1][2] = (x[2 * i + 1][2] + rb) * bf_lo(w.w); x[2 * i + 1][3] = (x[2 * i + 1][3] + rb) * bf_hi(w.w); } }
        float ss = 0.f;
#pragma unroll
        for (int i = 0; i < 8; ++i) ss += (x[i][0] * x[i][0] + x[i][1] * x[i][1]) + (x[i][2] * x[i][2] + x[i][3] * x[i][3]);
        ss += __shfl_xor(ss, 1); ss += __shfl_xor(ss, 2);
        const float rstd = __builtin_amdgcn_rsqf(ss * (1.0f / 128.0f) + EPS) * factor;
        const u32x4* zp = reinterpret_cast<const u32x4*>(Z + (size_t)row * LDP + seg * 32);
        const f32x4* gp = reinterpret_cast<const f32x4*>(g + seg * 32);
        u32x4* yp = reinterpret_cast<u32x4*>(Y + (size_t)row * DM + seg * 32);
#pragma unroll
        for (int i = 0; i < 4; ++i) { const u32x4 w = zp[i]; const f32x4 g0 = gp[2 * i], g1 = gp[2 * i + 1]; const f32x4 a = x[2 * i], b = x[2 * i + 1];
            u32x4 o;
            o.x = cvt_pk_bf16(a[0] * rstd * g0[0] * silu_f(bf_lo(w.x)), a[1] * rstd * g0[1] * silu_f(bf_hi(w.x)));
            o.y = cvt_pk_bf16(a[2] * rstd * g0[2] * silu_f(bf_lo(w.y)), a[3] * rstd * g0[3] * silu_f(bf_hi(w.y)));
            o.z = cvt_pk_bf16(b[0] * rstd * g1[0] * silu_f(bf_lo(w.z)), b[1] * rstd * g1[1] * silu_f(bf_hi(w.z)));
            o.w = cvt_pk_bf16(b[2] * rstd * g1[2] * silu_f(bf_lo(w.w)), b[3] * rstd * g1[3] * silu_f(bf_hi(w.w)));
            yp[i] = o; }
    }
}

struct AttnArgs {
    const bf16_t* Q;
    const bf16_t *K1, *K2, *V1, *V2;
    int n1, n2, NT;
    int R0, kfirst;
    const float* rpb;
    const bf16_t* Z; bf16_t* Y; const float* g; float factor, lam;
};
template <int MODE>
__device__ __forceinline__ void attn_epilogue(LAS char* lds, const AttnArgs& a, f32x16 (&o)[4], float l_reg, LAS float* li_l, int map, int qg, int r32, int hi) {
    if (hi == 0) li_l[r32] = l_reg; asm volatile("s_waitcnt lgkmcnt(0)" ::: "memory");
    float rli[16];
#pragma unroll
    for (int r = 0; r < 16; ++r) rli[r] = __builtin_amdgcn_rcpf(li_l[crow(r, hi)]);
    __syncthreads();
    LAS float* X = (LAS float*)lds;
    if (MODE != 0 || map == 0) {
#pragma unroll
        for (int r = 0; r < 16; ++r)
#pragma unroll
            for (int d0 = 0; d0 < 4; ++d0) X[(qg * 32 + crow(r, hi)) * XS + d0 * 32 + r32] = o[d0][r] * rli[r];
    }
    __syncthreads();
    if (MODE == 0) {
        if (map == 1) {
#pragma unroll
            for (int r = 0; r < 16; ++r)
#pragma unroll
                for (int d0 = 0; d0 < 4; ++d0) { LAS float* xp = X + (qg * 32 + crow(r, hi)) * XS + d0 * 32 + r32; *xp = *xp - a.lam * (o[d0][r] * rli[r]); }
        }
        __syncthreads();
    }
    final_pass<false>(X, (MODE == 0) ? 128 : 256, a.Z, a.Y, a.g, a.factor, nullptr, nullptr);
    __syncthreads();
}
constexpr int V3_OFF = 0, K3_OFF = 3 * SHM_V, WSF3_OFF = 3 * SHM_V + 3 * SHM_K;
constexpr float THRL = 10.f;
__device__ __forceinline__ void qkt_c(f32x16& p0, f32x16& p1, const LAS char* Ks, const bf16x8* qr, const f32x16& negm, int r32, int hi, int dbase) {
#pragma unroll
    for (int d0 = 0; d0 < 4; ++d0) { const int cb = ((dbase + d0) * 16 + hi * 8) * 2;
        const bf16x8 b0 = *reinterpret_cast<const LAS bf16x8*>(Ks + KSWZ(r32, cb));
        const bf16x8 b1 = *reinterpret_cast<const LAS bf16x8*>(Ks + KSWZ(32 + r32, cb));
        if (d0 == 0) { p0 = __builtin_amdgcn_mfma_f32_32x32x16_bf16(b0, qr[0], negm, 0, 0, 0); p1 = __builtin_amdgcn_mfma_f32_32x32x16_bf16(b1, qr[0], negm, 0, 0, 0); }
        else { p0 = __builtin_amdgcn_mfma_f32_32x32x16_bf16(b0, qr[d0], p0, 0, 0, 0); p1 = __builtin_amdgcn_mfma_f32_32x32x16_bf16(b1, qr[d0], p1, 0, 0, 0); } }
}
__device__ __forceinline__ bf16x8 lds_rd128(int addr) { bf16x8 r; asm volatile("ds_read_b128 %0, %1" : "=&v"(r) : "v"(addr) : "memory"); return r; }
__device__ __forceinline__ bf16x8 lds_rd128_hi(int addr) { bf16x8 r; asm volatile("ds_read_b128 %0, %1 offset:8192" : "=&v"(r) : "v"(addr) : "memory"); return r; }
__device__ __forceinline__ void qkt_cb(f32x16& p0, f32x16& p1, const int (&ka)[4], const bf16x8* qr, const f32x16& negm) {
    const bf16x8 a0 = lds_rd128(ka[0]), b0 = lds_rd128_hi(ka[0]), a1 = lds_rd128(ka[1]), b1 = lds_rd128_hi(ka[1]);
    const bf16x8 a2 = lds_rd128(ka[2]), b2 = lds_rd128_hi(ka[2]), a3 = lds_rd128(ka[3]), b3 = lds_rd128_hi(ka[3]);
    asm volatile("s_waitcnt lgkmcnt(6)" ::: "memory"); SBAR();
    p0 = __builtin_amdgcn_mfma_f32_32x32x16_bf16(a0, qr[0], negm, 0, 0, 0); p1 = __builtin_amdgcn_mfma_f32_32x32x16_bf16(b0, qr[0], negm, 0, 0, 0);
    asm volatile("s_waitcnt lgkmcnt(4)" ::: "memory"); SBAR();
    p0 = __builtin_amdgcn_mfma_f32_32x32x16_bf16(a1, qr[1], p0, 0, 0, 0); p1 = __builtin_amdgcn_mfma_f32_32x32x16_bf16(b1, qr[1], p1, 0, 0, 0);
    asm volatile("s_waitcnt lgkmcnt(2)" ::: "memory"); SBAR();
    p0 = __builtin_amdgcn_mfma_f32_32x32x16_bf16(a2, qr[2], p0, 0, 0, 0); p1 = __builtin_amdgcn_mfma_f32_32x32x16_bf16(b2, qr[2], p1, 0, 0, 0);
    asm volatile("s_waitcnt lgkmcnt(0)" ::: "memory"); SBAR();
    p0 = __builtin_amdgcn_mfma_f32_32x32x16_bf16(a3, qr[3], p0, 0, 0, 0); p1 = __builtin_amdgcn_mfma_f32_32x32x16_bf16(b3, qr[3], p1, 0, 0, 0);
}
struct VSet { s16x4 l0, h0, l1, h1, l2, h2, l3, h3; };
template <int KS> __device__ __forceinline__ void tr_group(VSet& s, int vb) {
    s.l0 = tr_read<v_rd_off(0, KS, 0)>(vb); s.h0 = tr_read<v_rd_off(0, KS, 1)>(vb); s.l1 = tr_read<v_rd_off(1, KS, 0)>(vb); s.h1 = tr_read<v_rd_off(1, KS, 1)>(vb);
    s.l2 = tr_read<v_rd_off(2, KS, 0)>(vb); s.h2 = tr_read<v_rd_off(2, KS, 1)>(vb); s.l3 = tr_read<v_rd_off(3, KS, 0)>(vb); s.h3 = tr_read<v_rd_off(3, KS, 1)>(vb);
}
__device__ __forceinline__ void mm_group(f32x16* o, bf16x8 pa, const VSet& s) {
#define PKV(L, H) (bf16x8){L[0], L[1], L[2], L[3], H[0], H[1], H[2], H[3]}
    o[0] = __builtin_amdgcn_mfma_f32_32x32x16_bf16(pa, PKV(s.l0, s.h0), o[0], 0, 0, 0);
    o[1] = __builtin_amdgcn_mfma_f32_32x32x16_bf16(pa, PKV(s.l1, s.h1), o[1], 0, 0, 0);
    o[2] = __builtin_amdgcn_mfma_f32_32x32x16_bf16(pa, PKV(s.l2, s.h2), o[2], 0, 0, 0);
    o[3] = __builtin_amdgcn_mfma_f32_32x32x16_bf16(pa, PKV(s.l3, s.h3), o[3], 0, 0, 0);
#undef PKV
}
#define LWAIT(n) do { asm volatile("s_waitcnt lgkmcnt(" #n ")" ::: "memory"); SBAR(); } while (0)
__device__ __forceinline__ void segm_body(f32x16& p0, f32x16& p1, f32x16* o, const int (&ka)[4], int vb, const bf16x8* qr, const f32x16& negm, bf16x8 pa0, bf16x8 pa1, bf16x8 pa2, bf16x8 pa3) {
    const bf16x8 a0 = lds_rd128(ka[0]), b0 = lds_rd128_hi(ka[0]), a1 = lds_rd128(ka[1]), b1 = lds_rd128_hi(ka[1]);
    const bf16x8 a2 = lds_rd128(ka[2]), b2 = lds_rd128_hi(ka[2]), a3 = lds_rd128(ka[3]), b3 = lds_rd128_hi(ka[3]);
    VSet sa, sb;
    tr_group<0>(sa, vb);
    LWAIT(14);
    p0 = __builtin_amdgcn_mfma_f32_32x32x16_bf16(a0, qr[0], negm, 0, 0, 0); p1 = __builtin_amdgcn_mfma_f32_32x32x16_bf16(b0, qr[0], negm, 0, 0, 0);
    LWAIT(12);
    p0 = __builtin_amdgcn_mfma_f32_32x32x16_bf16(a1, qr[1], p0, 0, 0, 0); p1 = __builtin_amdgcn_mfma_f32_32x32x16_bf16(b1, qr[1], p1, 0, 0, 0);
    LWAIT(10);
    p0 = __builtin_amdgcn_mfma_f32_32x32x16_bf16(a2, qr[2], p0, 0, 0, 0); p1 = __builtin_amdgcn_mfma_f32_32x32x16_bf16(b2, qr[2], p1, 0, 0, 0);
    LWAIT(8);
    p0 = __builtin_amdgcn_mfma_f32_32x32x16_bf16(a3, qr[3], p0, 0, 0, 0); p1 = __builtin_amdgcn_mfma_f32_32x32x16_bf16(b3, qr[3], p1, 0, 0, 0);
    tr_group<1>(sb, vb);
    LWAIT(8);
    mm_group(o, pa0, sa);
    tr_group<2>(sa, vb);
    LWAIT(8);
    mm_group(o, pa1, sb);
    tr_group<3>(sb, vb);
    LWAIT(8);
    mm_group(o, pa2, sa);
    LWAIT(0);
    mm_group(o, pa3, sb);
}
constexpr int V4_OFF = 0, K4_OFF = 4 * SHM_V, WSF4_OFF = 4 * SHM_V + 4 * SHM_K;
__device__ __forceinline__ void diff_unit(LAS char* lds, const AttnArgs& a) {
    int tid_ = threadIdx.x; asm volatile("" : "+v"(tid_));
    const int tid = tid_, wid = __builtin_amdgcn_readfirstlane(tid >> 6), lane = tid & 63, r32 = lane & 31, hi = lane >> 5;
    const int half = wid >> 2, map = wid >> 2, qg = wid & 3;
    LAS char* V_lds = lds + V4_OFF; LAS char* K_lds = lds + K4_OFF;
    LAS float* wsf = (LAS float*)(lds + WSF4_OFF) + wid * 64; LAS float* li_l = wsf; LAS float* al_l = wsf + 32;
    float mref = 0.f, l_reg = 0; f32x16 o[4] = {}; bf16x8 qr[4]; f32x16 negm = {};
    const bf16_t* Qw = a.Q + (size_t)(qg * 32 + r32) * LDP + map * 64 + hi * 8;
#pragma unroll
    for (int d0 = 0; d0 < 4; ++d0) qr[d0] = ld8(Qw + d0 * 16);
    unsigned gok[2], gov[2];
#pragma unroll
    for (int i = 0; i < 2; ++i) { const int pc = 2 * wid + i;
        const int r = 4 * pc + (lane >> 4), c = (lane & 15) ^ (r & 15); gok[i] = (unsigned)(r * LDP + c * 8) * 2u;
        const int sidx = 2 * pc + (lane >> 5), kk = 8 * (sidx >> 2) + ((lane & 31) >> 2), key = (kk & ~0xC) | ((kk & 4) << 1) | ((kk & 8) >> 1), col = 32 * (sidx & 3) + (lane & 3) * 8;
        gov[i] = (unsigned)(key * LDP + col) * 2u; }
    const int vb0 = (int)(uintptr_t)V_lds + v_rd_base(lane);
    int kb_[4];
#pragma unroll
    for (int d0 = 0; d0 < 4; ++d0) kb_[d0] = (int)(uintptr_t)K_lds + KSWZ(r32, ((map * 4 + d0) * 16 + hi * 8) * 2);
    const int n1 = a.n1, n2 = a.n2, NT = a.NT;
#define DMA_TILE(j, so) do { const int _j = (j); const int _j2 = min(_j - n1, n2 - 1); \
    const char* _Kt = (const char*)((_j < n1) ? a.K1 + (size_t)_j * 64 * LDP : a.K2 + (size_t)_j2 * 64 * LDP); \
    const char* _Vt = (const char*)((_j < n1) ? a.V1 + (size_t)_j * 64 * LDP : a.V2 + (size_t)_j2 * 64 * LDP); \
    LAS char* _kd = K_lds + (so) + wid * 2048; LAS char* _vd = V_lds + (so) + wid * 2048; \
    __builtin_amdgcn_global_load_lds((const unsigned*)(_Kt + gok[0]), (LAS unsigned*)(_kd), 16, 0, 0); \
    __builtin_amdgcn_global_load_lds((const unsigned*)(_Kt + gok[1]), (LAS unsigned*)(_kd + 1024), 16, 0, 0); \
    __builtin_amdgcn_global_load_lds((const unsigned*)(_Vt + gov[0]), (LAS unsigned*)(_vd), 16, 0, 0); \
    __builtin_amdgcn_global_load_lds((const unsigned*)(_Vt + gov[1]), (LAS unsigned*)(_vd + 1024), 16, 0, 0); } while (0)
#define VWAIT(n) asm volatile("s_waitcnt vmcnt(" #n ")" ::: "memory")
#define BAR() do { SBAR(); asm volatile("s_waitcnt lgkmcnt(0)" ::: "memory"); __builtin_amdgcn_s_barrier(); SBAR(); } while (0)
#define PIN(X) asm volatile("" : "+v"(X))
#define ROT4(s) ((s) == 3 * SHM_V ? 0 : (s) + SHM_V)
#define SEGV(X0, X1, t) do { \
    float rm = X0[0]; \
    _Pragma("unroll") for (int r = 1; r < 16; ++r) rm = fmaxf(rm, X0[r]); \
    _Pragma("unroll") for (int r = 0; r < 16; ++r) rm = fmaxf(rm, X1[r]); \
    { auto rr = __builtin_amdgcn_permlane32_swap(__float_as_uint(rm), __float_as_uint(rm), false, false); rm = fmaxf(__uint_as_float(rr[0]), __uint_as_float(rr[1])); } \
    if (__builtin_expect((t) == 0 || __any(rm > THRL), 0)) { const float dl = ((t) == 0) ? rm : fmaxf(rm, 0.f); mref += dl; \
        _Pragma("unroll") for (int r = 0; r < 16; ++r) { X0[r] -= dl; X1[r] -= dl; } \
        _Pragma("unroll") for (int r = 0; r < 16; ++r) negm[r] = -mref; \
        const float f = __builtin_amdgcn_exp2f(-dl); l_reg *= f; if (hi == 0) al_l[r32] = f; asm volatile("s_waitcnt lgkmcnt(0)" ::: "memory"); \
        _Pragma("unroll") for (int d = 0; d < 4; ++d) _Pragma("unroll") for (int r = 0; r < 16; ++r) o[d][r] *= al_l[crow(r, hi)]; } \
    sm_exp(X0); sm_exp(X1); \
    sm_finish(X0, X1, 1.0f, l_reg, pa0, pa1, pa2, pa3); \
    PIN(pa0); PIN(pa1); PIN(pa2); PIN(pa3); \
    if ((t) + 2 + half < NT) { DMA_TILE((t) + 2 + half, s_w); VWAIT(4); } else { VWAIT(0); } \
    s_w = ROT4(s_w); } while (0)
#define SEGM(X0, X1, t) do { \
    { int ka_[4]; _Pragma("unroll") for (int d0 = 0; d0 < 4; ++d0) ka_[d0] = kb_[d0] + s_k; segm_body(X0, X1, o, ka_, vb0 + s_v, qr, negm, pa0, pa1, pa2, pa3); }     \
    s_v = s_k; s_k = ROT4(s_k); } while (0)
    f32x16 pA0, pA1; bf16x8 pa0, pa1, pa2, pa3;
    DMA_TILE(0, 0);
    if (half) { DMA_TILE(1, SHM_V); }
    DMA_TILE(1 + half, (1 + half) * SHM_V);
    VWAIT(4);
    BAR();
    qkt_c(pA0, pA1, K_lds, qr, negm, r32, hi, map * 4);
    if (half) { __builtin_amdgcn_s_setprio(1); BAR(); }
    int s_w = (2 + half) * SHM_V;
    int s_v = 0, s_k = SHM_V;
    for (int t = 0; t < NT; ++t) {
        { TPROBE_BEGIN(3); SEGV(pA0, pA1, t); TPROBE_END(3); }  { TPROBE_BEGIN(5); BAR(); TPROBE_END(5); }
        { TPROBE_BEGIN(4); SEGM(pA0, pA1, t); TPROBE_END(4); }  { TPROBE_BEGIN(5); BAR(); TPROBE_END(5); }
    }
    if (!half) BAR();
    __builtin_amdgcn_s_setprio(0);
    asm volatile("s_waitcnt vmcnt(0)" ::: "memory");
    attn_epilogue<0>(lds, a, o, l_reg, li_l, map, qg, r32, hi);
#undef DMA_TILE
#undef VWAIT
#undef BAR
#undef PIN
#undef ROT4
#undef SEGV
#undef SEGM
}

template <int OFF> __device__ __forceinline__ float lds_rd32(int addr) { float r; asm volatile("ds_read_b32 %0, %1 offset:%2" : "=&v"(r) : "v"(addr), "i"(OFF) : "memory"); return r; }
__device__ __forceinline__ void na_unit(LAS char* lds, const AttnArgs& a) {
    constexpr float SC = ModeC<1>::SC;
    int tid_ = threadIdx.x; asm volatile("" : "+v"(tid_));
    const int tid = tid_, wid = __builtin_amdgcn_readfirstlane(tid >> 6), lane = tid & 63, r32 = lane & 31, hi = lane >> 5;
    LAS char* V_lds = lds; LAS char* K_lds = lds + 4 * SHM_V;
    LAS float* wsf = (LAS float*)(lds + 8 * SHM_V) + wid * 64; LAS float* li_l = wsf; LAS float* al_l = wsf + 32;
    LAS float* bias_l = (LAS float*)(lds + 8 * SHM_V + 2048);
    float m_reg = -1e30f, l_reg = 0; f32x16 o[4] = {}; bf16x8 qr[8];
    const bf16_t* Qw = a.Q + (size_t)(wid * 32 + r32) * LDP + hi * 8;
#pragma unroll
    for (int d0 = 0; d0 < 8; ++d0) qr[d0] = ld8(Qw + d0 * 16);
    const int nr = a.R0 + (wid >> 1), nqc = 32 * (wid & 1) + r32;
    const int ncs = min(max(nqc - 8, 0), 48), nrs = min(max(nr - 4, 0), 56);
    if (tid < 465) bias_l[tid] = a.rpb[tid] * (1.0f / SC);
    const int vb0 = (int)(uintptr_t)V_lds + v_rd_base(lane);
    const int n1 = a.n1, NT = a.n1 + a.n2;
    unsigned gok[2], gov[2];
#pragma unroll
    for (int i = 0; i < 2; ++i) { const int pc = 2 * wid + i;
        const int r = 4 * pc + (lane >> 4), c = (lane & 15) ^ (r & 15); gok[i] = (unsigned)(r * LDP + c * 8) * 2u;
        const int sidx = 2 * pc + (lane >> 5), kk = 8 * (sidx >> 2) + ((lane & 31) >> 2), key = (kk & ~0xC) | ((kk & 4) << 1) | ((kk & 8) >> 1), col = 32 * (sidx & 3) + (lane & 3) * 8;
        gov[i] = (unsigned)(key * LDP + col) * 2u; }
#define NA_DMA(j) do { const int _j = (j); const char* _Kt = (const char*)((_j < n1) ? a.K1 + (size_t)_j * 64 * LDP : a.K2 + (size_t)(_j - n1) * 64 * LDP); \
    const char* _Vt = (const char*)((_j < n1) ? a.V1 + (size_t)_j * 64 * LDP : a.V2 + (size_t)(_j - n1) * 64 * LDP); \
    LAS char* _kd = K_lds + (_j & 3) * SHM_K + wid * 2048; LAS char* _vd = V_lds + (_j & 3) * SHM_V + wid * 2048; \
    __builtin_amdgcn_global_load_lds((const unsigned*)(_Kt + gok[0]), (LAS unsigned*)(_kd), 16, 0, 0); \
    __builtin_amdgcn_global_load_lds((const unsigned*)(_Kt + gok[1]), (LAS unsigned*)(_kd + 1024), 16, 0, 0); \
    __builtin_amdgcn_global_load_lds((const unsigned*)(_Vt + gov[0]), (LAS unsigned*)(_vd), 16, 0, 0); \
    __builtin_amdgcn_global_load_lds((const unsigned*)(_Vt + gov[1]), (LAS unsigned*)(_vd + 1024), 16, 0, 0); } while (0)
    NA_DMA(0); if (1 < NT) NA_DMA(1); if (2 < NT) NA_DMA(2);
    if (NT >= 3) asm volatile("s_waitcnt vmcnt(8)" ::: "memory"); else asm volatile("s_waitcnt vmcnt(0)" ::: "memory");
    TPROBE_BEGIN(14);
    for (int j = 0; j < NT; ++j) {
        const int buf = j & 3;
        asm volatile("s_waitcnt lgkmcnt(0)" ::: "memory"); __builtin_amdgcn_s_barrier();
        if (j + 3 < NT) { NA_DMA(j + 3); }
        const int kr = a.kfirst + j;
        const bool loc = j < n1;
        const bool act = loc ? (kr >= nrs && kr <= nrs + 7) : true;
        TPROBE_BEGIN(13);
        if (act) {
            f32x16 p0, p1; float mn, al; bf16x8 pa0, pa1, pa2, pa3;
            {
              const int kx = (int)(uintptr_t)(K_lds + buf * SHM_K) + r32 * 256, x0 = (hi * 16) ^ ((r32 & 15) << 4);
              const bf16x8 a0 = lds_rd128(kx + (x0 ^ 0)), b0 = lds_rd128_hi(kx + (x0 ^ 0)), a1 = lds_rd128(kx + (x0 ^ 32)), b1 = lds_rd128_hi(kx + (x0 ^ 32));
              const bf16x8 a2 = lds_rd128(kx + (x0 ^ 64)), b2 = lds_rd128_hi(kx + (x0 ^ 64)), a3 = lds_rd128(kx + (x0 ^ 96)), b3 = lds_rd128_hi(kx + (x0 ^ 96));
              const bf16x8 a4 = lds_rd128(kx + (x0 ^ 128)), b4 = lds_rd128_hi(kx + (x0 ^ 128)), a5 = lds_rd128(kx + (x0 ^ 160)), b5 = lds_rd128_hi(kx + (x0 ^ 160));
              const bf16x8 a6 = lds_rd128(kx + (x0 ^ 192)), b6 = lds_rd128_hi(kx + (x0 ^ 192)), a7 = lds_rd128(kx + (x0 ^ 224)), b7 = lds_rd128_hi(kx + (x0 ^ 224));
              const f32x16 z = {};
              LWAIT(14); p0 = __builtin_amdgcn_mfma_f32_32x32x16_bf16(a0, qr[0], z, 0, 0, 0); p1 = __builtin_amdgcn_mfma_f32_32x32x16_bf16(b0, qr[0], z, 0, 0, 0);
              LWAIT(12); p0 = __builtin_amdgcn_mfma_f32_32x32x16_bf16(a1, qr[1], p0, 0, 0, 0); p1 = __builtin_amdgcn_mfma_f32_32x32x16_bf16(b1, qr[1], p1, 0, 0, 0);
              LWAIT(10); p0 = __builtin_amdgcn_mfma_f32_32x32x16_bf16(a2, qr[2], p0, 0, 0, 0); p1 = __builtin_amdgcn_mfma_f32_32x32x16_bf16(b2, qr[2], p1, 0, 0, 0);
              LWAIT(8);  p0 = __builtin_amdgcn_mfma_f32_32x32x16_bf16(a3, qr[3], p0, 0, 0, 0); p1 = __builtin_amdgcn_mfma_f32_32x32x16_bf16(b3, qr[3], p1, 0, 0, 0);
              LWAIT(6);  p0 = __builtin_amdgcn_mfma_f32_32x32x16_bf16(a4, qr[4], p0, 0, 0, 0); p1 = __builtin_amdgcn_mfma_f32_32x32x16_bf16(b4, qr[4], p1, 0, 0, 0);
              LWAIT(4);  p0 = __builtin_amdgcn_mfma_f32_32x32x16_bf16(a5, qr[5], p0, 0, 0, 0); p1 = __builtin_amdgcn_mfma_f32_32x32x16_bf16(b5, qr[5], p1, 0, 0, 0);
              LWAIT(2);  p0 = __builtin_amdgcn_mfma_f32_32x32x16_bf16(a6, qr[6], p0, 0, 0, 0); p1 = __builtin_amdgcn_mfma_f32_32x32x16_bf16(b6, qr[6], p1, 0, 0, 0);
              LWAIT(0);  p0 = __builtin_amdgcn_mfma_f32_32x32x16_bf16(a7, qr[7], p0, 0, 0, 0); p1 = __builtin_amdgcn_mfma_f32_32x32x16_bf16(b7, qr[7], p1, 0, 0, 0); }
            if (loc) {
                const int rel = kr - nr + 7; const int bb = (int)(uintptr_t)bias_l + 4 * (rel * 31 + 15 - nqc + 4 * hi);
                float bv0[16], bv1[16];
#define BRD(r) bv0[r] = lds_rd32<4 * (((r) & 3) + 8 * ((r) >> 2))>(bb); bv1[r] = lds_rd32<4 * (((r) & 3) + 8 * ((r) >> 2)) + 128>(bb);
                BRD(0) BRD(1) BRD(2) BRD(3) BRD(4) BRD(5) BRD(6) BRD(7) BRD(8) BRD(9) BRD(10) BRD(11) BRD(12) BRD(13) BRD(14) BRD(15)
#undef BRD
                asm volatile("s_waitcnt lgkmcnt(0)" ::: "memory"); SBAR();
#pragma unroll
                for (int r = 0; r < 16; ++r) { const int kc0 = crow(r, hi), kc1 = 32 + kc0;
                    const bool v0 = (unsigned)(kc0 - ncs) < 16u, v1 = (unsigned)(kc1 - ncs) < 16u;
                    p0[r] = v0 ? p0[r] + bv0[r] : -1e30f; p1[r] = v1 ? p1[r] + bv1[r] : -1e30f; }
            }
            partialSM<1>(p0, p1, m_reg, mn, al);
            if (__any(al < 1.f)) { if (hi == 0) al_l[r32] = al; asm volatile("s_waitcnt lgkmcnt(0)" ::: "memory");
#pragma unroll
                for (int d = 0; d < 4; ++d)
#pragma unroll
                    for (int r = 0; r < 16; ++r) o[d][r] *= al_l[crow(r, hi)]; }
            finishSM(p0, p1, al, l_reg, pa0, pa1, pa2, pa3);
            pv_d0(o, vb0 + buf * SHM_V, pa0, pa1, pa2, pa3);
        }
        TPROBE_END(13);
        if (j + 3 < NT) asm volatile("s_waitcnt vmcnt(8)" ::: "memory"); else if (j + 2 < NT) asm volatile("s_waitcnt vmcnt(4)" ::: "memory"); else asm volatile("s_waitcnt vmcnt(0)" ::: "memory");
    }
    TPROBE_END(14);
#undef NA_DMA
    attn_epilogue<1>(lds, a, o, l_reg, li_l, 0, wid, r32, hi);
}

struct MlpArgs { const bf16_t* Prow; bf16_t* Yrow; const bf16_t* Wsb; const float *lng, *lnb, *bs, *mg; int g; };
__device__ __forceinline__ void mlp_unit(LAS char* lds, const MlpArgs& a) {
    int tid_ = threadIdx.x; asm volatile("" : "+v"(tid_));
    const int tid = tid_, wid = __builtin_amdgcn_readfirstlane(tid >> 6), lane = tid & 63, r32 = lane & 31, hi = lane >> 5;
    const int sr = tid >> 4, sc = (tid & 15) * 8, g = a.g;
    const f32x4 lg0 = *(const f32x4*)(a.lng + g * 128 + sc), lg1 = *(const f32x4*)(a.lng + g * 128 + sc + 4);
    const f32x4 lb0 = *(const f32x4*)(a.lnb + g * 128 + sc), lb1 = *(const f32x4*)(a.lnb + g * 128 + sc + 4);
#pragma unroll
    for (int t = 0; t < 4; ++t) {
        const int q = t * 32 + sr;
        const u32x4 w = *(const u32x4*)(a.Prow + (size_t)q * LDP + C_MV + g * 128 + sc);
        float v[8] = {bf_lo(w.x), bf_hi(w.x), bf_lo(w.y), bf_hi(w.y), bf_lo(w.z), bf_hi(w.z), bf_lo(w.w), bf_hi(w.w)};
        float s = 0.f;
#pragma unroll
        for (int e = 0; e < 8; ++e) s += v[e];
        s += __shfl_xor(s, 1); s += __shfl_xor(s, 2); s += __shfl_xor(s, 4); s += __shfl_xor(s, 8);
        const float mu = s * (1.0f / 128.0f); float qq = 0.f;
#pragma unroll
        for (int e = 0; e < 8; ++e) { v[e] -= mu; qq += v[e] * v[e]; }
        qq += __shfl_xor(qq, 1); qq += __shfl_xor(qq, 2); qq += __shfl_xor(qq, 4); qq += __shfl_xor(qq, 8);
        const float rstd = __builtin_amdgcn_rsqf(qq * (1.0f / 128.0f) + EPS);
        u32x4 ow;
        ow.x = cvt_pk_bf16(v[0] * rstd * lg0[0] + lb0[0], v[1] * rstd * lg0[1] + lb0[1]); ow.y = cvt_pk_bf16(v[2] * rstd * lg0[2] + lb0[2], v[3] * rstd * lg0[3] + lb0[3]);
        ow.z = cvt_pk_bf16(v[4] * rstd * lg1[0] + lb1[0], v[5] * rstd * lg1[1] + lb1[1]); ow.w = cvt_pk_bf16(v[6] * rstd * lg1[2] + lb1[2], v[7] * rstd * lg1[3] + lb1[3]);
        *(LAS u32x4*)(lds + (q >> 6) * SHM_V + v_st(q & 63, sc)) = ow;
    }
    const int prow0 = 32 * (wid & 3), dsel = wid >> 2;
    bf16x8 pa[8];
    const bf16_t* wp = a.Wsb + ((size_t)(g * 128 + prow0 + r32)) * 128 + 8 * hi;
#pragma unroll
    for (int s = 0; s < 8; ++s) pa[s] = ld8(wp + 16 * s);
    __syncthreads();
    f32x16 o0 = {}, o1 = {};
    const int vb0 = (int)(uintptr_t)lds + v_rd_base(lane);
    if (dsel == 0) { pv_one<0>(o0, vb0, pa[0], pa[1], pa[2], pa[3]); pv_one<1>(o1, vb0, pa[0], pa[1], pa[2], pa[3]);
                     pv_one<0>(o0, vb0 + SHM_V, pa[4], pa[5], pa[6], pa[7]); pv_one<1>(o1, vb0 + SHM_V, pa[4], pa[5], pa[6], pa[7]); }
    else           { pv_one<2>(o0, vb0, pa[0], pa[1], pa[2], pa[3]); pv_one<3>(o1, vb0, pa[0], pa[1], pa[2], pa[3]);
                     pv_one<2>(o0, vb0 + SHM_V, pa[4], pa[5], pa[6], pa[7]); pv_one<3>(o1, vb0 + SHM_V, pa[4], pa[5], pa[6], pa[7]); }
    __syncthreads();
    LAS float* X = (LAS float*)lds;
#pragma unroll
    for (int r = 0; r < 16; ++r) { X[(prow0 + crow(r, hi)) * XS + (2 * dsel) * 32 + r32] = o0[r]; X[(prow0 + crow(r, hi)) * XS + (2 * dsel + 1) * 32 + r32] = o1[r]; }
    __syncthreads();
    final_pass<true>(X, 128, a.Prow + C_MZ + g * 128, a.Yrow + 1536 + g * 128, a.mg + g * 128, 1.0f, a.Prow + C_MU + g * 128, a.bs + g * 128);
    __syncthreads();
}
}

__device__ __forceinline__ void p0_transpose_item(const float* W, int K, int N, bf16_t* WT, LAS float* scr, int item, int lane) {
    const int nblk = N / 32, kb = item / nblk, nb = item % nblk, k0 = 64 * kb, n0 = 32 * nb;
#pragma unroll 8
    for (int i = 0; i < 32; ++i) { const int kk = 2 * i + (lane >> 5); scr[kk * 33 + (lane & 31)] = W[(size_t)(k0 + kk) * N + n0 + (lane & 31)]; }
    asm volatile("s_waitcnt lgkmcnt(0)" ::: "memory");
    const int c = lane & 7;
#pragma unroll
    for (int j = 0; j < 4; ++j) { const int n = (lane >> 3) + 8 * j; const LAS float* s = scr + (8 * c) * 33 + n;
        u32x4 o; o.x = cvt_pk_bf16(s[0 * 33], s[1 * 33]); o.y = cvt_pk_bf16(s[2 * 33], s[3 * 33]); o.z = cvt_pk_bf16(s[4 * 33], s[5 * 33]); o.w = cvt_pk_bf16(s[6 * 33], s[7 * 33]);
        *(u32x4*)(WT + (size_t)(n0 + n) * K + k0 + 8 * c) = o; }
    asm volatile("s_waitcnt lgkmcnt(0)" ::: "memory");
}

__device__ __forceinline__ void phase0a(const Params& p, LAS unsigned char* lds, int tid, int lane, int wave) {
    const int gw = blockIdx.x * 8 + wave, ngw = gridDim.x * 8;
    unsigned char* ws = p.ws;
    LAS float* scr = (LAS float*)(lds + wave * 16384);
    float* mod = (float*)(ws + WS_CTL + CTL_MOD);
    for (int it = (int)blockIdx.x + (int)gridDim.x * wave; it < 768; it += (int)gridDim.x * 8) {
        const int l = it / 384, r = it % 384, kc = r / 24, nc = r % 24;
        const float* W = p.ada_w + (size_t)l * DM * 6144 + nc * 256 + lane * 4;
        f32x4 acc[5];
#pragma unroll
        for (int b = 0; b < 5; ++b) acc[b] = (f32x4){0.f, 0.f, 0.f, 0.f};
        for (int half = 0; half < 2; ++half) {
            const int k0 = kc * 128 + half * 64;
            float sv[5];
#pragma unroll
            for (int b = 0; b < 4; ++b) sv[b] = silu_f(p.c[b * DM + k0 + lane]);
            sv[4] = silu_f(p.c_ctx[k0 + lane]);
#pragma unroll 8
            for (int kk = 0; kk < 64; ++kk) {
                const f32x4 w4 = *(const f32x4*)(W + (size_t)(k0 + kk) * 6144);
#pragma unroll
                for (int b = 0; b < 5; ++b) { const float s = __uint_as_float(__builtin_amdgcn_readlane(__float_as_uint(sv[b]), kk)); acc[b] += w4 * s; }
            }
        }
        if (kc == 0) { const f32x4 bv = *(const f32x4*)(p.ada_b + l * 6144 + nc * 256 + lane * 4);
#pragma unroll
            for (int b = 0; b < 5; ++b) acc[b] += bv; }
#pragma unroll
        for (int b = 0; b < 5; ++b) { float* dst = mod + ((size_t)(l * 5 + b)) * 6144 + nc * 256 + lane * 4;
#pragma unroll
            for (int e = 0; e < 4; ++e) atomicAdd(dst + e, acc[b][e]); }
    }
    float* tab = (float*)(ws + WS_TAB);
    if (gw == ngw - 1) {
        for (int idx = lane; idx < 1024; idx += 64) { const int pos = idx >> 4, i = idx & 15;
            const float freq = powf(10000.0f, -(float)i / 16.0f); const float ang = (float)pos * freq;
            tab[idx] = cosf(ang); tab[1024 + idx] = sinf(ang); }
    }
    if (gw == ngw - 2) {
        for (int l = 0; l < 2; ++l) {
            const float s1 = wave_sum(p.lq1[l * 64 + lane] * p.lk1[l * 64 + lane]), s2 = wave_sum(p.lq2[l * 64 + lane] * p.lk2[l * 64 + lane]);
            const float lam_init = 0.8f - 0.6f * expf(-0.3f * (float)l);
            if (lane == 0) tab[2048 + l] = expf(s1) - expf(s2) + lam_init;
        }
    }
    { bf16_t* wsb = (bf16_t*)(ws + WS_WSB); const int gt = blockIdx.x * 512 + tid;
      if (gt < 16384) { const f32x4 a = *(const f32x4*)(p.mws + gt * 8), b = *(const f32x4*)(p.mws + gt * 8 + 4);
          u32x4 o; o.x = cvt_pk_bf16(a[0], a[1]); o.y = cvt_pk_bf16(a[2], a[3]); o.z = cvt_pk_bf16(b[0], b[1]); o.w = cvt_pk_bf16(b[2], b[3]); *(u32x4*)(wsb + gt * 8) = o; } }
}

__device__ __forceinline__ void phase0b(const Params& p, LAS unsigned char* lds, int tid, int lane, int wave) {
    const int gw = blockIdx.x * 8 + wave, ngw = gridDim.x * 8;
    unsigned char* ws = p.ws;
    LAS float* scr = (LAS float*)(lds + wave * 16384);
    bf16_t* WinT = (bf16_t*)(ws + WS_WIN); bf16_t* WoutT = (bf16_t*)(ws + WS_WOUT);
    constexpr int I_IN = (DM / 64) * (INW / 32), I_OUT = (DM / 64) * (DM / 32), I_L = I_IN + I_OUT;
    for (int it = gw; it < 2 * I_L; it += ngw) {
        const int l = it / I_L, r = it % I_L;
        if (r < I_IN) p0_transpose_item(p.w_in + (size_t)l * DM * INW, DM, INW, WinT + (size_t)l * INW * DM, scr, r, lane);
        else p0_transpose_item(p.w_out + (size_t)l * DM * DM, DM, DM, WoutT + (size_t)l * DM * DM, scr, r - I_IN, lane);
    }
}

template <int L>
__device__ __forceinline__ void norm_phase(const Params& p, int lane, int wave) {
    const int gw = blockIdx.x * 8 + wave, ngw = gridDim.x * 8;
    unsigned char* ws = p.ws;
    const float* mod = (const float*)(ws + WS_CTL + CTL_MOD);
    const float* rowss = (const float*)(ws + WS_CTL + CTL_ROWSS);
    const bf16_t* Y0 = (const bf16_t*)(ws + WS_Y0); const bf16_t* Y1 = (const bf16_t*)(ws + WS_P);
    bf16_t* H = (bf16_t*)(ws + WS_H);
    const int nrows = (L == 2) ? NLAT : MROWS;
    int bcur = -1; f32x4 gq[2][4][2];
    for (int row = gw; row < nrows; row += ngw) {
        const bool isctx = row >= NLAT; const int b = isctx ? 4 : (row >> 12);
        const float* xin = isctx ? p.ctx + (size_t)(row - NLAT) * DM : p.x + (size_t)row * DM;
        f32x4 v[4][2];
#pragma unroll
        for (int j = 0; j < 4; ++j) { v[j][0] = *(const f32x4*)(xin + 8 * lane + 512 * j); v[j][1] = *(const f32x4*)(xin + 8 * lane + 512 * j + 4); }
        if (L >= 1 && b != bcur) { bcur = b;
#pragma unroll
            for (int lp = 0; lp < 2; ++lp) if (lp < L) {
                const float* gate = mod + ((size_t)(lp * 5 + b)) * 6144 + 4096; const float* pg = p.post_g + lp * DM;
#pragma unroll
                for (int j = 0; j < 4; ++j)
#pragma unroll
                    for (int e = 0; e < 2; ++e) { const int cidx = 8 * lane + 512 * j + 4 * e; gq[lp][j][e] = *(const f32x4*)(gate + cidx) * *(const f32x4*)(pg + cidx); } } }
#pragma unroll
        for (int lp = 0; lp < 2; ++lp) {
            if (lp < L) {
                const float rs = __builtin_amdgcn_rsqf(rowss[lp * MROWS + row] * (1.0f / DM) + EPS);
                const bf16_t* Yb = (lp == 0) ? Y0 : Y1;
#pragma unroll
                for (int j = 0; j < 4; ++j) { const int cidx = 8 * lane + 512 * j;
                    const u32x4 w = *(const u32x4*)(Yb + (size_t)row * DM + cidx);
                    const f32x4 y0 = {bf_lo(w.x), bf_hi(w.x), bf_lo(w.y), bf_hi(w.y)}, y1 = {bf_lo(w.z), bf_hi(w.z), bf_lo(w.w), bf_hi(w.w)};
                    v[j][0] = v[j][0] + gq[lp][j][0] * (y0 * rs); v[j][1] = v[j][1] + gq[lp][j][1] * (y1 * rs); }
            }
        }
        if (L == 2) {
            float* xo = p.out + (size_t)row * DM;
#pragma unroll
            for (int j = 0; j < 4; ++j) { *(f32x4*)(xo + 8 * lane + 512 * j) = v[j][0]; *(f32x4*)(xo + 8 * lane + 512 * j + 4) = v[j][1]; }
        } else {
            float ss = 0.f;
#pragma unroll
            for (int j = 0; j < 4; ++j)
#pragma unroll
                for (int e = 0; e < 2; ++e) ss += (v[j][e][0] * v[j][e][0] + v[j][e][1] * v[j][e][1]) + (v[j][e][2] * v[j][e][2] + v[j][e][3] * v[j][e][3]);
            ss = wave_sum(ss);
            const float rstd = __builtin_amdgcn_rsqf(ss * (1.0f / DM) + EPS);
            const float* shift = mod + ((size_t)(L * 5 + b)) * 6144; const float* scale = shift + 2048; const float* pg = p.pre_g + L * DM;
#pragma unroll
            for (int j = 0; j < 4; ++j) { const int cidx = 8 * lane + 512 * j;
                f32x4 hv[2];
#pragma unroll
                for (int e = 0; e < 2; ++e) { const f32x4 sh = *(const f32x4*)(shift + cidx + 4 * e), scv = *(const f32x4*)(scale + cidx + 4 * e), g4 = *(const f32x4*)(pg + cidx + 4 * e);
                    hv[e] = (v[j][e] * rstd) * g4 * (scv + 1.0f) + sh; }
                u32x4 w; w.x = cvt_pk_bf16(hv[0][0], hv[0][1]); w.y = cvt_pk_bf16(hv[0][2], hv[0][3]); w.z = cvt_pk_bf16(hv[1][0], hv[1][1]); w.w = cvt_pk_bf16(hv[1][2], hv[1][3]);
                *(u32x4*)(H + (size_t)row * DM + cidx) = w; }
        }
    }
}

template <int L>
__device__ __forceinline__ void mixer_phase(const Params& p, LAS unsigned char* lds8, int tid, int qslot, int umask) {
    LAS char* lds = (LAS char*)lds8;
    unsigned char* ws = p.ws;
    const bf16_t* P = (const bf16_t*)(ws + WS_P);
    bf16_t* Y = (bf16_t*)(ws + WS_H);
    const float* tab = (const float*)(ws + WS_TAB);
    const float lam = tab[2048 + L];
    const float lam_init = (L == 0) ? 0.2f : 0.35550906759096926f;
    unsigned* qctr = (unsigned*)(ws + WS_CTL + CTL_QCTR) + 64 * qslot;
    volatile LAS unsigned* misc = (volatile LAS unsigned*)(lds8 + MISC_OFF);
    constexpr int N_DIFF = NB * 6 * 32, N_NA = NB * 6 * 16, N_DIFFC = (L == 0) ? NB * 6 * 2 : 0, N_SMC = (L == 0) ? NB * 6 : 0, N_MLP = NB * 32 * 4, N_MLPC = (L == 0) ? NB * 2 * 4 : 0;
    constexpr int NU = N_DIFF + N_NA + N_DIFFC + N_SMC + N_MLP + N_MLPC;
#define PULL() do { if (tid == 0) misc[0] = atomicAdd(qctr, 1u); __syncthreads(); u = (int)misc[0]; __syncthreads(); } while (0)
    int u; PULL();
    constexpr int E_DIFF = N_DIFF, E_NA = E_DIFF + N_NA, E_DIFFC = E_NA + N_DIFFC, E_SMC = E_DIFFC + N_SMC;
    TPROBE_BEGIN(6); unsigned long long _tl = 0; if (PROBE_T == 30 + L && blockIdx.x == 0 && threadIdx.x == 0) _tl = wall_clock64();
    while (u < E_DIFF) { if (!(umask & 1)) { PULL(); continue; }
        if ((PROBE_T == 7 || PROBE_T == 34 + L) && blockIdx.x == 0 && threadIdx.x == 0) { misc[20] = misc[20] + 5000u; }
        const int qb = u & 31, h = (u >> 5) % 6, b = u / 192;
        att::AttnArgs a{};
        const size_t t0 = (size_t)b * SEQ, tq = t0 + qb * 128, tc = (size_t)NLAT + b * CTXL;
        a.Q = P + tq * LDP + C_AQ + h * HD;
        a.K1 = P + t0 * LDP + C_AK + h * HD; a.K2 = P + tc * LDP + C_AK + h * HD;
        a.V1 = P + t0 * LDP + C_AV + h * HD; a.V2 = P + tc * LDP + C_AV + h * HD;
        a.n1 = 64; a.n2 = 4; a.NT = 68;
        a.Z = P + tq * LDP + C_AZ + h * HD; a.Y = Y + tq * DM + h * HD; a.g = p.da_g + L * HD; a.factor = 1.0f - lam_init; a.lam = lam;
        { TPROBE_BEGIN(1); att::diff_unit(lds, a); TPROBE_END(1); }
        PULL();
    }
    TPROBE_END(6); if (PROBE_T == 30 + L && blockIdx.x == 0 && threadIdx.x == 0) { misc[20] = misc[20] + (unsigned)(wall_clock64() - _tl); }
    if (PROBE_T == 32 + L && blockIdx.x == 0 && threadIdx.x == 0) { misc[20] = misc[20] + 5000u * 0u; }
    TPROBE_BEGIN(8);
    while (u >= E_DIFF && u < E_NA) { if (!(umask & 2)) { PULL(); continue; }
        if (PROBE_T == 9 && blockIdx.x == 0 && threadIdx.x == 0) { misc[20] = misc[20] + 5000u; }
        const int v = u - E_DIFF; const int g4 = v & 15, h = (v >> 4) % 6, b = v / 96;
        att::AttnArgs a{};
        const int R0 = 4 * g4, kfirst = min(max(R0 - 4, 0), 56), klast = min(max(R0 - 1, 0), 56) + 7, nloc = klast - kfirst + 1;
        const size_t t0 = (size_t)b * SEQ, tq = t0 + R0 * 64, tk = t0 + kfirst * 64, tc = (size_t)NLAT + b * CTXL;
        a.Q = P + tq * LDP + C_NQ + h * HD;
        a.K1 = P + tk * LDP + C_NK + h * HD; a.K2 = P + tc * LDP + C_NK + h * HD;
        a.V1 = P + tk * LDP + C_NV + h * HD; a.V2 = P + tc * LDP + C_NV + h * HD;
        a.n1 = nloc; a.n2 = 4; a.NT = nloc + 4;
        a.R0 = R0; a.kfirst = kfirst; a.rpb = p.rpb + ((size_t)(L * 6 + h)) * 465;
        a.Z = P + tq * LDP + C_NZ + h * HD; a.Y = Y + tq * DM + 768 + h * HD; a.g = p.na_g + (L * 6 + h) * HD; a.factor = 1.0f; a.lam = 0.f;
        att::na_unit(lds, a);
        PULL();
    }
    TPROBE_END(8);
    while (L == 0 && u >= E_NA && u < E_DIFFC) { if (!(umask & 4)) { PULL(); continue; }
        const int v = u - E_NA; const int qb = v & 1, h = (v >> 1) % 6, b = v / 12;
        att::AttnArgs a{};
        const size_t tc = (size_t)NLAT + b * CTXL, tq = tc + qb * 128;
        a.Q = P + tq * LDP + C_AQ + h * HD;
        a.K1 = P + tc * LDP + C_AK + h * HD; a.K2 = a.K1; a.V1 = P + tc * LDP + C_AV + h * HD; a.V2 = a.V1;
        a.n1 = 4; a.n2 = 1; a.NT = 4;
        a.Z = P + tq * LDP + C_AZ + h * HD; a.Y = Y + tq * DM + h * HD; a.g = p.da_g + L * HD; a.factor = 1.0f - lam_init; a.lam = lam;
        att::diff_unit(lds, a);
        PULL();
    }
    while (L == 0 && u >= E_DIFFC && u < E_SMC) { if (!(umask & 8)) { PULL(); continue; }
        const int v = u - E_DIFFC; const int h = v % 6, b = v / 6;
        att::AttnArgs a{};
        const size_t tc = (size_t)NLAT + b * CTXL;
        a.Q = P + tc * LDP + C_NQ + h * HD;
        a.K1 = P + tc * LDP + C_NK + h * HD; a.K2 = a.K1; a.V1 = P + tc * LDP + C_NV + h * HD; a.V2 = a.V1;
        a.n1 = 0; a.n2 = 4; a.NT = 4; a.rpb = p.rpb;
        a.Z = P + tc * LDP + C_NZ + h * HD; a.Y = Y + tc * DM + 768 + h * HD; a.g = p.na_g + (L * 6 + h) * HD; a.factor = 1.0f; a.lam = 0.f;
        att::na_unit(lds, a);
        PULL();
    }
    TPROBE_BEGIN(12);
    while (u >= E_SMC && u < NU) { if (!(umask & 16)) { PULL(); continue; }
        const int v = u - E_SMC;
        att::MlpArgs m{};
        size_t t0;
        if (v < N_MLP) { const int g = v & 3, ch = (v >> 2) & 31, b = v >> 7; t0 = (size_t)b * SEQ + ch * 128; m.g = g; }
        else { const int w = v - N_MLP; const int g = w & 3, ch = (w >> 2) & 1, b = w >> 3; t0 = (size_t)NLAT + b * CTXL + ch * 128; m.g = g; }
        m.Prow = P + t0 * LDP; m.Yrow = Y + t0 * DM; m.Wsb = (const bf16_t*)(ws + WS_WSB) + (size_t)L * 4 * 128 * 128;
        m.lng = p.ln_g + L * 512; m.lnb = p.ln_b + L * 512; m.bs = p.mbs + L * 512; m.mg = p.mlp_g + L * 512;
        att::mlp_unit(lds, m);
        PULL();
    }
    TPROBE_END(12);
#undef PULL
}

#define XB_TMO      128
#define XB_XCNT(j)  (256  + 64 * (j))
#define XB_XSUB(j)  (1280 + 64 * (j))
#define XB_XGEN(j)  (2304 + 64 * (j))
#define XB_TOP      3328
#define XB_TOPGEN   3392
#define XCD_BAR_WORDS 3456
#define XB_SPIN_CAP (1u << 22)
__device__ __forceinline__ unsigned xb_ld(unsigned* p)              { return __hip_atomic_load(p, __ATOMIC_RELAXED, __HIP_MEMORY_SCOPE_AGENT); }
__device__ __forceinline__ unsigned xb_add(unsigned* p, unsigned v) { return __hip_atomic_fetch_add(p, v, __ATOMIC_RELAXED, __HIP_MEMORY_SCOPE_AGENT); }
__device__ __forceinline__ unsigned xb_xcc_id() { return (unsigned)__builtin_amdgcn_s_getreg((3 << 11) | 20) & 0xFu; }
#define XB_SPIN(cond, bar) do { unsigned _sp = 0; while (cond) { __builtin_amdgcn_s_sleep(1); \
    if ((++_sp & 255u) == 0u) { if (xb_ld(&(bar)[XB_TMO])) break; if (_sp > XB_SPIN_CAP) { atomicAdd(&(bar)[XB_TMO], 1u); break; } } } } while (0)
struct XcdBarrier { unsigned* bar; unsigned x; volatile LAS unsigned* st; };
__device__ __forceinline__ XcdBarrier xcd_barrier_post(unsigned* bar, volatile LAS unsigned* st) {
    XcdBarrier b; b.bar = bar; b.x = xb_xcc_id(); b.st = st;
    if (threadIdx.x == 0) (void)xb_add(&bar[XB_XCNT(b.x)], 1u);
    return b;
}
__device__ __forceinline__ void xcd_barrier_complete(unsigned* bar, unsigned x, unsigned& nloc, unsigned& nx) {
    const unsigned G = gridDim.x * gridDim.y * gridDim.z;
    unsigned sum, cnt, mine, sp = 0u;
    for (;;) {
        sum = 0u; cnt = 0u; mine = 0u;
#pragma unroll
        for (unsigned j = 0; j < 16; ++j) { const unsigned c = xb_ld(&bar[XB_XCNT(j)]); sum += c; cnt += (c > 0u) ? 1u : 0u; mine = (j == x) ? c : mine; }
        if (sum == G) break;
        __builtin_amdgcn_s_sleep(1);
        if ((++sp & 255u) == 0u) { if (xb_ld(&bar[XB_TMO])) break; if (sp > XB_SPIN_CAP) { atomicAdd(&bar[XB_TMO], 1u); break; } }
    }
    nloc = mine > 0u ? mine : 1u; nx = cnt > 0u ? cnt : 1u;
}
__device__ __forceinline__ void xcd_barrier(const XcdBarrier& b) {
    asm volatile("s_waitcnt vmcnt(0)" ::: "memory");
    __syncthreads();
    if (threadIdx.x == 0) {
        unsigned* bar = b.bar;
        __builtin_amdgcn_s_waitcnt(0);
        unsigned nloc = b.st[0], nx = b.st[1];
        if (nloc == 0u) { xcd_barrier_complete(bar, b.x, nloc, nx); b.st[0] = nloc; b.st[1] = nx; }
        const unsigned old = xb_add(&bar[XB_XSUB(b.x)], 1u);
        const unsigned gen = old / nloc;
        if (old + 1u == (gen + 1u) * nloc) {
            __builtin_amdgcn_fence(__ATOMIC_RELEASE, "agent");
            asm volatile("s_waitcnt vmcnt(0)" ::: "memory");
            const unsigned og = xb_add(&bar[XB_TOP], 1u);
            const unsigned tg = og / nx;
            if (og + 1u == (tg + 1u) * nx) xb_add(&bar[XB_TOPGEN], 1u);
            else XB_SPIN(xb_ld(&bar[XB_TOPGEN]) == tg, bar);
            __builtin_amdgcn_fence(__ATOMIC_ACQUIRE, "agent");
            xb_add(&bar[XB_XGEN(b.x)], 1u);
            asm volatile("s_waitcnt vmcnt(0)" ::: "memory");
        } else {
            XB_SPIN(xb_ld(&bar[XB_XGEN(b.x)]) == gen, bar);
            __builtin_amdgcn_fence(__ATOMIC_ACQUIRE, "agent");
            asm volatile("s_waitcnt vmcnt(0)" ::: "memory");
        }
    }
    __syncthreads();
}

__global__ void __launch_bounds__(512, 2) mega_fwd(Params p) {
    extern __shared__ __attribute__((aligned(16))) unsigned char lds_raw[];
    LAS unsigned char* lds = (LAS unsigned char*)lds_raw;
    const int tid = threadIdx.x, lane = tid & 63, wave = __builtin_amdgcn_readfirstlane(tid >> 6);
    unsigned char* ws = p.ws;
    const int lo = p.ph_lo, hi = p.ph_hi;
    volatile LAS unsigned* MISC = (volatile LAS unsigned*)(lds + MISC_OFF);
    if (tid < 64) MISC[tid] = 0u;
    __syncthreads();
    XcdBarrier bar = xcd_barrier_post((unsigned*)(ws + WS_CTL + CTL_BAR), MISC + 8);
#ifndef PH_MASK
#define PH_MASK 0x3ff
#endif
#define IN(k) (((PH_MASK >> (k)) & 1) && lo <= (k) && (k) < hi)
#define SEAM(k) do { if (IN(k) && IN((k) + 1)) { xcd_barrier(bar); } } while (0)
    TPROBE_BEGIN(20);
    if (IN(0)) phase0a(p, lds, tid, lane, wave);
    SEAM(0);
    TPROBE_END(20);
    TPROBE_BEGIN(21);
    if (IN(1)) { norm_phase<0>(p, lane, wave); phase0b(p, lds, tid, lane, wave); }
    SEAM(1);
    TPROBE_END(21);
    TPROBE_BEGIN(22);
    if (IN(2)) for (int rep = 0; rep < ((DUP_PHASE == 2) ? 2 : 1); ++rep) { if (rep) xcd_barrier(bar); pg8::Gemm g{(const bf16_t*)(ws + WS_H), (const bf16_t*)(ws + WS_WIN), DM}; pg8::Sched S; S.init(68, 30, gridDim.x, blockIdx.x, 0);
        pg8::Epi1 E{(bf16_t*)(ws + WS_P), (const float*)(ws + WS_TAB), (const float*)(ws + WS_TAB) + 1024}; pg8::gemm_phase<pg8::Epi1>(lds, g, S, E); }
    SEAM(2);
    TPROBE_END(22);
    TPROBE_BEGIN(23);
    if (IN(3)) mixer_phase<0>(p, lds, tid, 0, UNIT_MASK);
    if (DUP_PHASE == 3) { xcd_barrier(bar); mixer_phase<0>(p, lds, tid, 3, DUP_UMASK); }
    SEAM(3);
    TPROBE_END(23);
    TPROBE_BEGIN(24);
    if (IN(4)) { pg8::Gemm g{(const bf16_t*)(ws + WS_H), (const bf16_t*)(ws + WS_WOUT), DM}; pg8::Sched S; S.init(68, 8, gridDim.x, blockIdx.x, 0);
        pg8::Epi2 E{(bf16_t*)(ws + WS_Y0), (float*)(ws + WS_CTL + CTL_ROWSS)}; pg8::gemm_phase<pg8::Epi2>(lds, g, S, E); }
    SEAM(4);
    TPROBE_END(24);
    TPROBE_BEGIN(25);
    if (IN(5)) norm_phase<1>(p, lane, wave);
    if (DUP_PHASE == 5) { xcd_barrier(bar); norm_phase<1>(p, lane, wave); }
    SEAM(5);
    TPROBE_END(25);
    TPROBE_BEGIN(26);
    if (IN(6)) { pg8::Gemm g{(const bf16_t*)(ws + WS_H), (const bf16_t*)(ws + WS_WIN) + (size_t)INW * DM, DM}; pg8::Sched S; S.init(64, 30, gridDim.x, blockIdx.x, 48);
        pg8::Epi1 E{(bf16_t*)(ws + WS_P), (const float*)(ws + WS_TAB), (const float*)(ws + WS_TAB) + 1024}; pg8::gemm_phase<pg8::Epi1>(lds, g, S, E); }
    SEAM(6);
    TPROBE_END(26);
    { TPROBE_BEGIN(10); if (IN(7)) mixer_phase<1>(p, lds, tid, 1, UNIT_MASK); TPROBE_END(10);
      TPROBE_BEGIN(11); if (PROBE_T == 11) xcd_barrier(bar); TPROBE_END(11); }
    if (DUP_PHASE == 7) { xcd_barrier(bar); mixer_phase<1>(p, lds, tid, 2, DUP_UMASK); }
    SEAM(7);
    TPROBE_BEGIN(28);
    if (IN(8)) { pg8::Gemm g{(const bf16_t*)(ws + WS_H), (const bf16_t*)(ws + WS_WOUT) + (size_t)DM * DM, DM}; pg8::Sched S; S.init(64, 8, gridDim.x, blockIdx.x, 0);
        pg8::Epi2 E{(bf16_t*)(ws + WS_P), (float*)(ws + WS_CTL + CTL_ROWSS) + MROWS}; pg8::gemm_phase<pg8::Epi2>(lds, g, S, E); }
    if (DUP_PHASE == 8) { xcd_barrier(bar); pg8::Gemm g{(const bf16_t*)(ws + WS_H), (const bf16_t*)(ws + WS_WOUT) + (size_t)DM * DM, DM}; pg8::Sched S; S.init(64, 8, gridDim.x, blockIdx.x, 0);
        pg8::Epi2 E{(bf16_t*)(ws + WS_P), (float*)(ws + WS_CTL + 786432)}; pg8::gemm_phase<pg8::Epi2>(lds, g, S, E); }
    SEAM(8);
    TPROBE_END(28);
    TPROBE_BEGIN(29);
    if (IN(9)) norm_phase<2>(p, lane, wave);
    TPROBE_END(29);
    if (PROBE_T != 0 && blockIdx.x == 0 && tid == PROBE_TID) { const unsigned want = MISC[20]; const unsigned long long t0 = wall_clock64(); while ((unsigned)(wall_clock64() - t0) < want) __builtin_amdgcn_s_sleep(8); }
#undef IN
#undef SEAM
}

extern "C" void kernel_launch(void* const* d_in, const int* in_sizes, int n_in, void* d_out, int out_size, void* d_ws, size_t ws_size, hipStream_t stream) {
    static int grid = 0;
    if (grid == 0) {
        if (n_in != 22 || out_size != NLAT * DM || ws_size < WS_END) { fprintf(stderr, "kernel_launch: unexpected shapes (n_in %d out %d ws %zu)\n", n_in, out_size, ws_size); grid = -1; return; }
        int dev = 0, cus = 0, per_cu = 0;
        if (hipGetDevice(&dev) != hipSuccess || hipDeviceGetAttribute(&cus, hipDeviceAttributeMultiprocessorCount, dev) != hipSuccess) { grid = -1; return; }
        if (hipFuncSetAttribute((const void*)mega_fwd, hipFuncAttributeMaxDynamicSharedMemorySize, LDS_BYTES) != hipSuccess) { fprintf(stderr, "kernel_launch: hipFuncSetAttribute failed\n"); grid = -1; return; }
        if (hipOccupancyMaxActiveBlocksPerMultiprocessor(&per_cu, (const void*)mega_fwd, 512, LDS_BYTES) != hipSuccess || per_cu < 1) { fprintf(stderr, "kernel_launch: occupancy query says %d\n", per_cu); per_cu = 1; }
        (void)hipGetLastError();
        grid = cus * 1;
    }
    if (grid < 0) return;
    (void)hipMemsetAsync((char*)d_ws + WS_CTL, 0, CTL_BYTES, stream);
    Params p{};
    p.x = (const float*)d_in[0]; p.c = (const float*)d_in[1]; p.ctx = (const float*)d_in[2]; p.c_ctx = (const float*)d_in[3]; p.ada_w = (const float*)d_in[4]; p.ada_b = (const float*)d_in[5];
    p.pre_g = (const float*)d_in[6]; p.post_g = (const float*)d_in[7]; p.w_in = (const float*)d_in[8]; p.w_out = (const float*)d_in[9];
    p.lq1 = (const float*)d_in[10]; p.lk1 = (const float*)d_in[11]; p.lq2 = (const float*)d_in[12]; p.lk2 = (const float*)d_in[13];
    p.da_g = (const float*)d_in[14]; p.rpb = (const float*)d_in[15]; p.na_g = (const float*)d_in[16]; p.ln_g = (const float*)d_in[17]; p.ln_b = (const float*)d_in[18];
    p.mws = (const float*)d_in[19]; p.mbs = (const float*)d_in[20]; p.mlp_g = (const float*)d_in[21];
    p.out = (float*)d_out; p.ws = (unsigned char*)d_ws;
#if MK_SINGLE
    p.ph_lo = 0; p.ph_hi = 10;
    { void* args[] = {&p}; hipError_t e = hipLaunchCooperativeKernel((const void*)mega_fwd, dim3(grid), dim3(512), args, LDS_BYTES, stream);
      if (e != hipSuccess) fprintf(stderr, "kernel_launch: cooperative launch failed: %s (grid %d)\n", hipGetErrorString(e), grid); }
#else
    for (int ph = 0; ph < 10; ++ph) { p.ph_lo = ph; p.ph_hi = ph + 1; void* args[] = {&p};
        hipError_t e = hipLaunchCooperativeKernel((const void*)mega_fwd, dim3(grid), dim3(512), args, LDS_BYTES, stream);
        if (e != hipSuccess) { fprintf(stderr, "kernel_launch: launch %d failed: %s (grid %d)\n", ph, hipGetErrorString(e), grid); break; } }
#endif
}
```
